# Optimizing an MI355X kernel written in HIP

```python
import math
import jax
import jax.numpy as jnp
from jax import lax
import numpy as np

D_MODEL = 1024
BATCH = 4
SEQ = 8192
DEPTH = 2

EPS = 1e-6
N_BRANCHES = 3
D_SSM = 3 * D_MODEL // 4
SSM_GROUP = 16
SSM_GROUPS = D_SSM // SSM_GROUP
SSM_STATE = 64
DT_MIN = 0.001
DT_MAX = 0.1
ATTN_HEAD_DIM = 64
ATTN_HEADS_PER_GROUP = 4
ATTN_CONFIGS = ((128, 1), (512, 4), (2048, 16))
N_ATTN_HEADS = ATTN_HEADS_PER_GROUP * len(ATTN_CONFIGS)
D_ATTN = N_ATTN_HEADS * ATTN_HEAD_DIM
ATTN_BLOCK = 128
NUM_BUCKETS = 32
REL_MAX_DISTANCE = 2048
NEG_INF = -1e30
MEM_LEN = 256
MEM_HEADS = 4
MEM_HEAD_DIM = D_MODEL // 8
D_MEM = MEM_HEADS * MEM_HEAD_DIM
D_IN = 2 * D_SSM + 4 * D_ATTN + 2 * D_MEM + N_BRANCHES * D_MODEL

kernel_name = "hybrid_s5_dilated_attn_memxattn_gated"


def rms_norm(x, g):
    x32 = x.astype(jnp.float32)
    y = x32 * lax.rsqrt(jnp.mean(x32 * x32, axis=-1, keepdims=True) + EPS)
    return (y * g.astype(jnp.float32)).astype(x.dtype)


def rel_bucket(dist):
    n = jnp.maximum(dist, 0)
    max_exact = NUM_BUCKETS // 2
    n_f = jnp.maximum(n, 1).astype(jnp.float32)
    large = max_exact + (jnp.log(n_f / max_exact) / math.log(REL_MAX_DISTANCE / max_exact)
                         * (NUM_BUCKETS - max_exact)).astype(jnp.int32)
    large = jnp.minimum(large, NUM_BUCKETS - 1)
    return jnp.where(n < max_exact, n, large)


def s5_ssm(u, lam_re, lam_im, log_dt, b_re, b_im, c_re, c_im, d):
    B, L, _ = u.shape
    f32 = jnp.float32
    u32 = u.astype(f32).reshape(B, L, SSM_GROUPS, SSM_GROUP)
    lre, lim = lam_re.astype(f32), lam_im.astype(f32)
    dt = jnp.exp(log_dt.astype(f32))[:, None]
    mag = jnp.exp(lre * dt)
    abar_re, abar_im = mag * jnp.cos(lim * dt), mag * jnp.sin(lim * dt)
    den = lre * lre + lim * lim
    nr, ni = abar_re - 1.0, abar_im
    f_re = (nr * lre + ni * lim) / den
    f_im = (ni * lre - nr * lim) / den
    br, bi = b_re.astype(f32), b_im.astype(f32)
    bbar_re = f_re[..., None] * br - f_im[..., None] * bi
    bbar_im = f_re[..., None] * bi + f_im[..., None] * br
    bu_re = jnp.einsum('blgh,gph->blgp', u32, bbar_re)
    bu_im = jnp.einsum('blgh,gph->blgp', u32, bbar_im)
    a_re = jnp.broadcast_to(abar_re, (L, SSM_GROUPS, SSM_STATE))
    a_im = jnp.broadcast_to(abar_im, (L, SSM_GROUPS, SSM_STATE))

    def combine(e1, e2):
        a1r, a1i, b1r, b1i = e1
        a2r, a2i, b2r, b2i = e2
        return (a1r * a2r - a1i * a2i,
                a1r * a2i + a1i * a2r,
                a2r * b1r - a2i * b1i + b2r,
                a2r * b1i + a2i * b1r + b2i)

    def scan_one(br_seq, bi_seq):
        _, _, xr, xi = lax.associative_scan(combine, (a_re, a_im, br_seq, bi_seq), axis=0)
        return xr, xi

    xr, xi = jax.vmap(scan_one)(bu_re, bu_im)
    y = (jnp.einsum('blgp,ghp->blgh', xr, c_re.astype(f32))
         - jnp.einsum('blgp,ghp->blgh', xi, c_im.astype(f32))
         + d.astype(f32).reshape(SSM_GROUPS, SSM_GROUP) * u32)
    return y.reshape(B, L, D_SSM).astype(u.dtype)


def dilated_window_attention(q, k, v, bias_tab, window, dilation):
    B, L, H, hd = q.shape
    r = dilation
    span = window // dilation
    unit = r * ATTN_BLOCK
    Lp = -(-L // unit) * unit
    M = Lp // r
    nb = M // ATTN_BLOCK
    pad = ((0, 0), (0, Lp - L), (0, 0), (0, 0))

    def to_blocks(a):
        a = jnp.pad(a, pad).reshape(B, M, r, H, hd).transpose(0, 2, 1, 3, 4)
        return a.reshape(B, r, nb, ATTN_BLOCK, H, hd)

    def with_prev(a):
        prev = jnp.pad(a[:, :, :-1], ((0, 0), (0, 0), (1, 0), (0, 0), (0, 0), (0, 0)))
        return jnp.concatenate([prev, a], axis=3)

    qb = to_blocks(q)
    kw = with_prev(to_blocks(k))
    vw = with_prev(to_blocks(v))
    s = jnp.einsum('brnqhd,brnkhd->brnhqk', qb, kw).astype(jnp.float32) * (hd ** -0.5)
    qi = jnp.arange(ATTN_BLOCK)[:, None]
    kj = jnp.arange(2 * ATTN_BLOCK)[None, :]
    delta = ATTN_BLOCK + qi - kj
    band = (delta >= 0) & (delta <= span)
    has_prev = (jnp.arange(nb) > 0)[:, None, None] | (kj >= ATTN_BLOCK)[None]
    valid = band[None] & has_prev
    bias = bias_tab[rel_bucket(jnp.maximum(delta, 0) * r)]
    s = s + bias.transpose(2, 0, 1).astype(jnp.float32)
    s = jnp.where(valid[:, None], s, NEG_INF)
    m = jnp.max(s, axis=-1, keepdims=True)
    p = jnp.exp(s - m)
    l = jnp.sum(p, axis=-1, keepdims=True)
    o = jnp.einsum('brnhqk,brnkhd->brnqhd', (p / l).astype(v.dtype), vw)
    lse = (m + jnp.log(l))[..., 0]
    o = o.reshape(B, r, M, H, hd).transpose(0, 2, 1, 3, 4).reshape(B, Lp, H, hd)[:, :L]
    lse = lse.transpose(0, 1, 2, 4, 3).reshape(B, r, M, H).transpose(0, 2, 1, 3).reshape(B, Lp, H)[:, :L]
    return o, lse


def setup_inputs(seed: int = 0) -> dict:
    key = jax.random.key(seed)
    ks = jax.random.split(key, 32)
    f32 = jnp.float32

    def nrm(k, shape, scale):
        return jax.random.normal(k, shape, f32) * scale

    G, P, Hg = SSM_GROUPS, SSM_STATE, SSM_GROUP
    return {
        "x": nrm(ks[0], (BATCH, SEQ, D_MODEL), 1.0),
        "mem": nrm(ks[1], (BATCH, MEM_LEN, D_MODEL), 1.0),
        "norm_g": 1.0 + nrm(ks[2], (DEPTH, D_MODEL), 0.1),
        "mem_norm_g": 1.0 + nrm(ks[3], (DEPTH, D_MODEL), 0.1),
        "w_in": nrm(ks[4], (DEPTH, D_MODEL, D_IN), D_MODEL ** -0.5),
        "b_gate": nrm(ks[5], (DEPTH, N_BRANCHES * D_MODEL), 0.1),
        "ssm_lambda_re": -0.5 + nrm(ks[6], (DEPTH, G, P), 0.01),
        "ssm_lambda_im": math.pi * jnp.arange(P, dtype=f32) + nrm(ks[7], (DEPTH, G, P), 0.01),
        "ssm_log_dt": jax.random.uniform(ks[8], (DEPTH, G), f32, math.log(DT_MIN), math.log(DT_MAX)),
        "ssm_b_re": nrm(ks[9], (DEPTH, G, P, Hg), (0.5 / Hg) ** 0.5),
        "ssm_b_im": nrm(ks[10], (DEPTH, G, P, Hg), (0.5 / Hg) ** 0.5),
        "ssm_c_re": nrm(ks[11], (DEPTH, G, Hg, P), (0.5 / P) ** 0.5),
        "ssm_c_im": nrm(ks[12], (DEPTH, G, Hg, P), (0.5 / P) ** 0.5),
        "ssm_d": nrm(ks[13], (DEPTH, D_SSM), 0.5),
        "w_glu": nrm(ks[14], (DEPTH, D_SSM, D_SSM), D_SSM ** -0.5),
        "b_glu": nrm(ks[15], (DEPTH, D_SSM), 0.1),
        "w_mem_kv": nrm(ks[16], (DEPTH, D_MODEL, 2 * D_MEM), D_MODEL ** -0.5),
        "w_br_ssm": nrm(ks[17], (DEPTH, D_SSM, D_MODEL), D_SSM ** -0.5),
        "w_br_attn": nrm(ks[18], (DEPTH, D_ATTN, D_MODEL), D_ATTN ** -0.5),
        "w_br_mem": nrm(ks[19], (DEPTH, D_MEM, D_MODEL), D_MEM ** -0.5),
        "w_out": nrm(ks[20], (DEPTH, D_MODEL, D_MODEL), D_MODEL ** -0.5),
        "rel_bias": nrm(ks[21], (NUM_BUCKETS, N_ATTN_HEADS), 0.5),
        "final_norm_g": 1.0 + nrm(ks[22], (D_MODEL,), 0.1),
    }


def reference(x, mem, norm_g, mem_norm_g, w_in, b_gate, ssm_lambda_re, ssm_lambda_im, ssm_log_dt,
              ssm_b_re, ssm_b_im, ssm_c_re, ssm_c_im, ssm_d, w_glu, b_glu, w_mem_kv, w_br_ssm,
              w_br_attn, w_br_mem, w_out, rel_bias, final_norm_g):
    B, L, _ = x.shape
    sizes = (D_SSM, D_SSM, D_ATTN, D_ATTN, D_ATTN, D_ATTN, D_MEM, D_MEM, N_BRANCHES * D_MODEL)
    split_at = np.cumsum(sizes)[:-1].tolist()
    for layer in range(DEPTH):
        h = rms_norm(x, norm_g[layer])
        proj = h @ w_in[layer]
        u_ssm, z_ssm, q, k, v, z_attn, q_mem, z_mem, gate_logits = jnp.split(proj, split_at, axis=-1)

        y = s5_ssm(u_ssm, ssm_lambda_re[layer], ssm_lambda_im[layer], ssm_log_dt[layer],
                   ssm_b_re[layer], ssm_b_im[layer], ssm_c_re[layer], ssm_c_im[layer], ssm_d[layer])
        y = jax.nn.gelu(y)
        y = y * jax.nn.sigmoid(y @ w_glu[layer] + b_glu[layer])
        o_ssm = y * jax.nn.silu(z_ssm)

        qh = q.reshape(B, L, N_ATTN_HEADS, ATTN_HEAD_DIM)
        kh = k.reshape(B, L, N_ATTN_HEADS, ATTN_HEAD_DIM)
        vh = v.reshape(B, L, N_ATTN_HEADS, ATTN_HEAD_DIM)
        outs, lses = [], []
        for g, (window, dilation) in enumerate(ATTN_CONFIGS):
            sl = slice(g * ATTN_HEADS_PER_GROUP, (g + 1) * ATTN_HEADS_PER_GROUP)
            o_g, lse_g = dilated_window_attention(qh[:, :, sl], kh[:, :, sl], vh[:, :, sl],
                                                  rel_bias[:, sl], window, dilation)
            outs.append(o_g)
            lses.append(lse_g)
        alpha = jax.nn.softmax(jnp.stack(lses, axis=0), axis=0)
        o_attn = jnp.concatenate([o_g * alpha[g][..., None].astype(o_g.dtype) for g, o_g in enumerate(outs)],
                                 axis=2).reshape(B, L, D_ATTN)
        o_attn = o_attn * jax.nn.silu(z_attn)

        kv_mem = rms_norm(mem, mem_norm_g[layer]) @ w_mem_kv[layer]
        k_mem, v_mem = jnp.split(kv_mem, 2, axis=-1)
        k_mem = k_mem.reshape(B, MEM_LEN, MEM_HEADS, MEM_HEAD_DIM)
        v_mem = v_mem.reshape(B, MEM_LEN, MEM_HEADS, MEM_HEAD_DIM)
        qm = q_mem.reshape(B, L, MEM_HEADS, MEM_HEAD_DIM)
        s_mem = jnp.einsum('blhd,bmhd->bhlm', qm, k_mem).astype(jnp.float32) * (MEM_HEAD_DIM ** -0.5)
        p_mem = jax.nn.softmax(s_mem, axis=-1).astype(v_mem.dtype)
        o_mem = jnp.einsum('bhlm,bmhd->blhd', p_mem, v_mem).reshape(B, L, D_MEM)
        o_mem = o_mem * jax.nn.silu(z_mem)

        gates = jax.nn.sigmoid((gate_logits + b_gate[layer]).astype(jnp.float32))
        gates = gates.reshape(B, L, N_BRANCHES, D_MODEL).astype(x.dtype)
        merged = (gates[:, :, 0] * (o_ssm @ w_br_ssm[layer])
                  + gates[:, :, 1] * (o_attn @ w_br_attn[layer])
                  + gates[:, :, 2] * (o_mem @ w_br_mem[layer]))
        x = x + merged @ w_out[layer]
    return rms_norm(x, final_norm_g)
```

```cpp
#include <hip/hip_runtime.h>
#include <cstdint>
#include <cstdio>

typedef unsigned short bf16_t;
typedef short bf16x8 __attribute__((ext_vector_type(8)));
typedef float f32x4 __attribute__((ext_vector_type(4)));
typedef float f32x16 __attribute__((ext_vector_type(16)));
typedef unsigned u32x4 __attribute__((ext_vector_type(4)));
typedef unsigned u32x2 __attribute__((ext_vector_type(2)));

constexpr int D_MODEL = 1024, BATCH = 4, SEQ = 8192, DEPTH = 2, T = BATCH * SEQ;
constexpr int D_SSM = 768, NG = 48, HG = 16, NP = 64;
constexpr int NH = 12, HD = 64, D_ATTN = 768;
constexpr int MEM_LEN = 256, MH = 4, MHD = 128, D_MEM = 512;
constexpr int D_IN = 8704, N_A1 = 5632;
constexpr float EPS = 1e-6f;

constexpr size_t MiB = 1u << 20;
constexpr size_t OFF_RS = 1 * MiB, OFF_RSMEM = 1 * MiB + 256 * 1024, OFF_LSE = 2 * MiB;
constexpr size_t OFF_W = 4 * MiB, W_STRIDE = 27 * MiB;
constexpr size_t WO_IN = 0, WO_GLU = 17 * MiB, WO_B1 = WO_GLU + 1179648, WO_B2 = WO_B1 + 1572864, WO_B3 = WO_B2 + 1572864, WO_OUT = WO_B3 + 1048576, WO_MKV = WO_OUT + 2 * MiB;
static_assert(WO_MKV + 2 * MiB <= W_STRIDE, "weights");
constexpr size_t OFF_KVM = 58 * MiB, OFF_MEMB = 62 * MiB, OFF_XB = 64 * MiB, OFF_U = 128 * MiB, OFF_ZM = 188 * MiB, OFF_ZS = 220 * MiB, OFF_Q = 268 * MiB,
                 OFF_K = 316 * MiB, OFF_V = 364 * MiB, OFF_ZA = 412 * MiB, OFF_QM = 460 * MiB, OFF_TAB = 492 * MiB, WS_NEED = 512 * MiB;
constexpr size_t OFF_Y = OFF_K, OFF_MERGED = OFF_U;

__device__ __forceinline__ unsigned f2bf(float f) { unsigned u = __builtin_bit_cast(unsigned, f); return (u + 0x7fffu + ((u >> 16) & 1u)) >> 16; }
__device__ __forceinline__ unsigned pk2(float lo, float hi) { return f2bf(lo) | (f2bf(hi) << 16); }
__device__ __forceinline__ float bflo(unsigned u) { return __builtin_bit_cast(float, u << 16); }
__device__ __forceinline__ float bfhi(unsigned u) { return __builtin_bit_cast(float, u & 0xffff0000u); }
__device__ __forceinline__ float bf2f(bf16_t h) { return __builtin_bit_cast(float, (unsigned)h << 16); }
__device__ __forceinline__ float sigmoidf_(float x) { return 1.f / (1.f + __expf(-x)); }
__device__ __forceinline__ float siluf_(float x) { return x * sigmoidf_(x); }
__device__ __forceinline__ float gelu_tanh(float y) { return 0.5f * y * (1.f + tanhf(0.7978845608028654f * (y + 0.044715f * y * y * y))); }
__device__ __forceinline__ float wave_sum(float v) {
#pragma unroll
    for (int o = 1; o < 64; o <<= 1) v += __shfl_xor(v, o);
    return v;
}
__device__ __forceinline__ float wave_max(float v) {
#pragma unroll
    for (int o = 1; o < 64; o <<= 1) v = fmaxf(v, __shfl_xor(v, o));
    return v;
}

__global__ void __launch_bounds__(256) k_transpose(const float* __restrict__ W, int K, int N, bf16_t* __restrict__ WT, int ldt, const float* __restrict__ kscale) {
    __shared__ float tile[32][33];
    const int k0 = blockIdx.x * 32, n0 = blockIdx.y * 32, tx = threadIdx.x & 31, ty = threadIdx.x >> 5;
    for (int i = ty; i < 32; i += 8) { const float s = kscale ? kscale[k0 + i] : 1.f; tile[i][tx] = W[(size_t)(k0 + i) * N + n0 + tx] * s; }
    __syncthreads();
    for (int i = ty; i < 32; i += 8) WT[(size_t)(n0 + i) * ldt + k0 + tx] = (bf16_t)f2bf(tile[tx][i]);
}
__global__ void __launch_bounds__(256) k_rownorm_bf16(const float* __restrict__ x, bf16_t* __restrict__ xb, float* __restrict__ rs, int rows) {
    const int lane = threadIdx.x & 63; const int row = blockIdx.x * 4 + (threadIdx.x >> 6);
    if (row >= rows) return;
    const f32x4* xr = (const f32x4*)(x + (size_t)row * 1024) + lane;
    f32x4 v[4]; float s = 0.f;
#pragma unroll
    for (int j = 0; j < 4; ++j) { v[j] = xr[64 * j]; s += (v[j].x * v[j].x + v[j].y * v[j].y) + (v[j].z * v[j].z + v[j].w * v[j].w); }
    s = wave_sum(s);
    u32x2* o = (u32x2*)(xb + (size_t)row * 1024) + lane;
#pragma unroll
    for (int j = 0; j < 4; ++j) o[64 * j] = (u32x2){pk2(v[j].x, v[j].y), pk2(v[j].z, v[j].w)};
    if (lane == 0) rs[row] = 1.0f / sqrtf(s * (1.f / 1024.f) + EPS);
}
__global__ void __launch_bounds__(256) k_final_norm(float* __restrict__ x, const float* __restrict__ g, int rows) {
    const int lane = threadIdx.x & 63; const int row = blockIdx.x * 4 + (threadIdx.x >> 6);
    if (row >= rows) return;
    f32x4* xr = (f32x4*)(x + (size_t)row * 1024) + lane; const f32x4* gr = (const f32x4*)g + lane;
    f32x4 v[4]; float s = 0.f;
#pragma unroll
    for (int j = 0; j < 4; ++j) { v[j] = xr[64 * j]; s += (v[j].x * v[j].x + v[j].y * v[j].y) + (v[j].z * v[j].z + v[j].w * v[j].w); }
    s = wave_sum(s); const float r = 1.0f / sqrtf(s * (1.f / 1024.f) + EPS);
#pragma unroll
    for (int j = 0; j < 4; ++j) xr[64 * j] = v[j] * r * gr[64 * j];
}

struct EpiA1 {
    const float* rs; bf16_t *U, *ZS, *Q, *Kb, *V, *ZA, *QM, *ZM;
    __device__ __forceinline__ void operator()(int m, int n, f32x4 v) const {
        v = v * rs[m]; bf16_t* dst; bool silu = false; float sc = 1.f;
        if (n < 768) dst = U + (size_t)m * 768 + n;
        else if (n < 1536) { dst = ZS + (size_t)m * 768 + (n - 768); silu = true; }
        else if (n < 2304) { dst = Q + (size_t)m * 768 + (n - 1536); sc = 0.125f; }
        else if (n < 3072) dst = Kb + (size_t)m * 768 + (n - 2304);
        else if (n < 3840) dst = V + (size_t)m * 768 + (n - 3072);
        else if (n < 4608) { dst = ZA + (size_t)m * 768 + (n - 3840); silu = true; }
        else if (n < 5120) { dst = QM + (size_t)m * 512 + (n - 4608); sc = 0.08838834764831845f; }
        else { dst = ZM + (size_t)m * 512 + (n - 5120); silu = true; }
        if (silu) { v.x = siluf_(v.x); v.y = siluf_(v.y); v.z = siluf_(v.z); v.w = siluf_(v.w); }
        v = v * sc;
        *(u32x2*)dst = (u32x2){pk2(v.x, v.y), pk2(v.z, v.w)};
    }
};
struct EpiKvm {
    const float* rs; bf16_t* O;
    __device__ __forceinline__ void operator()(int m, int n, f32x4 v) const { v = v * rs[m]; *(u32x2*)(O + (size_t)m * 1024 + n) = (u32x2){pk2(v.x, v.y), pk2(v.z, v.w)}; }
};
struct EpiGlu {
    const bf16_t* Y; bf16_t* ZS; const float* b;
    __device__ __forceinline__ void operator()(int m, int n, f32x4 v) const {
        const u32x2 y = *(const u32x2*)(Y + (size_t)m * 768 + n); u32x2* zp = (u32x2*)(ZS + (size_t)m * 768 + n); const u32x2 z = *zp; const f32x4 bb = *(const f32x4*)(b + n);
        const float o0 = bflo(y.x) * sigmoidf_(v.x + bb.x) * bflo(z.x), o1 = bfhi(y.x) * sigmoidf_(v.y + bb.y) * bfhi(z.x);
        const float o2 = bflo(y.y) * sigmoidf_(v.z + bb.z) * bflo(z.y), o3 = bfhi(y.y) * sigmoidf_(v.w + bb.w) * bfhi(z.y);
        *zp = (u32x2){pk2(o0, o1), pk2(o2, o3)};
    }
};
struct EpiOut {
    const float* xold; float* xnew;
    __device__ __forceinline__ void operator()(int m, int n, f32x4 v) const { const size_t o = (size_t)m * 1024 + n; *(f32x4*)(xnew + o) = *(const f32x4*)(xold + o) + v; }
};
template <class Epi>
__global__ void __launch_bounds__(256) k_wgemm(const bf16_t* __restrict__ A, int lda, const bf16_t* __restrict__ Bt, int ldb, int K, int ntn, Epi epi) {
    const int wid = threadIdx.x >> 6, lane = threadIdx.x & 63, r = lane & 31, hi = lane >> 5;
    const int bm = blockIdx.x / ntn, bn = blockIdx.x % ntn;
    const int m0 = bm * 128 + (wid >> 1) * 64, n0 = bn * 128 + (wid & 1) * 64;
    f32x16 acc[2][2];
#pragma unroll
    for (int i = 0; i < 2; ++i)
#pragma unroll
        for (int j = 0; j < 2; ++j)
#pragma unroll
            for (int q = 0; q < 16; ++q) acc[i][j][q] = 0.f;
    const bf16_t* ap = A + (size_t)(m0 + r) * lda + 8 * hi;
    const bf16_t* bp = Bt + (size_t)(n0 + r) * ldb + 8 * hi;
    for (int k = 0; k < K; k += 16) {
        const bf16x8 a0 = *(const bf16x8*)(ap + k), a1 = *(const bf16x8*)(ap + (size_t)32 * lda + k);
        const bf16x8 b0 = *(const bf16x8*)(bp + k), b1 = *(const bf16x8*)(bp + (size_t)32 * ldb + k);
        acc[0][0] = __builtin_amdgcn_mfma_f32_32x32x16_bf16(b0, a0, acc[0][0], 0, 0, 0);
        acc[0][1] = __builtin_amdgcn_mfma_f32_32x32x16_bf16(b1, a0, acc[0][1], 0, 0, 0);
        acc[1][0] = __builtin_amdgcn_mfma_f32_32x32x16_bf16(b0, a1, acc[1][0], 0, 0, 0);
        acc[1][1] = __builtin_amdgcn_mfma_f32_32x32x16_bf16(b1, a1, acc[1][1], 0, 0, 0);
    }
#pragma unroll
    for (int mi = 0; mi < 2; ++mi)
#pragma unroll
        for (int ni = 0; ni < 2; ++ni)
#pragma unroll
            for (int q = 0; q < 4; ++q)
                epi(m0 + 32 * mi + r, n0 + 32 * ni + 8 * q + 4 * hi, (f32x4){acc[mi][ni][4 * q], acc[mi][ni][4 * q + 1], acc[mi][ni][4 * q + 2], acc[mi][ni][4 * q + 3]});
}

__global__ void __launch_bounds__(256) k_merge(const bf16_t* __restrict__ XB, const float* __restrict__ rs, const bf16_t* __restrict__ WinT, const float* __restrict__ bg,
                                               const bf16_t* __restrict__ OS, const bf16_t* __restrict__ OA, const bf16_t* __restrict__ OM,
                                               const bf16_t* __restrict__ W1, const bf16_t* __restrict__ W2, const bf16_t* __restrict__ W3, bf16_t* __restrict__ MG) {
    const int wid = threadIdx.x >> 6, lane = threadIdx.x & 63, r = lane & 31, hi = lane >> 5;
    const int tile = blockIdx.x * 4 + wid; const int m0 = (tile >> 5) * 32, n0 = (tile & 31) * 32;
    f32x16 L0, L1, L2, P0, P1, P2;
#pragma unroll
    for (int q = 0; q < 16; ++q) { L0[q] = 0.f; L1[q] = 0.f; L2[q] = 0.f; P0[q] = 0.f; P1[q] = 0.f; P2[q] = 0.f; }
    {
        const bf16_t* ap = XB + (size_t)(m0 + r) * 1024 + 8 * hi; const bf16_t* bp = WinT + (size_t)(N_A1 + n0 + r) * 1024 + 8 * hi;
        for (int k = 0; k < 1024; k += 16) {
            const bf16x8 a = *(const bf16x8*)(ap + k);
            L0 = __builtin_amdgcn_mfma_f32_32x32x16_bf16(*(const bf16x8*)(bp + k), a, L0, 0, 0, 0);
            L1 = __builtin_amdgcn_mfma_f32_32x32x16_bf16(*(const bf16x8*)(bp + (size_t)1024 * 1024 + k), a, L1, 0, 0, 0);
            L2 = __builtin_amdgcn_mfma_f32_32x32x16_bf16(*(const bf16x8*)(bp + (size_t)2048 * 1024 + k), a, L2, 0, 0, 0);
        }
    }
    {
        const bf16_t* ap = OS + (size_t)(m0 + r) * 768 + 8 * hi; const bf16_t* bp = W1 + (size_t)(n0 + r) * 768 + 8 * hi;
        for (int k = 0; k < 768; k += 16) P0 = __builtin_amdgcn_mfma_f32_32x32x16_bf16(*(const bf16x8*)(bp + k), *(const bf16x8*)(ap + k), P0, 0, 0, 0);
    }
    {
        const bf16_t* ap = OA + (size_t)(m0 + r) * 768 + 8 * hi; const bf16_t* bp = W2 + (size_t)(n0 + r) * 768 + 8 * hi;
        for (int k = 0; k < 768; k += 16) P1 = __builtin_amdgcn_mfma_f32_32x32x16_bf16(*(const bf16x8*)(bp + k), *(const bf16x8*)(ap + k), P1, 0, 0, 0);
    }
    {
        const bf16_t* ap = OM + (size_t)(m0 + r) * 512 + 8 * hi; const bf16_t* bp = W3 + (size_t)(n0 + r) * 512 + 8 * hi;
        for (int k = 0; k < 512; k += 16) P2 = __builtin_amdgcn_mfma_f32_32x32x16_bf16(*(const bf16x8*)(bp + k), *(const bf16x8*)(ap + k), P2, 0, 0, 0);
    }
    const int m = m0 + r; const float rsm = rs[m];
#pragma unroll
    for (int q = 0; q < 4; ++q) {
        const int n = n0 + 8 * q + 4 * hi; float o[4];
#pragma unroll
        for (int e = 0; e < 4; ++e) {
            const int rg = 4 * q + e;
            const float g0 = sigmoidf_(rsm * L0[rg] + bg[n + e]), g1 = sigmoidf_(rsm * L1[rg] + bg[1024 + n + e]), g2 = sigmoidf_(rsm * L2[rg] + bg[2048 + n + e]);
            o[e] = g0 * P0[rg] + g1 * P1[rg] + g2 * P2[rg];
        }
        *(u32x2*)(MG + (size_t)m * 1024 + n) = (u32x2){pk2(o[0], o[1]), pk2(o[2], o[3])};
    }
}

__global__ void __launch_bounds__(64) k_ssm_naive(const bf16_t* __restrict__ U, bf16_t* __restrict__ Y, const float* __restrict__ lam_re, const float* __restrict__ lam_im,
                                                  const float* __restrict__ log_dt, const float* __restrict__ b_re, const float* __restrict__ b_im,
                                                  const float* __restrict__ c_re, const float* __restrict__ c_im, const float* __restrict__ dvec) {
    __shared__ float xs[128];
    const int b = blockIdx.x / NG, g = blockIdx.x % NG, lane = threadIdx.x;
    const float dt = expf(log_dt[g]); const float lre = lam_re[g * 64 + lane], lim = lam_im[g * 64 + lane];
    const float mag = expf(lre * dt); const float ar = mag * cosf(lim * dt), ai = mag * sinf(lim * dt);
    const float den = lre * lre + lim * lim, nr = ar - 1.0f, ni = ai;
    const float fr = (nr * lre + ni * lim) / den, fi = (ni * lre - nr * lim) / den;
    float bbr[16], bbi[16];
#pragma unroll
    for (int h = 0; h < 16; ++h) { const float br = b_re[(g * 64 + lane) * 16 + h], bi = b_im[(g * 64 + lane) * 16 + h]; bbr[h] = fr * br - fi * bi; bbi[h] = fr * bi + fi * br; }
    const int hq = lane & 15, part = lane >> 4;
    float cr[16], ci[16];
#pragma unroll
    for (int i = 0; i < 16; ++i) { cr[i] = c_re[(g * 16 + hq) * 64 + part * 16 + i]; ci[i] = c_im[(g * 16 + hq) * 64 + part * 16 + i]; }
    const float dd = dvec[g * 16 + hq];
    float xr = 0.f, xi = 0.f;
    const bf16_t* up = U + (size_t)b * SEQ * 768 + g * 16; bf16_t* yp = Y + (size_t)b * SEQ * 768 + g * 16;
    for (int t = 0; t < SEQ; ++t) {
        const u32x4 ua = *(const u32x4*)(up + (size_t)t * 768), ub = *(const u32x4*)(up + (size_t)t * 768 + 8);
        const float uh = bf2f(up[(size_t)t * 768 + hq]);
        float u[16];
        u[0] = bflo(ua.x); u[1] = bfhi(ua.x); u[2] = bflo(ua.y); u[3] = bfhi(ua.y); u[4] = bflo(ua.z); u[5] = bfhi(ua.z); u[6] = bflo(ua.w); u[7] = bfhi(ua.w);
        u[8] = bflo(ub.x); u[9] = bfhi(ub.x); u[10] = bflo(ub.y); u[11] = bfhi(ub.y); u[12] = bflo(ub.z); u[13] = bfhi(ub.z); u[14] = bflo(ub.w); u[15] = bfhi(ub.w);
        float bur = 0.f, bui = 0.f;
#pragma unroll
        for (int h = 0; h < 16; ++h) { bur += bbr[h] * u[h]; bui += bbi[h] * u[h]; }
        const float nxr = ar * xr - ai * xi + bur, nxi = ar * xi + ai * xr + bui; xr = nxr; xi = nxi;
        xs[lane] = xr; xs[64 + lane] = xi;
        __syncthreads();
        float acc = 0.f;
#pragma unroll
        for (int i = 0; i < 16; ++i) acc += cr[i] * xs[part * 16 + i] - ci[i] * xs[64 + part * 16 + i];
        acc += __shfl_xor(acc, 16); acc += __shfl_xor(acc, 32);
        __syncthreads();
        if (lane < 16) yp[(size_t)t * 768 + lane] = (bf16_t)f2bf(gelu_tanh(acc + dd * uh));
    }
}

__device__ __forceinline__ int rel_bucket(int n) {
    if (n < 16) return n;
    const float v = logf((float)n / 16.0f) / 4.852030263919617f * 16.0f;
    const int lg = 16 + (int)v; return lg < 31 ? lg : 31;
}
__device__ __forceinline__ float dot8(const u32x4 a, const u32x4 b) {
    return bflo(a.x) * bflo(b.x) + bfhi(a.x) * bfhi(b.x) + bflo(a.y) * bflo(b.y) + bfhi(a.y) * bfhi(b.y) + bflo(a.z) * bflo(b.z) + bfhi(a.z) * bfhi(b.z) + bflo(a.w) * bflo(b.w) + bfhi(a.w) * bfhi(b.w);
}
__global__ void __launch_bounds__(256) k_attn_naive(bf16_t* Q, const bf16_t* __restrict__ Kb, const bf16_t* __restrict__ V, const float* __restrict__ rel_bias, float* __restrict__ lse) {
    const int lane = threadIdx.x & 63; const int gw = blockIdx.x * 4 + (threadIdx.x >> 6), nw = gridDim.x * 4;
    for (int item = gw; item < T * NH; item += nw) {
        const int head = item % NH, tok = item / NH, t = tok % SEQ, row0 = tok - t;
        const int grp = head >> 2, r = grp == 0 ? 1 : (grp == 1 ? 4 : 16);
        bf16_t* qp = Q + (size_t)tok * 768 + head * 64;
        u32x4 qv[8];
#pragma unroll
        for (int i = 0; i < 8; ++i) qv[i] = ((const u32x4*)qp)[i];
        float s[3]; bool ok[3];
#pragma unroll
        for (int sl = 0; sl < 3; ++sl) {
            const int j = sl * 64 + lane, p = t - j * r; ok[sl] = (j <= 128) && (p >= 0); s[sl] = -1e30f;
            if (ok[sl]) {
                const u32x4* kp = (const u32x4*)(Kb + (size_t)(row0 + p) * 768 + head * 64); float d = 0.f;
#pragma unroll
                for (int i = 0; i < 8; ++i) d += dot8(qv[i], kp[i]);
                s[sl] = d + rel_bias[rel_bucket(j * r) * NH + head];
            }
        }
        const float m = wave_max(fmaxf(fmaxf(s[0], s[1]), s[2]));
        float e[3];
#pragma unroll
        for (int sl = 0; sl < 3; ++sl) e[sl] = ok[sl] ? __expf(s[sl] - m) : 0.f;
        const float l = wave_sum(e[0] + e[1] + e[2]);
        float o = 0.f;
#pragma unroll
        for (int sl = 0; sl < 3; ++sl) {
            for (int jj = 0; jj < 64; ++jj) {
                const int j = sl * 64 + jj, p = t - j * r; if (j > 128 || p < 0) break;
                const float pj = __shfl(e[sl], jj);
                o += pj * bf2f(V[(size_t)(row0 + p) * 768 + head * 64 + lane]);
            }
        }
        qp[lane] = (bf16_t)f2bf(o / l);
        if (lane == 0) lse[(size_t)tok * NH + head] = m + logf(l);
    }
}
__global__ void __launch_bounds__(256) k_attn_final(bf16_t* __restrict__ Q, const float* __restrict__ lse, const bf16_t* __restrict__ ZA) {
    const int lane = threadIdx.x & 63; const int tok = blockIdx.x * 4 + (threadIdx.x >> 6);
    const float* lp = lse + (size_t)tok * NH;
    for (int c = lane * 4; c < 768; c += 256) {
        const int head = c >> 6, hh = head & 3; const float l0 = lp[hh], l1 = lp[4 + hh], l2 = lp[8 + hh];
        const float mx = fmaxf(fmaxf(l0, l1), l2); const float e0 = __expf(l0 - mx), e1 = __expf(l1 - mx), e2 = __expf(l2 - mx);
        const float mine = head < 4 ? e0 : (head < 8 ? e1 : e2); const float al = mine / (e0 + e1 + e2);
        u32x2* qp = (u32x2*)(Q + (size_t)tok * 768 + c); const u32x2 o = *qp; const u32x2 z = *(const u32x2*)(ZA + (size_t)tok * 768 + c);
        *qp = (u32x2){pk2(bflo(o.x) * al * bflo(z.x), bfhi(o.x) * al * bfhi(z.x)), pk2(bflo(o.y) * al * bflo(z.y), bfhi(o.y) * al * bfhi(z.y))};
    }
}
__global__ void __launch_bounds__(256) k_memattn_naive(bf16_t* QM, const bf16_t* __restrict__ KVM, const bf16_t* __restrict__ ZM) {
    const int lane = threadIdx.x & 63; const int gw = blockIdx.x * 4 + (threadIdx.x >> 6), nw = gridDim.x * 4;
    for (int item = gw; item < T * MH; item += nw) {
        const int head = item & 3, tok = item >> 2, b = tok / SEQ;
        bf16_t* qp = QM + (size_t)tok * 512 + head * 128;
        u32x4 qv[16];
#pragma unroll
        for (int i = 0; i < 16; ++i) qv[i] = ((const u32x4*)qp)[i];
        float s[4];
#pragma unroll
        for (int sl = 0; sl < 4; ++sl) {
            const int j = sl * 64 + lane; const u32x4* kp = (const u32x4*)(KVM + (size_t)(b * 256 + j) * 1024 + head * 128); float d = 0.f;
#pragma unroll
            for (int i = 0; i < 16; ++i) d += dot8(qv[i], kp[i]);
            s[sl] = d;
        }
        const float m = wave_max(fmaxf(fmaxf(s[0], s[1]), fmaxf(s[2], s[3])));
        float e[4];
#pragma unroll
        for (int sl = 0; sl < 4; ++sl) e[sl] = __expf(s[sl] - m);
        const float l = wave_sum((e[0] + e[1]) + (e[2] + e[3]));
        float o0 = 0.f, o1 = 0.f;
#pragma unroll
        for (int sl = 0; sl < 4; ++sl)
            for (int jj = 0; jj < 64; ++jj) {
                const int j = sl * 64 + jj; const float pj = __shfl(e[sl], jj);
                const bf16_t* vp = KVM + (size_t)(b * 256 + j) * 1024 + 512 + head * 128;
                o0 += pj * bf2f(vp[lane]); o1 += pj * bf2f(vp[64 + lane]);
            }
        const bf16_t* zp = ZM + (size_t)tok * 512 + head * 128;
        qp[lane] = (bf16_t)f2bf(o0 / l * bf2f(zp[lane])); qp[64 + lane] = (bf16_t)f2bf(o1 / l * bf2f(zp[64 + lane]));
    }
}

extern "C" void kernel_launch(void* const* d_in, const int* in_sizes, int n_in, void* d_out, int out_size, void* d_ws, size_t ws_size, hipStream_t stream) {
    if (n_in != 23 || ws_size < WS_NEED || out_size != T * D_MODEL) { fprintf(stderr, "kernel_launch: unexpected shapes (n_in %d, ws %zu, out %d)\n", n_in, ws_size, out_size); return; }
    const float* x = (const float*)d_in[0]; const float* mem = (const float*)d_in[1]; const float* norm_g = (const float*)d_in[2]; const float* mem_norm_g = (const float*)d_in[3];
    const float* w_in = (const float*)d_in[4]; const float* b_gate = (const float*)d_in[5];
    const float* lam_re = (const float*)d_in[6]; const float* lam_im = (const float*)d_in[7]; const float* log_dt = (const float*)d_in[8];
    const float* b_re = (const float*)d_in[9]; const float* b_im = (const float*)d_in[10]; const float* c_re = (const float*)d_in[11]; const float* c_im = (const float*)d_in[12];
    const float* ssm_d = (const float*)d_in[13]; const float* w_glu = (const float*)d_in[14]; const float* b_glu = (const float*)d_in[15]; const float* w_mem_kv = (const float*)d_in[16];
    const float* w_br_ssm = (const float*)d_in[17]; const float* w_br_attn = (const float*)d_in[18]; const float* w_br_mem = (const float*)d_in[19]; const float* w_out = (const float*)d_in[20];
    const float* rel_bias = (const float*)d_in[21]; const float* final_g = (const float*)d_in[22];
    float* out = (float*)d_out; unsigned char* ws = (unsigned char*)d_ws;
    float* rs = (float*)(ws + OFF_RS); float* rs_mem = (float*)(ws + OFF_RSMEM); float* lse = (float*)(ws + OFF_LSE);
    bf16_t* XB = (bf16_t*)(ws + OFF_XB); bf16_t* U = (bf16_t*)(ws + OFF_U); bf16_t* ZM = (bf16_t*)(ws + OFF_ZM); bf16_t* ZS = (bf16_t*)(ws + OFF_ZS); bf16_t* Q = (bf16_t*)(ws + OFF_Q);
    bf16_t* Kb = (bf16_t*)(ws + OFF_K); bf16_t* V = (bf16_t*)(ws + OFF_V); bf16_t* ZA = (bf16_t*)(ws + OFF_ZA); bf16_t* QM = (bf16_t*)(ws + OFF_QM);
    bf16_t* Y = (bf16_t*)(ws + OFF_Y); bf16_t* MG = (bf16_t*)(ws + OFF_MERGED); bf16_t* MEMB = (bf16_t*)(ws + OFF_MEMB);
    auto Wl = [&](int l, size_t o) { return (bf16_t*)(ws + OFF_W + (size_t)l * W_STRIDE + o); };
    for (int l = 0; l < DEPTH; ++l) {
        k_transpose<<<dim3(1024 / 32, D_IN / 32), 256, 0, stream>>>(w_in + (size_t)l * 1024 * D_IN, 1024, D_IN, Wl(l, WO_IN), 1024, norm_g + l * 1024);
        k_transpose<<<dim3(768 / 32, 768 / 32), 256, 0, stream>>>(w_glu + (size_t)l * 768 * 768, 768, 768, Wl(l, WO_GLU), 768, nullptr);
        k_transpose<<<dim3(768 / 32, 1024 / 32), 256, 0, stream>>>(w_br_ssm + (size_t)l * 768 * 1024, 768, 1024, Wl(l, WO_B1), 768, nullptr);
        k_transpose<<<dim3(768 / 32, 1024 / 32), 256, 0, stream>>>(w_br_attn + (size_t)l * 768 * 1024, 768, 1024, Wl(l, WO_B2), 768, nullptr);
        k_transpose<<<dim3(512 / 32, 1024 / 32), 256, 0, stream>>>(w_br_mem + (size_t)l * 512 * 1024, 512, 1024, Wl(l, WO_B3), 512, nullptr);
        k_transpose<<<dim3(1024 / 32, 1024 / 32), 256, 0, stream>>>(w_out + (size_t)l * 1024 * 1024, 1024, 1024, Wl(l, WO_OUT), 1024, nullptr);
        k_transpose<<<dim3(1024 / 32, 1024 / 32), 256, 0, stream>>>(w_mem_kv + (size_t)l * 1024 * 1024, 1024, 1024, Wl(l, WO_MKV), 1024, mem_norm_g + l * 1024);
    }
    k_rownorm_bf16<<<T / 4, 256, 0, stream>>>(x, XB, rs, T);
    k_rownorm_bf16<<<BATCH * MEM_LEN / 4, 256, 0, stream>>>(mem, MEMB, rs_mem, BATCH * MEM_LEN);
    for (int l = 0; l < DEPTH; ++l) {
        bf16_t* KVM = (bf16_t*)(ws + OFF_KVM + (size_t)l * 2 * MiB);
        k_wgemm<EpiKvm><<<(1024 / 128) * (1024 / 128), 256, 0, stream>>>(MEMB, 1024, Wl(l, WO_MKV), 1024, 1024, 1024 / 128, EpiKvm{rs_mem, KVM});
    }
    for (int l = 0; l < DEPTH; ++l) {
        bf16_t* KVM = (bf16_t*)(ws + OFF_KVM + (size_t)l * 2 * MiB);
        k_wgemm<EpiA1><<<(T / 128) * (N_A1 / 128), 256, 0, stream>>>(XB, 1024, Wl(l, WO_IN), 1024, 1024, N_A1 / 128, EpiA1{rs, U, ZS, Q, Kb, V, ZA, QM, ZM});
        k_attn_naive<<<4096, 256, 0, stream>>>(Q, Kb, V, rel_bias, lse);
        k_attn_final<<<T / 4, 256, 0, stream>>>(Q, lse, ZA);
        k_memattn_naive<<<4096, 256, 0, stream>>>(QM, KVM, ZM);
        k_ssm_naive<<<BATCH * NG, 64, 0, stream>>>(U, Y, lam_re + l * NG * NP, lam_im + l * NG * NP, log_dt + l * NG, b_re + (size_t)l * NG * NP * HG, b_im + (size_t)l * NG * NP * HG,
                                                   c_re + (size_t)l * NG * HG * NP, c_im + (size_t)l * NG * HG * NP, ssm_d + l * D_SSM);
        k_wgemm<EpiGlu><<<(T / 128) * (768 / 128), 256, 0, stream>>>(Y, 768, Wl(l, WO_GLU), 768, 768, 768 / 128, EpiGlu{Y, ZS, b_glu + l * 768});
        k_merge<<<(T / 32) * (1024 / 32) / 4, 256, 0, stream>>>(XB, rs, Wl(l, WO_IN), b_gate + l * 3072, ZS, Q, QM, Wl(l, WO_B1), Wl(l, WO_B2), Wl(l, WO_B3), MG);
        k_wgemm<EpiOut><<<(T / 128) * (1024 / 128), 256, 0, stream>>>(MG, 1024, Wl(l, WO_OUT), 1024, 1024, 1024 / 128, EpiOut{l == 0 ? x : out, out});
        if (l + 1 < DEPTH) k_rownorm_bf16<<<T / 4, 256, 0, stream>>>(out, XB, rs, T);
    }
    k_final_norm<<<T / 4, 256, 0, stream>>>(out, final_g, T);
}
```

```cpp
#include <hip/hip_runtime.h>
#include <cstdint>
#include <cstdio>

typedef unsigned short bf16_t;
typedef short bf16x8 __attribute__((ext_vector_type(8)));
typedef float f32x4 __attribute__((ext_vector_type(4)));
typedef float f32x16 __attribute__((ext_vector_type(16)));
typedef unsigned u32x4 __attribute__((ext_vector_type(4)));
typedef unsigned u32x2 __attribute__((ext_vector_type(2)));

constexpr int D_MODEL = 1024, BATCH = 4, SEQ = 8192, DEPTH = 2, T = BATCH * SEQ;
constexpr int D_SSM = 768, NG = 48, HG = 16, NP = 64;
constexpr int NH = 12, HD = 64, D_ATTN = 768;
constexpr int MEM_LEN = 256, MH = 4, MHD = 128, D_MEM = 512;
constexpr int D_IN = 8704, N_A1 = 5632;
constexpr float EPS = 1e-6f;

constexpr size_t MiB = 1u << 20;
constexpr size_t OFF_RS = 1 * MiB, OFF_RSMEM = 1 * MiB + 256 * 1024, OFF_LSE = 2 * MiB;
constexpr size_t OFF_W = 4 * MiB, W_STRIDE = 27 * MiB;
constexpr size_t WO_IN = 0, WO_GLU = 17 * MiB, WO_B1 = WO_GLU + 1179648, WO_B2 = WO_B1 + 1572864, WO_B3 = WO_B2 + 1572864, WO_OUT = WO_B3 + 1048576, WO_MKV = WO_OUT + 2 * MiB;
static_assert(WO_MKV + 2 * MiB <= W_STRIDE, "weights");
constexpr size_t OFF_KVM = 58 * MiB, OFF_MEMB = 62 * MiB, OFF_XB = 64 * MiB, OFF_U = 128 * MiB, OFF_ZM = 188 * MiB, OFF_ZS = 220 * MiB, OFF_Q = 268 * MiB,
                 OFF_K = 316 * MiB, OFF_V = 364 * MiB, OFF_ZA = 412 * MiB, OFF_QM = 460 * MiB, OFF_TAB = 492 * MiB, WS_NEED = 512 * MiB;
constexpr size_t OFF_Y = OFF_K, OFF_MERGED = OFF_U;

__device__ __forceinline__ unsigned f2bf(float f) { unsigned u = __builtin_bit_cast(unsigned, f); return (u + 0x7fffu + ((u >> 16) & 1u)) >> 16; }
__device__ __forceinline__ unsigned pk2(float lo, float hi) { return f2bf(lo) | (f2bf(hi) << 16); }
__device__ __forceinline__ float bflo(unsigned u) { return __builtin_bit_cast(float, u << 16); }
__device__ __forceinline__ float bfhi(unsigned u) { return __builtin_bit_cast(float, u & 0xffff0000u); }
__device__ __forceinline__ float bf2f(bf16_t h) { return __builtin_bit_cast(float, (unsigned)h << 16); }
__device__ __forceinline__ float sigmoidf_(float x) { return 1.f / (1.f + __expf(-x)); }
__device__ __forceinline__ float siluf_(float x) { return x * sigmoidf_(x); }
__device__ __forceinline__ float gelu_tanh(float y) { return 0.5f * y * (1.f + tanhf(0.7978845608028654f * (y + 0.044715f * y * y * y))); }
__device__ __forceinline__ float wave_sum(float v) {
#pragma unroll
    for (int o = 1; o < 64; o <<= 1) v += __shfl_xor(v, o);
    return v;
}
__device__ __forceinline__ float wave_max(float v) {
#pragma unroll
    for (int o = 1; o < 64; o <<= 1) v = fmaxf(v, __shfl_xor(v, o));
    return v;
}

#define GAS __attribute__((address_space(1)))
#define LAS __attribute__((address_space(3)))
constexpr int NWAVES = 8, NTHREADS = 512;
constexpr int RING_BYTES = 131072, LDSCTL_OFF = RING_BYTES, MISC_OFF = LDSCTL_OFF + 320, LDS_BYTES = 147456;
constexpr size_t CTL_ZERO_BYTES = 1 * MiB; constexpr int CW_BAR = 4096;

#define XB_TMO      128
#define XB_XCNT(j)  (256  + 64 * (j))
#define XB_XSUB(j)  (1280 + 64 * (j))
#define XB_XGEN(j)  (2304 + 64 * (j))
#define XB_TOP      3328
#define XB_TOPGEN   3392
#define XCD_BAR_WORDS 3456
#define XB_SPIN_CAP (1u << 18)
__device__ __forceinline__ unsigned xb_ld(unsigned* p)              { return __hip_atomic_load(p, __ATOMIC_RELAXED, __HIP_MEMORY_SCOPE_AGENT); }
__device__ __forceinline__ unsigned xb_add(unsigned* p, unsigned v) { return __hip_atomic_fetch_add(p, v, __ATOMIC_RELAXED, __HIP_MEMORY_SCOPE_AGENT); }
__device__ __forceinline__ unsigned xb_xcc_id() { return (unsigned)__builtin_amdgcn_s_getreg((3 << 11) | 20) & 0xFu; }
#define XB_SPIN(cond, bar) do { unsigned _sp = 0; while (cond) { __builtin_amdgcn_s_sleep(1); \
    if ((++_sp & 255u) == 0u) { if (xb_ld(&(bar)[XB_TMO])) break; if (_sp > XB_SPIN_CAP) { atomicAdd(&(bar)[XB_TMO], 1u); break; } } } } while (0)
struct XcdBarrier { unsigned* bar; unsigned x; volatile LAS unsigned* st; };
__device__ __forceinline__ XcdBarrier xcd_barrier_post(unsigned* bar, volatile LAS unsigned* st) {
    XcdBarrier b; b.bar = bar; b.x = xb_xcc_id(); b.st = st;
    if (threadIdx.x == 0) (void)xb_add(&bar[XB_XCNT(b.x)], 1u);
    return b;
}
__device__ __forceinline__ void xcd_barrier_complete(unsigned* bar, unsigned x, unsigned& nloc, unsigned& nx) {
    const unsigned G = gridDim.x * gridDim.y * gridDim.z;
    unsigned sum, cnt, mine, sp = 0u;
    for (;;) {
        sum = 0u; cnt = 0u; mine = 0u;
#pragma unroll
        for (unsigned j = 0; j < 16; ++j) { const unsigned c = xb_ld(&bar[XB_XCNT(j)]); sum += c; cnt += (c > 0u) ? 1u : 0u; mine = (j == x) ? c : mine; }
        if (sum == G) break;
        __builtin_amdgcn_s_sleep(1);
        if ((++sp & 255u) == 0u) { if (xb_ld(&bar[XB_TMO])) break; if (sp > XB_SPIN_CAP) { atomicAdd(&bar[XB_TMO], 1u); break; } }
    }
    nloc = mine > 0u ? mine : 1u; nx = cnt > 0u ? cnt : 1u;
}
__device__ __forceinline__ void xcd_barrier(const XcdBarrier& b) {
    asm volatile("s_waitcnt vmcnt(0)" ::: "memory");
    __syncthreads();
    if (threadIdx.x == 0) {
        unsigned* bar = b.bar;
        __builtin_amdgcn_s_waitcnt(0);
        unsigned nloc = b.st[0], nx = b.st[1];
        if (nloc == 0u) { xcd_barrier_complete(bar, b.x, nloc, nx); b.st[0] = nloc; b.st[1] = nx; }
        const unsigned old = xb_add(&bar[XB_XSUB(b.x)], 1u);
        const unsigned gen = old / nloc;
        if (old + 1u == (gen + 1u) * nloc) {
            __builtin_amdgcn_fence(__ATOMIC_RELEASE, "agent");
            asm volatile("s_waitcnt vmcnt(0)" ::: "memory");
            const unsigned og = xb_add(&bar[XB_TOP], 1u);
            const unsigned tg = og / nx;
            if (og + 1u == (tg + 1u) * nx) xb_add(&bar[XB_TOPGEN], 1u);
            else XB_SPIN(xb_ld(&bar[XB_TOPGEN]) == tg, bar);
            __builtin_amdgcn_fence(__ATOMIC_ACQUIRE, "agent");
            xb_add(&bar[XB_XGEN(b.x)], 1u);
            asm volatile("s_waitcnt vmcnt(0)" ::: "memory");
        } else {
            XB_SPIN(xb_ld(&bar[XB_XGEN(b.x)]) == gen, bar);
            __builtin_amdgcn_fence(__ATOMIC_ACQUIRE, "agent");
            asm volatile("s_waitcnt vmcnt(0)" ::: "memory");
        }
    }
    __syncthreads();
}

__device__ __forceinline__ void transpose_item(const float* __restrict__ W, int K, int N, bf16_t* __restrict__ WT, int ldt, const float* __restrict__ kscale, LAS float* scr, int item, int lane) {
    const int nblk = N / 32, kb = item / nblk, nb = item % nblk, k0 = 64 * kb, n0 = 32 * nb;
#pragma unroll 8
    for (int i = 0; i < 32; ++i) { const int kk = 2 * i + (lane >> 5); const float s = kscale ? kscale[k0 + kk] : 1.f; scr[kk * 33 + (lane & 31)] = W[(size_t)(k0 + kk) * N + n0 + (lane & 31)] * s; }
    asm volatile("s_waitcnt lgkmcnt(0)" ::: "memory");
    const int c = lane & 7;
#pragma unroll
    for (int j = 0; j < 4; ++j) { const int n = (lane >> 3) + 8 * j; const LAS float* s = scr + (8 * c) * 33 + n;
        u32x4 o; o.x = pk2(s[0 * 33], s[1 * 33]); o.y = pk2(s[2 * 33], s[3 * 33]); o.z = pk2(s[4 * 33], s[5 * 33]); o.w = pk2(s[6 * 33], s[7 * 33]);
        *(u32x4*)(WT + (size_t)(n0 + n) * ldt + k0 + 8 * c) = o; }
    asm volatile("s_waitcnt lgkmcnt(0)" ::: "memory");
}
__device__ __forceinline__ void rownorm_row(const float* __restrict__ x, bf16_t* __restrict__ xb, float* __restrict__ rs, int row, int lane) {
    const f32x4* xr = (const f32x4*)(x + (size_t)row * 1024) + lane;
    f32x4 v[4]; float s = 0.f;
#pragma unroll
    for (int j = 0; j < 4; ++j) { v[j] = xr[64 * j]; s += (v[j].x * v[j].x + v[j].y * v[j].y) + (v[j].z * v[j].z + v[j].w * v[j].w); }
    s = wave_sum(s);
    u32x2* o = (u32x2*)(xb + (size_t)row * 1024) + lane;
#pragma unroll
    for (int j = 0; j < 4; ++j) o[64 * j] = (u32x2){pk2(v[j].x, v[j].y), pk2(v[j].z, v[j].w)};
    if (lane == 0) rs[row] = 1.0f / sqrtf(s * (1.f / 1024.f) + EPS);
}
__device__ __forceinline__ void final_norm_row(float* __restrict__ x, const float* __restrict__ g, int row, int lane) {
    f32x4* xr = (f32x4*)(x + (size_t)row * 1024) + lane; const f32x4* gr = (const f32x4*)g + lane;
    f32x4 v[4]; float s = 0.f;
#pragma unroll
    for (int j = 0; j < 4; ++j) { v[j] = xr[64 * j]; s += (v[j].x * v[j].x + v[j].y * v[j].y) + (v[j].z * v[j].z + v[j].w * v[j].w); }
    s = wave_sum(s); const float r = 1.0f / sqrtf(s * (1.f / 1024.f) + EPS);
#pragma unroll
    for (int j = 0; j < 4; ++j) xr[64 * j] = v[j] * r * gr[64 * j];
}

struct EpiA1 {
    const float* rs; bf16_t *U, *ZS, *Q, *Kb, *V, *ZA, *QM, *ZM;
    __device__ __forceinline__ void operator()(int m, int n, f32x4 v) const {
        v = v * rs[m]; bf16_t* dst; bool silu = false; float sc = 1.f;
        if (n < 768) dst = U + (size_t)m * 768 + n;
        else if (n < 1536) { dst = ZS + (size_t)m * 768 + (n - 768); silu = true; }
        else if (n < 2304) { dst = Q + (size_t)m * 768 + (n - 1536); sc = 0.125f; }
        else if (n < 3072) dst = Kb + (size_t)m * 768 + (n - 2304);
        else if (n < 3840) dst = V + (size_t)m * 768 + (n - 3072);
        else if (n < 4608) { dst = ZA + (size_t)m * 768 + (n - 3840); silu = true; }
        else if (n < 5120) { dst = QM + (size_t)m * 512 + (n - 4608); sc = 0.08838834764831845f; }
        else { dst = ZM + (size_t)m * 512 + (n - 5120); silu = true; }
        if (silu) { v.x = siluf_(v.x); v.y = siluf_(v.y); v.z = siluf_(v.z); v.w = siluf_(v.w); }
        v = v * sc;
        *(u32x2*)dst = (u32x2){pk2(v.x, v.y), pk2(v.z, v.w)};
    }
};
struct EpiKvm {
    const float* rs; bf16_t* O;
    __device__ __forceinline__ void operator()(int m, int n, f32x4 v) const { v = v * rs[m]; *(u32x2*)(O + (size_t)m * 1024 + n) = (u32x2){pk2(v.x, v.y), pk2(v.z, v.w)}; }
};
struct EpiGlu {
    const bf16_t* Y; bf16_t* ZS; const float* b;
    __device__ __forceinline__ void operator()(int m, int n, f32x4 v) const {
        const u32x2 y = *(const u32x2*)(Y + (size_t)m * 768 + n); u32x2* zp = (u32x2*)(ZS + (size_t)m * 768 + n); const u32x2 z = *zp; const f32x4 bb = *(const f32x4*)(b + n);
        const float o0 = bflo(y.x) * sigmoidf_(v.x + bb.x) * bflo(z.x), o1 = bfhi(y.x) * sigmoidf_(v.y + bb.y) * bfhi(z.x);
        const float o2 = bflo(y.y) * sigmoidf_(v.z + bb.z) * bflo(z.y), o3 = bfhi(y.y) * sigmoidf_(v.w + bb.w) * bfhi(z.y);
        *zp = (u32x2){pk2(o0, o1), pk2(o2, o3)};
    }
};
struct EpiOut {
    const float* xold; float* xnew;
    __device__ __forceinline__ void operator()(int m, int n, f32x4 v) const { const size_t o = (size_t)m * 1024 + n; *(f32x4*)(xnew + o) = *(const f32x4*)(xold + o) + v; }
};
template <class Epi>
__device__ __forceinline__ void wgemm(const bf16_t* __restrict__ A, int lda, const bf16_t* __restrict__ Bt, int ldb, int M, int N, int K, const Epi& epi, int gw, int ngw, int lane) {
    const int r = lane & 31, hi = lane >> 5; const int ntn = N / 64, ntiles = (M / 64) * ntn;
    for (int tile = gw; tile < ntiles; tile += ngw) {
        const int m0 = (tile / ntn) * 64, n0 = (tile % ntn) * 64;
        f32x16 acc[2][2];
#pragma unroll
        for (int i = 0; i < 2; ++i)
#pragma unroll
            for (int j = 0; j < 2; ++j)
#pragma unroll
                for (int q = 0; q < 16; ++q) acc[i][j][q] = 0.f;
        const bf16_t* ap = A + (size_t)(m0 + r) * lda + 8 * hi;
        const bf16_t* bp = Bt + (size_t)(n0 + r) * ldb + 8 * hi;
        for (int k = 0; k < K; k += 16) {
            const bf16x8 a0 = *(const bf16x8*)(ap + k), a1 = *(const bf16x8*)(ap + (size_t)32 * lda + k);
            const bf16x8 b0 = *(const bf16x8*)(bp + k), b1 = *(const bf16x8*)(bp + (size_t)32 * ldb + k);
            acc[0][0] = __builtin_amdgcn_mfma_f32_32x32x16_bf16(b0, a0, acc[0][0], 0, 0, 0);
            acc[0][1] = __builtin_amdgcn_mfma_f32_32x32x16_bf16(b1, a0, acc[0][1], 0, 0, 0);
            acc[1][0] = __builtin_amdgcn_mfma_f32_32x32x16_bf16(b0, a1, acc[1][0], 0, 0, 0);
            acc[1][1] = __builtin_amdgcn_mfma_f32_32x32x16_bf16(b1, a1, acc[1][1], 0, 0, 0);
        }
#pragma unroll
        for (int mi = 0; mi < 2; ++mi)
#pragma unroll
            for (int ni = 0; ni < 2; ++ni)
#pragma unroll
                for (int q = 0; q < 4; ++q)
                    epi(m0 + 32 * mi + r, n0 + 32 * ni + 8 * q + 4 * hi, (f32x4){acc[mi][ni][4 * q], acc[mi][ni][4 * q + 1], acc[mi][ni][4 * q + 2], acc[mi][ni][4 * q + 3]});
    }
}
__device__ __forceinline__ void merge_ref(const bf16_t* __restrict__ XB, const float* __restrict__ rs, const bf16_t* __restrict__ WinT, const float* __restrict__ bg,
                                          const bf16_t* __restrict__ OS, const bf16_t* __restrict__ OA, const bf16_t* __restrict__ OM,
                                          const bf16_t* __restrict__ W1, const bf16_t* __restrict__ W2, const bf16_t* __restrict__ W3, bf16_t* __restrict__ MG, int gw, int ngw, int lane) {
    const int r = lane & 31, hi = lane >> 5;
    for (int tile = gw; tile < (T / 32) * 32; tile += ngw) {
        const int m0 = (tile >> 5) * 32, n0 = (tile & 31) * 32;
        f32x16 L0, L1, L2, P0, P1, P2;
#pragma unroll
        for (int q = 0; q < 16; ++q) { L0[q] = 0.f; L1[q] = 0.f; L2[q] = 0.f; P0[q] = 0.f; P1[q] = 0.f; P2[q] = 0.f; }
        {
            const bf16_t* ap = XB + (size_t)(m0 + r) * 1024 + 8 * hi; const bf16_t* bp = WinT + (size_t)(N_A1 + n0 + r) * 1024 + 8 * hi;
            for (int k = 0; k < 1024; k += 16) {
                const bf16x8 a = *(const bf16x8*)(ap + k);
                L0 = __builtin_amdgcn_mfma_f32_32x32x16_bf16(*(const bf16x8*)(bp + k), a, L0, 0, 0, 0);
                L1 = __builtin_amdgcn_mfma_f32_32x32x16_bf16(*(const bf16x8*)(bp + (size_t)1024 * 1024 + k), a, L1, 0, 0, 0);
                L2 = __builtin_amdgcn_mfma_f32_32x32x16_bf16(*(const bf16x8*)(bp + (size_t)2048 * 1024 + k), a, L2, 0, 0, 0);
            }
        }
        {
            const bf16_t* ap = OS + (size_t)(m0 + r) * 768 + 8 * hi; const bf16_t* bp = W1 + (size_t)(n0 + r) * 768 + 8 * hi;
            for (int k = 0; k < 768; k += 16) P0 = __builtin_amdgcn_mfma_f32_32x32x16_bf16(*(const bf16x8*)(bp + k), *(const bf16x8*)(ap + k), P0, 0, 0, 0);
        }
        {
            const bf16_t* ap = OA + (size_t)(m0 + r) * 768 + 8 * hi; const bf16_t* bp = W2 + (size_t)(n0 + r) * 768 + 8 * hi;
            for (int k = 0; k < 768; k += 16) P1 = __builtin_amdgcn_mfma_f32_32x32x16_bf16(*(const bf16x8*)(bp + k), *(const bf16x8*)(ap + k), P1, 0, 0, 0);
        }
        {
            const bf16_t* ap = OM + (size_t)(m0 + r) * 512 + 8 * hi; const bf16_t* bp = W3 + (size_t)(n0 + r) * 512 + 8 * hi;
            for (int k = 0; k < 512; k += 16) P2 = __builtin_amdgcn_mfma_f32_32x32x16_bf16(*(const bf16x8*)(bp + k), *(const bf16x8*)(ap + k), P2, 0, 0, 0);
        }
        const int m = m0 + r; const float rsm = rs[m];
#pragma unroll
        for (int q = 0; q < 4; ++q) {
            const int n = n0 + 8 * q + 4 * hi; float o[4];
#pragma unroll
            for (int e = 0; e < 4; ++e) {
                const int rg = 4 * q + e;
                const float g0 = sigmoidf_(rsm * L0[rg] + bg[n + e]), g1 = sigmoidf_(rsm * L1[rg] + bg[1024 + n + e]), g2 = sigmoidf_(rsm * L2[rg] + bg[2048 + n + e]);
                o[e] = g0 * P0[rg] + g1 * P1[rg] + g2 * P2[rg];
            }
            *(u32x2*)(MG + (size_t)m * 1024 + n) = (u32x2){pk2(o[0], o[1]), pk2(o[2], o[3])};
        }
    }
}

__device__ __forceinline__ void ssm_ref(int b, int g, int lane, LAS float* xs, const bf16_t* __restrict__ U, bf16_t* __restrict__ Y, const float* __restrict__ lam_re, const float* __restrict__ lam_im,
                                        const float* __restrict__ log_dt, const float* __restrict__ b_re, const float* __restrict__ b_im,
                                        const float* __restrict__ c_re, const float* __restrict__ c_im, const float* __restrict__ dvec) {
    const float dt = expf(log_dt[g]); const float lre = lam_re[g * 64 + lane], lim = lam_im[g * 64 + lane];
    const float mag = expf(lre * dt); const float ar = mag * cosf(lim * dt), ai = mag * sinf(lim * dt);
    const float den = lre * lre + lim * lim, nr = ar - 1.0f, ni = ai;
    const float fr = (nr * lre + ni * lim) / den, fi = (ni * lre - nr * lim) / den;
    float bbr[16], bbi[16];
#pragma unroll
    for (int h = 0; h < 16; ++h) { const float br = b_re[(g * 64 + lane) * 16 + h], bi = b_im[(g * 64 + lane) * 16 + h]; bbr[h] = fr * br - fi * bi; bbi[h] = fr * bi + fi * br; }
    const int hq = lane & 15, part = lane >> 4;
    float cr[16], ci[16];
#pragma unroll
    for (int i = 0; i < 16; ++i) { cr[i] = c_re[(g * 16 + hq) * 64 + part * 16 + i]; ci[i] = c_im[(g * 16 + hq) * 64 + part * 16 + i]; }
    const float dd = dvec[g * 16 + hq];
    float xr = 0.f, xi = 0.f;
    const bf16_t* up = U + (size_t)b * SEQ * 768 + g * 16; bf16_t* yp = Y + (size_t)b * SEQ * 768 + g * 16;
    for (int t = 0; t < SEQ; ++t) {
        const u32x4 ua = *(const u32x4*)(up + (size_t)t * 768), ub = *(const u32x4*)(up + (size_t)t * 768 + 8);
        const float uh = bf2f(up[(size_t)t * 768 + hq]);
        float u[16];
        u[0] = bflo(ua.x); u[1] = bfhi(ua.x); u[2] = bflo(ua.y); u[3] = bfhi(ua.y); u[4] = bflo(ua.z); u[5] = bfhi(ua.z); u[6] = bflo(ua.w); u[7] = bfhi(ua.w);
        u[8] = bflo(ub.x); u[9] = bfhi(ub.x); u[10] = bflo(ub.y); u[11] = bfhi(ub.y); u[12] = bflo(ub.z); u[13] = bfhi(ub.z); u[14] = bflo(ub.w); u[15] = bfhi(ub.w);
        float bur = 0.f, bui = 0.f;
#pragma unroll
        for (int h = 0; h < 16; ++h) { bur += bbr[h] * u[h]; bui += bbi[h] * u[h]; }
        const float nxr = ar * xr - ai * xi + bur, nxi = ar * xi + ai * xr + bui; xr = nxr; xi = nxi;
        xs[lane] = xr; xs[64 + lane] = xi;
        asm volatile("s_waitcnt lgkmcnt(0)" ::: "memory");
        float acc = 0.f;
#pragma unroll
        for (int i = 0; i < 16; ++i) acc += cr[i] * xs[part * 16 + i] - ci[i] * xs[64 + part * 16 + i];
        acc += __shfl_xor(acc, 16); acc += __shfl_xor(acc, 32);
        asm volatile("s_waitcnt lgkmcnt(0)" ::: "memory");
        if (lane < 16) yp[(size_t)t * 768 + lane] = (bf16_t)f2bf(gelu_tanh(acc + dd * uh));
    }
}

__device__ __forceinline__ int rel_bucket(int n) {
    if (n < 16) return n;
    const float v = logf((float)n / 16.0f) / 4.852030263919617f * 16.0f;
    const int lg = 16 + (int)v; return lg < 31 ? lg : 31;
}
__device__ __forceinline__ float dot8(const u32x4 a, const u32x4 b) {
    return bflo(a.x) * bflo(b.x) + bfhi(a.x) * bfhi(b.x) + bflo(a.y) * bflo(b.y) + bfhi(a.y) * bfhi(b.y) + bflo(a.z) * bflo(b.z) + bfhi(a.z) * bfhi(b.z) + bflo(a.w) * bflo(b.w) + bfhi(a.w) * bfhi(b.w);
}
__device__ __forceinline__ void attn_ref(bf16_t* Q, const bf16_t* __restrict__ Kb, const bf16_t* __restrict__ V, const float* __restrict__ rel_bias, float* __restrict__ lse, int gw, int ngw, int lane) {
    for (int item = gw; item < T * NH; item += ngw) {
        const int head = item % NH, tok = item / NH, t = tok % SEQ, row0 = tok - t;
        const int grp = head >> 2, r = grp == 0 ? 1 : (grp == 1 ? 4 : 16);
        bf16_t* qp = Q + (size_t)tok * 768 + head * 64;
        u32x4 qv[8];
#pragma unroll
        for (int i = 0; i < 8; ++i) qv[i] = ((const u32x4*)qp)[i];
        float s[3]; bool ok[3];
#pragma unroll
        for (int sl = 0; sl < 3; ++sl) {
            const int j = sl * 64 + lane, p = t - j * r; ok[sl] = (j <= 128) && (p >= 0); s[sl] = -1e30f;
            if (ok[sl]) {
                const u32x4* kp = (const u32x4*)(Kb + (size_t)(row0 + p) * 768 + head * 64); float d = 0.f;
#pragma unroll
                for (int i = 0; i < 8; ++i) d += dot8(qv[i], kp[i]);
                s[sl] = d + rel_bias[rel_bucket(j * r) * NH + head];
            }
        }
        const float m = wave_max(fmaxf(fmaxf(s[0], s[1]), s[2]));
        float e[3];
#pragma unroll
        for (int sl = 0; sl < 3; ++sl) e[sl] = ok[sl] ? __expf(s[sl] - m) : 0.f;
        const float l = wave_sum(e[0] + e[1] + e[2]);
        float o = 0.f;
#pragma unroll
        for (int sl = 0; sl < 3; ++sl) {
            for (int jj = 0; jj < 64; ++jj) {
                const int j = sl * 64 + jj, p = t - j * r; if (j > 128 || p < 0) break;
                const float pj = __shfl(e[sl], jj);
                o += pj * bf2f(V[(size_t)(row0 + p) * 768 + head * 64 + lane]);
            }
        }
        qp[lane] = (bf16_t)f2bf(o / l);
        if (lane == 0) lse[(size_t)tok * NH + head] = m + logf(l);
    }
}
__device__ __forceinline__ void attn_final_tok(bf16_t* __restrict__ Q, const float* __restrict__ lse, const bf16_t* __restrict__ ZA, int tok, int lane) {
    const float* lp = lse + (size_t)tok * NH;
    for (int c = lane * 4; c < 768; c += 256) {
        const int head = c >> 6, hh = head & 3; const float l0 = lp[hh], l1 = lp[4 + hh], l2 = lp[8 + hh];
        const float mx = fmaxf(fmaxf(l0, l1), l2); const float e0 = __expf(l0 - mx), e1 = __expf(l1 - mx), e2 = __expf(l2 - mx);
        const float mine = head < 4 ? e0 : (head < 8 ? e1 : e2); const float al = mine / (e0 + e1 + e2);
        u32x2* qp = (u32x2*)(Q + (size_t)tok * 768 + c); const u32x2 o = *qp; const u32x2 z = *(const u32x2*)(ZA + (size_t)tok * 768 + c);
        *qp = (u32x2){pk2(bflo(o.x) * al * bflo(z.x), bfhi(o.x) * al * bfhi(z.x)), pk2(bflo(o.y) * al * bflo(z.y), bfhi(o.y) * al * bfhi(z.y))};
    }
}
__device__ __forceinline__ void memattn_ref(bf16_t* QM, const bf16_t* __restrict__ KVM, const bf16_t* __restrict__ ZM, int gw, int ngw, int lane) {
    for (int item = gw; item < T * MH; item += ngw) {
        const int head = item & 3, tok = item >> 2, b = tok / SEQ;
        bf16_t* qp = QM + (size_t)tok * 512 + head * 128;
        u32x4 qv[16];
#pragma unroll
        for (int i = 0; i < 16; ++i) qv[i] = ((const u32x4*)qp)[i];
        float s[4];
#pragma unroll
        for (int sl = 0; sl < 4; ++sl) {
            const int j = sl * 64 + lane; const u32x4* kp = (const u32x4*)(KVM + (size_t)(b * 256 + j) * 1024 + head * 128); float d = 0.f;
#pragma unroll
            for (int i = 0; i < 16; ++i) d += dot8(qv[i], kp[i]);
            s[sl] = d;
        }
        const float m = wave_max(fmaxf(fmaxf(s[0], s[1]), fmaxf(s[2], s[3])));
        float e[4];
#pragma unroll
        for (int sl = 0; sl < 4; ++sl) e[sl] = __expf(s[sl] - m);
        const float l = wave_sum((e[0] + e[1]) + (e[2] + e[3]));
        float o0 = 0.f, o1 = 0.f;
#pragma unroll
        for (int sl = 0; sl < 4; ++sl)
            for (int jj = 0; jj < 64; ++jj) {
                const int j = sl * 64 + jj; const float pj = __shfl(e[sl], jj);
                const bf16_t* vp = KVM + (size_t)(b * 256 + j) * 1024 + 512 + head * 128;
                o0 += pj * bf2f(vp[lane]); o1 += pj * bf2f(vp[64 + lane]);
            }
        const bf16_t* zp = ZM + (size_t)tok * 512 + head * 128;
        qp[lane] = (bf16_t)f2bf(o0 / l * bf2f(zp[lane])); qp[64 + lane] = (bf16_t)f2bf(o1 / l * bf2f(zp[64 + lane]));
    }
}

struct Args { const float* in[23]; float* out; unsigned char* ws; int ph_lo, ph_hi; };
__global__ void __launch_bounds__(NTHREADS, 2) mega_fwd(Args args) {
    extern __shared__ __attribute__((aligned(16))) unsigned char lds_raw[];
    LAS unsigned char* lds = (LAS unsigned char*)lds_raw;
    const int tid = threadIdx.x, lane = tid & 63, wave = __builtin_amdgcn_readfirstlane(tid >> 6);
    const int G_ = gridDim.x, gw = blockIdx.x * NWAVES + wave, ngw = G_ * NWAVES;
    unsigned char* ws = args.ws;
    for (int u = tid; u < (LDS_BYTES - LDSCTL_OFF) / 4; u += NTHREADS) ((LAS unsigned*)(lds + LDSCTL_OFF))[u] = 0u;
    __syncthreads();
    XcdBarrier bar = xcd_barrier_post((unsigned*)ws + CW_BAR, (volatile LAS unsigned*)(lds + MISC_OFF) + 8);
    const float* x = args.in[0]; const float* mem = args.in[1]; const float* norm_g = args.in[2]; const float* mem_norm_g = args.in[3];
    const float* w_in = args.in[4]; const float* b_gate = args.in[5];
    const float* lam_re = args.in[6]; const float* lam_im = args.in[7]; const float* log_dt = args.in[8];
    const float* b_re = args.in[9]; const float* b_im = args.in[10]; const float* c_re = args.in[11]; const float* c_im = args.in[12];
    const float* ssm_d = args.in[13]; const float* w_glu = args.in[14]; const float* b_glu = args.in[15]; const float* w_mem_kv = args.in[16];
    const float* w_br_ssm = args.in[17]; const float* w_br_attn = args.in[18]; const float* w_br_mem = args.in[19]; const float* w_out = args.in[20];
    const float* rel_bias = args.in[21]; const float* final_g = args.in[22];
    float* out = args.out;
    float* rs = (float*)(ws + OFF_RS); float* rs_mem = (float*)(ws + OFF_RSMEM); float* lse = (float*)(ws + OFF_LSE);
    bf16_t* XB = (bf16_t*)(ws + OFF_XB); bf16_t* U = (bf16_t*)(ws + OFF_U); bf16_t* ZM = (bf16_t*)(ws + OFF_ZM); bf16_t* ZS = (bf16_t*)(ws + OFF_ZS); bf16_t* Q = (bf16_t*)(ws + OFF_Q);
    bf16_t* Kb = (bf16_t*)(ws + OFF_K); bf16_t* V = (bf16_t*)(ws + OFF_V); bf16_t* ZA = (bf16_t*)(ws + OFF_ZA); bf16_t* QM = (bf16_t*)(ws + OFF_QM);
    bf16_t* Y = (bf16_t*)(ws + OFF_Y); bf16_t* MG = (bf16_t*)(ws + OFF_MERGED); bf16_t* MEMB = (bf16_t*)(ws + OFF_MEMB);
#define WL(l, o) ((bf16_t*)(ws + OFF_W + (size_t)(l) * W_STRIDE + (o)))
#define GRID_BAR() xcd_barrier(bar)
    {
        LAS float* scr = (LAS float*)(lds + wave * 16384);
        for (int l = 0; l < DEPTH; ++l) {
            constexpr int I_IN = (1024 / 64) * (D_IN / 32), I_GLU = (768 / 64) * (768 / 32), I_B12 = (768 / 64) * (1024 / 32), I_B3 = (512 / 64) * (1024 / 32), I_SQ = (1024 / 64) * (1024 / 32);
            constexpr int NIT = I_IN + I_GLU + 2 * I_B12 + I_B3 + 2 * I_SQ;
            for (int it = gw; it < NIT; it += ngw) {
                int r = it;
                if (r < I_IN) { transpose_item(w_in + (size_t)l * 1024 * D_IN, 1024, D_IN, WL(l, WO_IN), 1024, norm_g + l * 1024, scr, r, lane); continue; } r -= I_IN;
                if (r < I_GLU) { transpose_item(w_glu + (size_t)l * 768 * 768, 768, 768, WL(l, WO_GLU), 768, nullptr, scr, r, lane); continue; } r -= I_GLU;
                if (r < I_B12) { transpose_item(w_br_ssm + (size_t)l * 768 * 1024, 768, 1024, WL(l, WO_B1), 768, nullptr, scr, r, lane); continue; } r -= I_B12;
                if (r < I_B12) { transpose_item(w_br_attn + (size_t)l * 768 * 1024, 768, 1024, WL(l, WO_B2), 768, nullptr, scr, r, lane); continue; } r -= I_B12;
                if (r < I_B3) { transpose_item(w_br_mem + (size_t)l * 512 * 1024, 512, 1024, WL(l, WO_B3), 512, nullptr, scr, r, lane); continue; } r -= I_B3;
                if (r < I_SQ) { transpose_item(w_out + (size_t)l * 1024 * 1024, 1024, 1024, WL(l, WO_OUT), 1024, nullptr, scr, r, lane); continue; } r -= I_SQ;
                transpose_item(w_mem_kv + (size_t)l * 1024 * 1024, 1024, 1024, WL(l, WO_MKV), 1024, mem_norm_g + l * 1024, scr, r, lane);
            }
        }
        for (int m = gw; m < T; m += ngw) rownorm_row(x, XB, rs, m, lane);
        for (int m = gw; m < BATCH * MEM_LEN; m += ngw) rownorm_row(mem, MEMB, rs_mem, m, lane);
    }
    GRID_BAR();
    for (int l = 0; l < DEPTH; ++l) {
        bf16_t* KVM = (bf16_t*)(ws + OFF_KVM + (size_t)l * 2 * MiB);
        wgemm(MEMB, 1024, WL(l, WO_MKV), 1024, 1024, 1024, 1024, EpiKvm{rs_mem, KVM}, gw, ngw, lane);
        wgemm(XB, 1024, WL(l, WO_IN), 1024, T, N_A1, 1024, EpiA1{rs, U, ZS, Q, Kb, V, ZA, QM, ZM}, gw, ngw, lane);
        GRID_BAR();
        attn_ref(Q, Kb, V, rel_bias, lse, gw, ngw, lane);
        memattn_ref(QM, KVM, ZM, gw, ngw, lane);
        GRID_BAR();
        if (gw < BATCH * NG)
            ssm_ref(gw / NG, gw % NG, lane, (LAS float*)(lds + wave * 16384), U, Y, lam_re + l * NG * NP, lam_im + l * NG * NP, log_dt + l * NG, b_re + (size_t)l * NG * NP * HG, b_im + (size_t)l * NG * NP * HG,
                    c_re + (size_t)l * NG * HG * NP, c_im + (size_t)l * NG * HG * NP, ssm_d + l * D_SSM);
        else
            for (int tok = gw - BATCH * NG; tok < T; tok += ngw - BATCH * NG) attn_final_tok(Q, lse, ZA, tok, lane);
        GRID_BAR();
        wgemm(Y, 768, WL(l, WO_GLU), 768, T, 768, 768, EpiGlu{Y, ZS, b_glu + l * 768}, gw, ngw, lane);
        GRID_BAR();
        merge_ref(XB, rs, WL(l, WO_IN), b_gate + l * 3072, ZS, Q, QM, WL(l, WO_B1), WL(l, WO_B2), WL(l, WO_B3), MG, gw, ngw, lane);
        GRID_BAR();
        wgemm(MG, 1024, WL(l, WO_OUT), 1024, T, 1024, 1024, EpiOut{l == 0 ? x : out, out}, gw, ngw, lane);
        GRID_BAR();
        if (l + 1 < DEPTH) { for (int m = gw; m < T; m += ngw) rownorm_row(out, XB, rs, m, lane); GRID_BAR(); }
        else { for (int m = gw; m < T; m += ngw) final_norm_row(out, final_g, m, lane); }
    }
}

extern "C" void kernel_launch(void* const* d_in, const int* in_sizes, int n_in, void* d_out, int out_size, void* d_ws, size_t ws_size, hipStream_t stream) {
    static int grid = 0;
    if (grid == 0) {
        if (n_in != 23 || ws_size < WS_NEED || out_size != T * D_MODEL) { fprintf(stderr, "kernel_launch: unexpected shapes (n_in %d, ws %zu, out %d)\n", n_in, ws_size, out_size); grid = -1; return; }
        int dev = 0, cus = 0, per_cu = 0;
        if (hipGetDevice(&dev) != hipSuccess || hipDeviceGetAttribute(&cus, hipDeviceAttributeMultiprocessorCount, dev) != hipSuccess) { grid = -1; return; }
        if (hipFuncSetAttribute((const void*)mega_fwd, hipFuncAttributeMaxDynamicSharedMemorySize, LDS_BYTES) != hipSuccess) { fprintf(stderr, "kernel_launch: hipFuncSetAttribute failed\n"); grid = -1; return; }
        if (hipOccupancyMaxActiveBlocksPerMultiprocessor(&per_cu, (const void*)mega_fwd, NTHREADS, LDS_BYTES) != hipSuccess || per_cu < 1) { fprintf(stderr, "kernel_launch: occupancy query says %d blocks/CU\n", per_cu); per_cu = 1; }
        (void)hipGetLastError();
        grid = cus * 1;
    }
    if (grid < 0) return;
    (void)hipMemsetAsync(d_ws, 0, CTL_ZERO_BYTES, stream);
    Args a{};
    for (int i = 0; i < 23; ++i) a.in[i] = (const float*)d_in[i];
    a.out = (float*)d_out; a.ws = (unsigned char*)d_ws; a.ph_lo = 0; a.ph_hi = 0;
    hipLaunchKernelGGL(mega_fwd, dim3(grid), dim3(NTHREADS), LDS_BYTES, stream, a);
}
```

```cpp
#include <hip/hip_runtime.h>
#include <cstdint>
#include <cstdio>

typedef unsigned short bf16_t;
typedef short bf16x8 __attribute__((ext_vector_type(8)));
typedef float f32x4 __attribute__((ext_vector_type(4)));
typedef float f32x16 __attribute__((ext_vector_type(16)));
typedef unsigned u32x4 __attribute__((ext_vector_type(4)));
typedef unsigned u32x2 __attribute__((ext_vector_type(2)));

constexpr int D_MODEL = 1024, BATCH = 4, SEQ = 8192, DEPTH = 2, T = BATCH * SEQ;
constexpr int D_SSM = 768, NG = 48, HG = 16, NP = 64;
constexpr int NH = 12, HD = 64, D_ATTN = 768;
constexpr int MEM_LEN = 256, MH = 4, MHD = 128, D_MEM = 512;
constexpr int D_IN = 8704, N_A1 = 5632;
constexpr float EPS = 1e-6f;

constexpr size_t MiB = 1u << 20;
constexpr size_t OFF_RS = 1 * MiB, OFF_RSMEM = 1 * MiB + 256 * 1024, OFF_LSE = 2 * MiB;
constexpr size_t OFF_W = 4 * MiB, W_STRIDE = 27 * MiB;
constexpr size_t WO_IN = 0, WO_GLU = 17 * MiB, WO_B1 = WO_GLU + 1179648, WO_B2 = WO_B1 + 1572864, WO_B3 = WO_B2 + 1572864, WO_OUT = WO_B3 + 1048576, WO_MKV = WO_OUT + 2 * MiB;
static_assert(WO_MKV + 2 * MiB <= W_STRIDE, "weights");
constexpr size_t OFF_KVM = 58 * MiB, OFF_MEMB = 62 * MiB, OFF_XB = 64 * MiB, OFF_U = 128 * MiB, OFF_ZM = 188 * MiB, OFF_ZS = 220 * MiB, OFF_Q = 268 * MiB,
                 OFF_K = 316 * MiB, OFF_V = 364 * MiB, OFF_ZA = 412 * MiB, OFF_QM = 460 * MiB, OFF_TAB = 492 * MiB, WS_NEED = 512 * MiB;
constexpr size_t OFF_Y = OFF_K, OFF_MERGED = OFF_U;

__device__ __forceinline__ unsigned f2bf(float f) { unsigned u = __builtin_bit_cast(unsigned, f); return (u + 0x7fffu + ((u >> 16) & 1u)) >> 16; }
__device__ __forceinline__ unsigned pk2(float lo, float hi) { return f2bf(lo) | (f2bf(hi) << 16); }
__device__ __forceinline__ float bflo(unsigned u) { return __builtin_bit_cast(float, u << 16); }
__device__ __forceinline__ float bfhi(unsigned u) { return __builtin_bit_cast(float, u & 0xffff0000u); }
__device__ __forceinline__ float bf2f(bf16_t h) { return __builtin_bit_cast(float, (unsigned)h << 16); }
__device__ __forceinline__ float sigmoidf_(float x) { return 1.f / (1.f + __expf(-x)); }
__device__ __forceinline__ float siluf_(float x) { return x * sigmoidf_(x); }
__device__ __forceinline__ float gelu_tanh(float y) { return 0.5f * y * (1.f + tanhf(0.7978845608028654f * (y + 0.044715f * y * y * y))); }
__device__ __forceinline__ float wave_sum(float v) {
#pragma unroll
    for (int o = 1; o < 64; o <<= 1) v += __shfl_xor(v, o);
    return v;
}
__device__ __forceinline__ float wave_max(float v) {
#pragma unroll
    for (int o = 1; o < 64; o <<= 1) v = fmaxf(v, __shfl_xor(v, o));
    return v;
}

#define GAS __attribute__((address_space(1)))
#define LAS __attribute__((address_space(3)))
constexpr int NWAVES = 8, NTHREADS = 512;
constexpr int RING_BYTES = 131072, LDSCTL_OFF = RING_BYTES, MISC_OFF = LDSCTL_OFF + 320, LDS_BYTES = 147456;
constexpr size_t CTL_ZERO_BYTES = 1 * MiB; constexpr int CW_BAR = 4096;

#define XB_TMO      128
#define XB_XCNT(j)  (256  + 64 * (j))
#define XB_XSUB(j)  (1280 + 64 * (j))
#define XB_XGEN(j)  (2304 + 64 * (j))
#define XB_TOP      3328
#define XB_TOPGEN   3392
#define XCD_BAR_WORDS 3456
#define XB_SPIN_CAP (1u << 18)
__device__ __forceinline__ unsigned xb_ld(unsigned* p)              { return __hip_atomic_load(p, __ATOMIC_RELAXED, __HIP_MEMORY_SCOPE_AGENT); }
__device__ __forceinline__ unsigned xb_add(unsigned* p, unsigned v) { return __hip_atomic_fetch_add(p, v, __ATOMIC_RELAXED, __HIP_MEMORY_SCOPE_AGENT); }
__device__ __forceinline__ unsigned xb_xcc_id() { return (unsigned)__builtin_amdgcn_s_getreg((3 << 11) | 20) & 0xFu; }
#define XB_SPIN(cond, bar) do { unsigned _sp = 0; while (cond) { __builtin_amdgcn_s_sleep(1); \
    if ((++_sp & 255u) == 0u) { if (xb_ld(&(bar)[XB_TMO])) break; if (_sp > XB_SPIN_CAP) { atomicAdd(&(bar)[XB_TMO], 1u); break; } } } } while (0)
struct XcdBarrier { unsigned* bar; unsigned x; volatile LAS unsigned* st; };
__device__ __forceinline__ XcdBarrier xcd_barrier_post(unsigned* bar, volatile LAS unsigned* st) {
    XcdBarrier b; b.bar = bar; b.x = xb_xcc_id(); b.st = st;
    if (threadIdx.x == 0) (void)xb_add(&bar[XB_XCNT(b.x)], 1u);
    return b;
}
__device__ __forceinline__ void xcd_barrier_complete(unsigned* bar, unsigned x, unsigned& nloc, unsigned& nx) {
    const unsigned G = gridDim.x * gridDim.y * gridDim.z;
    unsigned sum, cnt, mine, sp = 0u;
    for (;;) {
        sum = 0u; cnt = 0u; mine = 0u;
#pragma unroll
        for (unsigned j = 0; j < 16; ++j) { const unsigned c = xb_ld(&bar[XB_XCNT(j)]); sum += c; cnt += (c > 0u) ? 1u : 0u; mine = (j == x) ? c : mine; }
        if (sum == G) break;
        __builtin_amdgcn_s_sleep(1);
        if ((++sp & 255u) == 0u) { if (xb_ld(&bar[XB_TMO])) break; if (sp > XB_SPIN_CAP) { atomicAdd(&bar[XB_TMO], 1u); break; } }
    }
    nloc = mine > 0u ? mine : 1u; nx = cnt > 0u ? cnt : 1u;
}
__device__ __forceinline__ void xcd_barrier(const XcdBarrier& b) {
    asm volatile("s_waitcnt vmcnt(0)" ::: "memory");
    __syncthreads();
    if (threadIdx.x == 0) {
        unsigned* bar = b.bar;
        __builtin_amdgcn_s_waitcnt(0);
        unsigned nloc = b.st[0], nx = b.st[1];
        if (nloc == 0u) { xcd_barrier_complete(bar, b.x, nloc, nx); b.st[0] = nloc; b.st[1] = nx; }
        const unsigned old = xb_add(&bar[XB_XSUB(b.x)], 1u);
        const unsigned gen = old / nloc;
        if (old + 1u == (gen + 1u) * nloc) {
            __builtin_amdgcn_fence(__ATOMIC_RELEASE, "agent");
            asm volatile("s_waitcnt vmcnt(0)" ::: "memory");
            const unsigned og = xb_add(&bar[XB_TOP], 1u);
            const unsigned tg = og / nx;
            if (og + 1u == (tg + 1u) * nx) xb_add(&bar[XB_TOPGEN], 1u);
            else XB_SPIN(xb_ld(&bar[XB_TOPGEN]) == tg, bar);
            __builtin_amdgcn_fence(__ATOMIC_ACQUIRE, "agent");
            xb_add(&bar[XB_XGEN(b.x)], 1u);
            asm volatile("s_waitcnt vmcnt(0)" ::: "memory");
        } else {
            XB_SPIN(xb_ld(&bar[XB_XGEN(b.x)]) == gen, bar);
            __builtin_amdgcn_fence(__ATOMIC_ACQUIRE, "agent");
            asm volatile("s_waitcnt vmcnt(0)" ::: "memory");
        }
    }
    __syncthreads();
}

__device__ __forceinline__ void transpose_item(const float* __restrict__ W, int K, int N, bf16_t* __restrict__ WT, int ldt, const float* __restrict__ kscale, LAS float* scr, int item, int lane) {
    const int nblk = N / 32, kb = item / nblk, nb = item % nblk, k0 = 64 * kb, n0 = 32 * nb;
#pragma unroll 8
    for (int i = 0; i < 32; ++i) { const int kk = 2 * i + (lane >> 5); const float s = kscale ? kscale[k0 + kk] : 1.f; scr[kk * 33 + (lane & 31)] = W[(size_t)(k0 + kk) * N + n0 + (lane & 31)] * s; }
    asm volatile("s_waitcnt lgkmcnt(0)" ::: "memory");
    const int c = lane & 7;
#pragma unroll
    for (int j = 0; j < 4; ++j) { const int n = (lane >> 3) + 8 * j; const LAS float* s = scr + (8 * c) * 33 + n;
        u32x4 o; o.x = pk2(s[0 * 33], s[1 * 33]); o.y = pk2(s[2 * 33], s[3 * 33]); o.z = pk2(s[4 * 33], s[5 * 33]); o.w = pk2(s[6 * 33], s[7 * 33]);
        *(u32x4*)(WT + (size_t)(n0 + n) * ldt + k0 + 8 * c) = o; }
    asm volatile("s_waitcnt lgkmcnt(0)" ::: "memory");
}
__device__ __forceinline__ void rownorm_row(const float* __restrict__ x, bf16_t* __restrict__ xb, float* __restrict__ rs, int row, int lane) {
    const f32x4* xr = (const f32x4*)(x + (size_t)row * 1024) + lane;
    f32x4 v[4]; float s = 0.f;
#pragma unroll
    for (int j = 0; j < 4; ++j) { v[j] = xr[64 * j]; s += (v[j].x * v[j].x + v[j].y * v[j].y) + (v[j].z * v[j].z + v[j].w * v[j].w); }
    s = wave_sum(s);
    u32x2* o = (u32x2*)(xb + (size_t)row * 1024) + lane;
#pragma unroll
    for (int j = 0; j < 4; ++j) o[64 * j] = (u32x2){pk2(v[j].x, v[j].y), pk2(v[j].z, v[j].w)};
    if (lane == 0) rs[row] = 1.0f / sqrtf(s * (1.f / 1024.f) + EPS);
}
__device__ __forceinline__ void final_norm_row(float* __restrict__ x, const float* __restrict__ g, int row, int lane) {
    f32x4* xr = (f32x4*)(x + (size_t)row * 1024) + lane; const f32x4* gr = (const f32x4*)g + lane;
    f32x4 v[4]; float s = 0.f;
#pragma unroll
    for (int j = 0; j < 4; ++j) { v[j] = xr[64 * j]; s += (v[j].x * v[j].x + v[j].y * v[j].y) + (v[j].z * v[j].z + v[j].w * v[j].w); }
    s = wave_sum(s); const float r = 1.0f / sqrtf(s * (1.f / 1024.f) + EPS);
#pragma unroll
    for (int j = 0; j < 4; ++j) xr[64 * j] = v[j] * r * gr[64 * j];
}

struct EpiA1 {
    const float* rs; bf16_t *U, *ZS, *Q, *Kb, *V, *ZA, *QM, *ZM;
    __device__ __forceinline__ void operator()(int m, int n, f32x4 v) const {
        v = v * rs[m]; bf16_t* dst; bool silu = false; float sc = 1.f;
        if (n < 768) dst = U + (size_t)m * 768 + n;
        else if (n < 1536) { dst = ZS + (size_t)m * 768 + (n - 768); silu = true; }
        else if (n < 2304) { dst = Q + (size_t)m * 768 + (n - 1536); sc = 0.125f; }
        else if (n < 3072) dst = Kb + (size_t)m * 768 + (n - 2304);
        else if (n < 3840) dst = V + (size_t)m * 768 + (n - 3072);
        else if (n < 4608) { dst = ZA + (size_t)m * 768 + (n - 3840); silu = true; }
        else if (n < 5120) { dst = QM + (size_t)m * 512 + (n - 4608); sc = 0.08838834764831845f; }
        else { dst = ZM + (size_t)m * 512 + (n - 5120); silu = true; }
        if (silu) { v.x = siluf_(v.x); v.y = siluf_(v.y); v.z = siluf_(v.z); v.w = siluf_(v.w); }
        v = v * sc;
        *(u32x2*)dst = (u32x2){pk2(v.x, v.y), pk2(v.z, v.w)};
    }
};
struct EpiKvm {
    const float* rs; bf16_t* O;
    __device__ __forceinline__ void operator()(int m, int n, f32x4 v) const { v = v * rs[m]; *(u32x2*)(O + (size_t)m * 1024 + n) = (u32x2){pk2(v.x, v.y), pk2(v.z, v.w)}; }
};
struct EpiGlu {
    const bf16_t* Y; bf16_t* ZS; const float* b;
    __device__ __forceinline__ void operator()(int m, int n, f32x4 v) const {
        const u32x2 y = *(const u32x2*)(Y + (size_t)m * 768 + n); u32x2* zp = (u32x2*)(ZS + (size_t)m * 768 + n); const u32x2 z = *zp; const f32x4 bb = *(const f32x4*)(b + n);
        const float o0 = bflo(y.x) * sigmoidf_(v.x + bb.x) * bflo(z.x), o1 = bfhi(y.x) * sigmoidf_(v.y + bb.y) * bfhi(z.x);
        const float o2 = bflo(y.y) * sigmoidf_(v.z + bb.z) * bflo(z.y), o3 = bfhi(y.y) * sigmoidf_(v.w + bb.w) * bfhi(z.y);
        *zp = (u32x2){pk2(o0, o1), pk2(o2, o3)};
    }
};
struct EpiOut {
    const float* xold; float* xnew;
    __device__ __forceinline__ void operator()(int m, int n, f32x4 v) const { const size_t o = (size_t)m * 1024 + n; *(f32x4*)(xnew + o) = *(const f32x4*)(xold + o) + v; }
};
template <class Epi>
__device__ __forceinline__ void wgemm(const bf16_t* __restrict__ A, int lda, const bf16_t* __restrict__ Bt, int ldb, int M, int N, int K, const Epi& epi, int gw, int ngw, int lane) {
    const int r = lane & 31, hi = lane >> 5; const int ntn = N / 64, ntiles = (M / 64) * ntn;
    for (int tile = gw; tile < ntiles; tile += ngw) {
        const int m0 = (tile / ntn) * 64, n0 = (tile % ntn) * 64;
        f32x16 acc[2][2];
#pragma unroll
        for (int i = 0; i < 2; ++i)
#pragma unroll
            for (int j = 0; j < 2; ++j)
#pragma unroll
                for (int q = 0; q < 16; ++q) acc[i][j][q] = 0.f;
        const bf16_t* ap = A + (size_t)(m0 + r) * lda + 8 * hi;
        const bf16_t* bp = Bt + (size_t)(n0 + r) * ldb + 8 * hi;
        for (int k = 0; k < K; k += 16) {
            const bf16x8 a0 = *(const bf16x8*)(ap + k), a1 = *(const bf16x8*)(ap + (size_t)32 * lda + k);
            const bf16x8 b0 = *(const bf16x8*)(bp + k), b1 = *(const bf16x8*)(bp + (size_t)32 * ldb + k);
            acc[0][0] = __builtin_amdgcn_mfma_f32_32x32x16_bf16(b0, a0, acc[0][0], 0, 0, 0);
            acc[0][1] = __builtin_amdgcn_mfma_f32_32x32x16_bf16(b1, a0, acc[0][1], 0, 0, 0);
            acc[1][0] = __builtin_amdgcn_mfma_f32_32x32x16_bf16(b0, a1, acc[1][0], 0, 0, 0);
            acc[1][1] = __builtin_amdgcn_mfma_f32_32x32x16_bf16(b1, a1, acc[1][1], 0, 0, 0);
        }
#pragma unroll
        for (int mi = 0; mi < 2; ++mi)
#pragma unroll
            for (int ni = 0; ni < 2; ++ni)
#pragma unroll
                for (int q = 0; q < 4; ++q)
                    epi(m0 + 32 * mi + r, n0 + 32 * ni + 8 * q + 4 * hi, (f32x4){acc[mi][ni][4 * q], acc[mi][ni][4 * q + 1], acc[mi][ni][4 * q + 2], acc[mi][ni][4 * q + 3]});
    }
}
__device__ __forceinline__ void merge_ref(const bf16_t* __restrict__ XB, const float* __restrict__ rs, const bf16_t* __restrict__ WinT, const float* __restrict__ bg,
                                          const bf16_t* __restrict__ OS, const bf16_t* __restrict__ OA, const bf16_t* __restrict__ OM,
                                          const bf16_t* __restrict__ W1, const bf16_t* __restrict__ W2, const bf16_t* __restrict__ W3, bf16_t* __restrict__ MG, int gw, int ngw, int lane) {
    const int r = lane & 31, hi = lane >> 5;
    for (int tile = gw; tile < (T / 32) * 32; tile += ngw) {
        const int m0 = (tile >> 5) * 32, n0 = (tile & 31) * 32;
        f32x16 L0, L1, L2, P0, P1, P2;
#pragma unroll
        for (int q = 0; q < 16; ++q) { L0[q] = 0.f; L1[q] = 0.f; L2[q] = 0.f; P0[q] = 0.f; P1[q] = 0.f; P2[q] = 0.f; }
        {
            const bf16_t* ap = XB + (size_t)(m0 + r) * 1024 + 8 * hi; const bf16_t* bp = WinT + (size_t)(N_A1 + n0 + r) * 1024 + 8 * hi;
            for (int k = 0; k < 1024; k += 16) {
                const bf16x8 a = *(const bf16x8*)(ap + k);
                L0 = __builtin_amdgcn_mfma_f32_32x32x16_bf16(*(const bf16x8*)(bp + k), a, L0, 0, 0, 0);
                L1 = __builtin_amdgcn_mfma_f32_32x32x16_bf16(*(const bf16x8*)(bp + (size_t)1024 * 1024 + k), a, L1, 0, 0, 0);
                L2 = __builtin_amdgcn_mfma_f32_32x32x16_bf16(*(const bf16x8*)(bp + (size_t)2048 * 1024 + k), a, L2, 0, 0, 0);
            }
        }
        {
            const bf16_t* ap = OS + (size_t)(m0 + r) * 768 + 8 * hi; const bf16_t* bp = W1 + (size_t)(n0 + r) * 768 + 8 * hi;
            for (int k = 0; k < 768; k += 16) P0 = __builtin_amdgcn_mfma_f32_32x32x16_bf16(*(const bf16x8*)(bp + k), *(const bf16x8*)(ap + k), P0, 0, 0, 0);
        }
        {
            const bf16_t* ap = OA + (size_t)(m0 + r) * 768 + 8 * hi; const bf16_t* bp = W2 + (size_t)(n0 + r) * 768 + 8 * hi;
            for (int k = 0; k < 768; k += 16) P1 = __builtin_amdgcn_mfma_f32_32x32x16_bf16(*(const bf16x8*)(bp + k), *(const bf16x8*)(ap + k), P1, 0, 0, 0);
        }
        {
            const bf16_t* ap = OM + (size_t)(m0 + r) * 512 + 8 * hi; const bf16_t* bp = W3 + (size_t)(n0 + r) * 512 + 8 * hi;
            for (int k = 0; k < 512; k += 16) P2 = __builtin_amdgcn_mfma_f32_32x32x16_bf16(*(const bf16x8*)(bp + k), *(const bf16x8*)(ap + k), P2, 0, 0, 0);
        }
        const int m = m0 + r; const float rsm = rs[m];
#pragma unroll
        for (int q = 0; q < 4; ++q) {
            const int n = n0 + 8 * q + 4 * hi; float o[4];
#pragma unroll
            for (int e = 0; e < 4; ++e) {
                const int rg = 4 * q + e;
                const float g0 = sigmoidf_(rsm * L0[rg] + bg[n + e]), g1 = sigmoidf_(rsm * L1[rg] + bg[1024 + n + e]), g2 = sigmoidf_(rsm * L2[rg] + bg[2048 + n + e]);
                o[e] = g0 * P0[rg] + g1 * P1[rg] + g2 * P2[rg];
            }
            *(u32x2*)(MG + (size_t)m * 1024 + n) = (u32x2){pk2(o[0], o[1]), pk2(o[2], o[3])};
        }
    }
}

__device__ __forceinline__ void ssm_ref(int b, int g, int lane, LAS float* xs, const bf16_t* __restrict__ U, bf16_t* __restrict__ Y, const float* __restrict__ lam_re, const float* __restrict__ lam_im,
                                        const float* __restrict__ log_dt, const float* __restrict__ b_re, const float* __restrict__ b_im,
                                        const float* __restrict__ c_re, const float* __restrict__ c_im, const float* __restrict__ dvec) {
    const float dt = expf(log_dt[g]); const float lre = lam_re[g * 64 + lane], lim = lam_im[g * 64 + lane];
    const float mag = expf(lre * dt); const float ar = mag * cosf(lim * dt), ai = mag * sinf(lim * dt);
    const float den = lre * lre + lim * lim, nr = ar - 1.0f, ni = ai;
    const float fr = (nr * lre + ni * lim) / den, fi = (ni * lre - nr * lim) / den;
    float bbr[16], bbi[16];
#pragma unroll
    for (int h = 0; h < 16; ++h) { const float br = b_re[(g * 64 + lane) * 16 + h], bi = b_im[(g * 64 + lane) * 16 + h]; bbr[h] = fr * br - fi * bi; bbi[h] = fr * bi + fi * br; }
    const int hq = lane & 15, part = lane >> 4;
    float cr[16], ci[16];
#pragma unroll
    for (int i = 0; i < 16; ++i) { cr[i] = c_re[(g * 16 + hq) * 64 + part * 16 + i]; ci[i] = c_im[(g * 16 + hq) * 64 + part * 16 + i]; }
    const float dd = dvec[g * 16 + hq];
    float xr = 0.f, xi = 0.f;
    const bf16_t* up = U + (size_t)b * SEQ * 768 + g * 16; bf16_t* yp = Y + (size_t)b * SEQ * 768 + g * 16;
    for (int t = 0; t < SEQ; ++t) {
        const u32x4 ua = *(const u32x4*)(up + (size_t)t * 768), ub = *(const u32x4*)(up + (size_t)t * 768 + 8);
        const float uh = bf2f(up[(size_t)t * 768 + hq]);
        float u[16];
        u[0] = bflo(ua.x); u[1] = bfhi(ua.x); u[2] = bflo(ua.y); u[3] = bfhi(ua.y); u[4] = bflo(ua.z); u[5] = bfhi(ua.z); u[6] = bflo(ua.w); u[7] = bfhi(ua.w);
        u[8] = bflo(ub.x); u[9] = bfhi(ub.x); u[10] = bflo(ub.y); u[11] = bfhi(ub.y); u[12] = bflo(ub.z); u[13] = bfhi(ub.z); u[14] = bflo(ub.w); u[15] = bfhi(ub.w);
        float bur = 0.f, bui = 0.f;
#pragma unroll
        for (int h = 0; h < 16; ++h) { bur += bbr[h] * u[h]; bui += bbi[h] * u[h]; }
        const float nxr = ar * xr - ai * xi + bur, nxi = ar * xi + ai * xr + bui; xr = nxr; xi = nxi;
        xs[lane] = xr; xs[64 + lane] = xi;
        asm volatile("s_waitcnt lgkmcnt(0)" ::: "memory");
        float acc = 0.f;
#pragma unroll
        for (int i = 0; i < 16; ++i) acc += cr[i] * xs[part * 16 + i] - ci[i] * xs[64 + part * 16 + i];
        acc += __shfl_xor(acc, 16); acc += __shfl_xor(acc, 32);
        asm volatile("s_waitcnt lgkmcnt(0)" ::: "memory");
        if (lane < 16) yp[(size_t)t * 768 + lane] = (bf16_t)f2bf(gelu_tanh(acc + dd * uh));
    }
}

__device__ __forceinline__ int rel_bucket(int n) {
    if (n < 16) return n;
    const float v = logf((float)n / 16.0f) / 4.852030263919617f * 16.0f;
    const int lg = 16 + (int)v; return lg < 31 ? lg : 31;
}
__device__ __forceinline__ float dot8(const u32x4 a, const u32x4 b) {
    return bflo(a.x) * bflo(b.x) + bfhi(a.x) * bfhi(b.x) + bflo(a.y) * bflo(b.y) + bfhi(a.y) * bfhi(b.y) + bflo(a.z) * bflo(b.z) + bfhi(a.z) * bfhi(b.z) + bflo(a.w) * bflo(b.w) + bfhi(a.w) * bfhi(b.w);
}
__device__ __forceinline__ void attn_ref(bf16_t* Q, const bf16_t* __restrict__ Kb, const bf16_t* __restrict__ V, const float* __restrict__ rel_bias, float* __restrict__ lse, int gw, int ngw, int lane) {
    for (int item = gw; item < T * NH; item += ngw) {
        const int head = item % NH, tok = item / NH, t = tok % SEQ, row0 = tok - t;
        const int grp = head >> 2, r = grp == 0 ? 1 : (grp == 1 ? 4 : 16);
        bf16_t* qp = Q + (size_t)tok * 768 + head * 64;
        u32x4 qv[8];
#pragma unroll
        for (int i = 0; i < 8; ++i) qv[i] = ((const u32x4*)qp)[i];
        float s[3]; bool ok[3];
#pragma unroll
        for (int sl = 0; sl < 3; ++sl) {
            const int j = sl * 64 + lane, p = t - j * r; ok[sl] = (j <= 128) && (p >= 0); s[sl] = -1e30f;
            if (ok[sl]) {
                const u32x4* kp = (const u32x4*)(Kb + (size_t)(row0 + p) * 768 + head * 64); float d = 0.f;
#pragma unroll
                for (int i = 0; i < 8; ++i) d += dot8(qv[i], kp[i]);
                s[sl] = d + rel_bias[rel_bucket(j * r) * NH + head];
            }
        }
        const float m = wave_max(fmaxf(fmaxf(s[0], s[1]), s[2]));
        float e[3];
#pragma unroll
        for (int sl = 0; sl < 3; ++sl) e[sl] = ok[sl] ? __expf(s[sl] - m) : 0.f;
        const float l = wave_sum(e[0] + e[1] + e[2]);
        float o = 0.f;
#pragma unroll
        for (int sl = 0; sl < 3; ++sl) {
            for (int jj = 0; jj < 64; ++jj) {
                const int j = sl * 64 + jj, p = t - j * r; if (j > 128 || p < 0) break;
                const float pj = __shfl(e[sl], jj);
                o += pj * bf2f(V[(size_t)(row0 + p) * 768 + head * 64 + lane]);
            }
        }
        qp[lane] = (bf16_t)f2bf(o / l);
        if (lane == 0) lse[(size_t)tok * NH + head] = m + logf(l);
    }
}
__device__ __forceinline__ void attn_final_tok(bf16_t* __restrict__ Q, const float* __restrict__ lse, const bf16_t* __restrict__ ZA, int tok, int lane) {
    const float* lp = lse + (size_t)tok * NH;
    for (int c = lane * 4; c < 768; c += 256) {
        const int head = c >> 6, hh = head & 3; const float l0 = lp[hh], l1 = lp[4 + hh], l2 = lp[8 + hh];
        const float mx = fmaxf(fmaxf(l0, l1), l2); const float e0 = __expf(l0 - mx), e1 = __expf(l1 - mx), e2 = __expf(l2 - mx);
        const float mine = head < 4 ? e0 : (head < 8 ? e1 : e2); const float al = mine / (e0 + e1 + e2);
        u32x2* qp = (u32x2*)(Q + (size_t)tok * 768 + c); const u32x2 o = *qp; const u32x2 z = *(const u32x2*)(ZA + (size_t)tok * 768 + c);
        *qp = (u32x2){pk2(bflo(o.x) * al * bflo(z.x), bfhi(o.x) * al * bfhi(z.x)), pk2(bflo(o.y) * al * bflo(z.y), bfhi(o.y) * al * bfhi(z.y))};
    }
}
__device__ __forceinline__ void memattn_ref(bf16_t* QM, const bf16_t* __restrict__ KVM, const bf16_t* __restrict__ ZM, int gw, int ngw, int lane) {
    for (int item = gw; item < T * MH; item += ngw) {
        const int head = item & 3, tok = item >> 2, b = tok / SEQ;
        bf16_t* qp = QM + (size_t)tok * 512 + head * 128;
        u32x4 qv[16];
#pragma unroll
        for (int i = 0; i < 16; ++i) qv[i] = ((const u32x4*)qp)[i];
        float s[4];
#pragma unroll
        for (int sl = 0; sl < 4; ++sl) {
            const int j = sl * 64 + lane; const u32x4* kp = (const u32x4*)(KVM + (size_t)(b * 256 + j) * 1024 + head * 128); float d = 0.f;
#pragma unroll
            for (int i = 0; i < 16; ++i) d += dot8(qv[i], kp[i]);
            s[sl] = d;
        }
        const float m = wave_max(fmaxf(fmaxf(s[0], s[1]), fmaxf(s[2], s[3])));
        float e[4];
#pragma unroll
        for (int sl = 0; sl < 4; ++sl) e[sl] = __expf(s[sl] - m);
        const float l = wave_sum((e[0] + e[1]) + (e[2] + e[3]));
        float o0 = 0.f, o1 = 0.f;
#pragma unroll
        for (int sl = 0; sl < 4; ++sl)
            for (int jj = 0; jj < 64; ++jj) {
                const int j = sl * 64 + jj; const float pj = __shfl(e[sl], jj);
                const bf16_t* vp = KVM + (size_t)(b * 256 + j) * 1024 + 512 + head * 128;
                o0 += pj * bf2f(vp[lane]); o1 += pj * bf2f(vp[64 + lane]);
            }
        const bf16_t* zp = ZM + (size_t)tok * 512 + head * 128;
        qp[lane] = (bf16_t)f2bf(o0 / l * bf2f(zp[lane])); qp[64 + lane] = (bf16_t)f2bf(o1 / l * bf2f(zp[64 + lane]));
    }
}

constexpr size_t TAB_TOEP = 0, TAB_CST = 2 * MiB, TAB_WST = 8 * MiB, TAB_AQ = 15 * MiB;
__device__ __forceinline__ int fresh_tid() { int t = threadIdx.x; asm volatile("" : "+v"(t)); return t; }
__device__ __forceinline__ unsigned char* fresh_ptr(unsigned char* p) { asm volatile("" : "+s"(p)); return p; }
__device__ __forceinline__ int fresh_bid() { int b = blockIdx.x; asm volatile("" : "+s"(b)); return b; }
namespace ge {
constexpr int BM = 256, BK = 64, HALF = 128, HTB = HALF * BK * 2, STAGE_BYTES = 8 * HTB;
__device__ __forceinline__ int lds_byte(int r, int c) { const int st = (r >> 4) * 2 + (c >> 5), rr = r & 15, cc = c & 31, ob = rr * 64 + cc * 2; return st * 1024 + (ob ^ (((ob >> 9) & 1) << 5)); }
__device__ __forceinline__ void stage_rc(int b, int& R, int& C) { const int st = b / 1024, sb = b % 1024, swz = sb ^ (((sb >> 9) & 1) << 5); R = (st >> 1) * 16 + swz / 64; C = (st & 1) * 32 + (swz % 64) / 2; }
__device__ __forceinline__ int perm32(int rho) { const int n = rho >> 4, i = rho & 15; return 8 * (i >> 2) + 4 * n + (i & 3); }
enum { A_STD = 0, A_GM = 1 };
enum { B_STD = 0, B_PERM = 1, B_TOEP = 2 };
struct Seg { const char* A; const char* B; int a_h, b_h, a_k, b_k, npairs, amode, bmode; unsigned lda2, ldb2; };
struct Unit { int type, pm, pn, g; };
typedef f32x4 Acc[2][2][4][2];

template <class Sched, class Epi>
__device__ __forceinline__ void gemm_run(LAS unsigned char* lds, const Sched& S, const Epi& E) {
    const int tid = fresh_tid(), wid = __builtin_amdgcn_readfirstlane(tid >> 6), lane = tid & 63, wr = wid >> 2, wc = wid & 3, fr = lane & 15, fq = lane >> 4;
    const unsigned ldsw = (unsigned)wid * 1024u;
    const int aoff = lds_byte(wr * 64 + fr, fq * 8), boff = lds_byte(wc * 32 + fr, fq * 8);
#define GE_SA(b, h) (((b) * 2 + (h)) * HTB)
#define GE_SB(b, h) ((4 + (b) * 2 + (h)) * HTB)
#define GE_STAGE(bufoff, gbase, voff) do { _Pragma("unroll") for (int _i = 0; _i < 2; ++_i) \
        __builtin_amdgcn_global_load_lds((const unsigned*)((const char*)(gbase) + (voff)[_i]), (LAS unsigned*)(lds + (bufoff) + ldsw + _i * 8192), 16, 0, 0); } while (0)
#define GE_LDA(dst, b, h) do { _Pragma("unroll") for (int m = 0; m < 4; ++m) _Pragma("unroll") for (int k = 0; k < 2; ++k) dst[m][k] = *(const LAS bf16x8*)(lds + GE_SA(b, h) + aoff + m * 2048 + k * 1024); } while (0)
#define GE_LDB(dst, b, h) do { _Pragma("unroll") for (int n = 0; n < 2; ++n) _Pragma("unroll") for (int k = 0; k < 2; ++k) dst[n][k] = *(const LAS bf16x8*)(lds + GE_SB(b, h) + boff + n * 2048 + k * 1024); } while (0)
#define GE_MMA(ai, bj, At, Bt) do { __builtin_amdgcn_s_setprio(1); _Pragma("unroll") for (int m = 0; m < 4; ++m) _Pragma("unroll") for (int n = 0; n < 2; ++n) _Pragma("unroll") for (int k = 0; k < 2; ++k) \
        acc[ai][bj][m][n] = __builtin_amdgcn_mfma_f32_16x16x32_bf16(Bt[n][k], At[m][k], acc[ai][bj][m][n], 0, 0, 0); __builtin_amdgcn_s_setprio(0); } while (0)
#define GE_WAIT_V(n) asm volatile("s_waitcnt vmcnt(" #n ")" ::: "memory")
#define GE_WAIT_L(n) asm volatile("s_waitcnt lgkmcnt(" #n ")" ::: "memory")
#define GE_BAR __builtin_amdgcn_s_barrier()
#define GE_SCHED __builtin_amdgcn_sched_barrier(0)
#define GE_VOFFS(sg, va, vb) do { _Pragma("unroll") for (int _i = 0; _i < 2; ++_i) { int R_, C_; stage_rc(tid * 16 + _i * 8192, R_, C_); const int Rp_ = (R_ & ~31) + perm32(R_ & 31); \
        va[_i] = (sg).amode == A_GM ? (unsigned)(R_ * 32 + (C_ >> 4) * (T * 32) + (C_ & 15) * 2) : (unsigned)R_ * (sg).lda2 + (unsigned)(C_ * 2); \
        vb[_i] = (sg).bmode == B_TOEP ? (unsigned)((((Rp_ >> 4) - (C_ >> 4) + 3) * 256 + (Rp_ & 15) * 16 + (C_ & 15)) * 2) : (unsigned)((sg).bmode == B_PERM ? Rp_ : R_) * (sg).ldb2 + (unsigned)(C_ * 2); } } while (0)
    Unit nu; int nui = 0;
    if (!S.unit(0, nu)) return;
    Seg ns; int nsi = 0, npi = 0; S.seg(nu, 0, ns);
    const char* npa = ns.A; const char* npb = ns.B; unsigned nva[2], nvb[2]; GE_VOFFS(ns, nva, nvb);
    bool nreal = true;
    Unit cu; int csi; bool c_lastseg, c_lastunit; const char* c_a1h; unsigned cva[2];
#define GE_ADVANCE() do { ++npi; if (npi < ns.npairs) { npa += 2 * ns.a_k; npb += 2 * ns.b_k; } else { npi = 0; ++nsi; \
        if (nsi >= S.nseg(nu)) { nsi = 0; Unit tu; if (S.unit(nui + 1, tu)) { ++nui; nu = tu; } else nreal = false; } \
        S.seg(nu, nsi, ns); npa = ns.A; npb = ns.B; GE_VOFFS(ns, nva, nvb); } } while (0)
#define GE_SHIFT() do { cu = nu; csi = nsi; c_lastseg = (npi == ns.npairs - 1); c_lastunit = c_lastseg && (nsi == S.nseg(nu) - 1); \
        c_a1h = npa + ns.a_k + ns.a_h; cva[0] = nva[0]; cva[1] = nva[1]; GE_ADVANCE(); } while (0)
    Acc acc;
#pragma unroll
    for (int a = 0; a < 2; ++a)
#pragma unroll
        for (int b = 0; b < 2; ++b)
#pragma unroll
            for (int m = 0; m < 4; ++m)
#pragma unroll
                for (int n = 0; n < 2; ++n) acc[a][b][m][n] = (f32x4){0.f, 0.f, 0.f, 0.f};
    bf16x8 At[4][2], B0[2][2], B1[2][2];
    GE_STAGE(GE_SB(0, 0), npb, nvb); GE_STAGE(GE_SB(0, 1), npb + ns.b_h, nvb); GE_STAGE(GE_SA(0, 0), npa, nva); GE_STAGE(GE_SA(0, 1), npa + ns.a_h, nva);
    if (wr == 1) GE_BAR;
    GE_WAIT_V(2); GE_BAR;
    GE_STAGE(GE_SB(1, 0), npb + ns.b_k, nvb); GE_STAGE(GE_SA(1, 0), npa + ns.a_k, nva); GE_STAGE(GE_SB(1, 1), npb + ns.b_k + ns.b_h, nvb);
    GE_WAIT_V(6); GE_BAR;
    GE_SHIFT();
    for (;;) {
        GE_LDB(B0, 0, 0); GE_LDB(B1, 0, 1); GE_SCHED; GE_LDA(At, 0, 0); GE_STAGE(GE_SA(1, 1), c_a1h, cva);
        GE_WAIT_V(8); GE_WAIT_L(0); GE_BAR; GE_MMA(0, 0, At, B0); GE_MMA(0, 1, At, B1); GE_BAR; GE_SCHED;
        GE_LDA(At, 0, 1); GE_STAGE(GE_SB(0, 0), npb, nvb); GE_STAGE(GE_SB(0, 1), npb + ns.b_h, nvb); GE_STAGE(GE_SA(0, 0), npa, nva);
        GE_WAIT_V(8); GE_WAIT_L(0); GE_BAR; GE_MMA(1, 0, At, B0); GE_MMA(1, 1, At, B1); GE_BAR; GE_SCHED;
        GE_LDB(B0, 1, 0); GE_LDB(B1, 1, 1); GE_SCHED; GE_LDA(At, 1, 0); GE_STAGE(GE_SA(0, 1), npa + ns.a_h, nva);
        GE_WAIT_V(8); GE_WAIT_L(0); GE_BAR; GE_MMA(0, 0, At, B0); GE_MMA(0, 1, At, B1); GE_BAR; GE_SCHED;
        GE_LDA(At, 1, 1); GE_STAGE(GE_SB(1, 0), npb + ns.b_k, nvb); GE_STAGE(GE_SB(1, 1), npb + ns.b_k + ns.b_h, nvb); GE_STAGE(GE_SA(1, 0), npa + ns.a_k, nva);
        GE_WAIT_V(8); GE_WAIT_L(0); GE_BAR; GE_MMA(1, 0, At, B0); GE_MMA(1, 1, At, B1); GE_BAR; GE_SCHED;
        if (c_lastunit) {
            if (wr == 0) GE_BAR;
            { int fr_ = fr, fq_ = fq; asm volatile("" : "+v"(fr_), "+v"(fq_)); E.finish(acc, cu, wr, wc, fr_, fq_); }
            if (!nreal) break;
#pragma unroll
            for (int a = 0; a < 2; ++a)
#pragma unroll
                for (int b = 0; b < 2; ++b)
#pragma unroll
                    for (int m = 0; m < 4; ++m)
#pragma unroll
                        for (int n = 0; n < 2; ++n) acc[a][b][m][n] = (f32x4){0.f, 0.f, 0.f, 0.f};
            if (wr == 1) GE_BAR;
        } else if (c_lastseg) {
            { int fr_ = fr, fq_ = fq; asm volatile("" : "+v"(fr_), "+v"(fq_)); E.seg_end(acc, cu, csi, wr, wc, fr_, fq_); }
        }
        GE_SHIFT();
    }
    GE_WAIT_V(0);
    GE_BAR;
    { int fr_ = fr, fq_ = fq; asm volatile("" : "+v"(fr_), "+v"(fq_)); E.after_drain(acc, cu, lds, wr, wc, fr_, fq_); }
#undef GE_SA
#undef GE_SB
#undef GE_STAGE
#undef GE_LDA
#undef GE_LDB
#undef GE_MMA
#undef GE_WAIT_V
#undef GE_WAIT_L
#undef GE_BAR
#undef GE_SCHED
#undef GE_VOFFS
#undef GE_ADVANCE
#undef GE_SHIFT
}
__device__ __forceinline__ bool static_tile(int i, int G, int c, int nM, int nN, int& pm, int& pn) {
    const int nwg = nM * nN; const long L = (long)i * G + c; if (L >= nwg) return false;
    int wgid = (int)L; { const int q = nwg / 8, r = nwg % 8, xcd = wgid % 8, off = wgid / 8; wgid = (xcd < r ? xcd * (q + 1) : r * (q + 1) + (xcd - r) * q) + off; }
    const int nig = 8 * nN, gid = wgid / nig, fm = gid * 8, gsz = (nM - fm) < 8 ? (nM - fm) : 8;
    pm = fm + ((wgid % nig) % gsz); pn = (wgid % nig) / gsz; return true;
}
__device__ __forceinline__ unsigned cvt_pk_bf16(float lo, float hi) { unsigned r; asm volatile("v_cvt_pk_bf16_f32 %0, %1, %2" : "=v"(r) : "v"(lo), "v"(hi)); return r; }
__device__ __forceinline__ u32x4 pack8(const f32x4 a, const f32x4 b) { u32x4 w; w.x = cvt_pk_bf16(a[0], a[1]); w.y = cvt_pk_bf16(a[2], a[3]); w.z = cvt_pk_bf16(b[0], b[1]); w.w = cvt_pk_bf16(b[2], b[3]); return w; }
__device__ __forceinline__ void unpack8(const u32x4 w, f32x4& a, f32x4& b) { a = (f32x4){bflo(w.x), bfhi(w.x), bflo(w.y), bfhi(w.y)}; b = (f32x4){bflo(w.z), bfhi(w.z), bflo(w.w), bfhi(w.w)}; }
__device__ __forceinline__ float fsigm(float x) { return __builtin_amdgcn_rcpf(1.f + __builtin_amdgcn_exp2f(-1.4426950408889634f * x)); }
__device__ __forceinline__ float fgelu(float y) { return y * fsigm(1.5957691216057308f * (y + 0.044715f * y * y * y)); }
__device__ __forceinline__ f32x4 silu4(f32x4 v) { return (f32x4){v[0] * fsigm(v[0]), v[1] * fsigm(v[1]), v[2] * fsigm(v[2]), v[3] * fsigm(v[3])}; }
__device__ __forceinline__ f32x4 sigm4(f32x4 v) { return (f32x4){fsigm(v[0]), fsigm(v[1]), fsigm(v[2]), fsigm(v[3])}; }
__device__ __forceinline__ f32x4 gelu4(f32x4 v) { return (f32x4){fgelu(v[0]), fgelu(v[1]), fgelu(v[2]), fgelu(v[3])}; }
#define GE_FOR_PERM(...) _Pragma("unroll") for (int ai = 0; ai < 2; ++ai) _Pragma("unroll") for (int m = 0; m < 4; ++m) _Pragma("unroll") for (int bj = 0; bj < 2; ++bj) { \
        const int row = ai * HALF + wr * 64 + m * 16 + fr, col8 = bj * HALF + wc * 32 + 8 * fq; __VA_ARGS__ asm volatile("" ::: "memory"); }

struct PA_Sched {
    int G, c; const unsigned char *ws, *wl;
    __device__ __forceinline__ bool unit(int i, Unit& u) const {
        constexpr int nwg = (T / 256) * (N_A1 / 256); const int nA = c < nwg ? (nwg - c + G - 1) / G : 0;
        if (i < nA) { u.type = 0; u.g = 0; return static_tile(i, G, c, T / 256, N_A1 / 256, u.pm, u.pn); }
        if (i == nA && c < 16) { u.type = 1; u.pm = c >> 2; u.pn = c & 3; u.g = 0; return true; }
        return false;
    }
    __device__ __forceinline__ int nseg(const Unit&) const { return 1; }
    __device__ __forceinline__ void seg(const Unit& u, int, Seg& s) const {
        s.A = (const char*)(ws + (u.type == 0 ? OFF_XB : OFF_MEMB)) + (size_t)u.pm * 256 * 2048; s.B = (const char*)(wl + (u.type == 0 ? WO_IN : WO_MKV)) + (size_t)u.pn * 256 * 2048;
        s.a_h = 128 * 2048; s.b_h = 128 * 2048; s.a_k = 128; s.b_k = 128; s.npairs = 8; s.amode = A_STD; s.bmode = B_PERM; s.lda2 = 2048; s.ldb2 = 2048;
    }
};
struct PA_Epi {
    unsigned char* ws; int l;
    __device__ __forceinline__ void seg_end(Acc&, const Unit&, int, int, int, int, int) const {}
    __device__ __forceinline__ void after_drain(Acc&, const Unit&, LAS unsigned char*, int, int, int, int) const {}
    __device__ __forceinline__ void finish(Acc& acc, const Unit& u, int wr, int wc, int fr, int fq) const {
        const int pn = u.pn;
        if (u.type == 1) {
            const float* rsm = (const float*)(ws + OFF_RSMEM); bf16_t* KVM = (bf16_t*)(ws + OFF_KVM + (size_t)l * 2 * MiB);
            GE_FOR_PERM({ const int tr = u.pm * 256 + row; const float r = rsm[tr]; *(u32x4*)(KVM + (size_t)tr * 1024 + pn * 256 + col8) = pack8(acc[ai][bj][m][0] * r, acc[ai][bj][m][1] * r); })
            return;
        }
        const float* rs = (const float*)(ws + OFF_RS);
        if (pn < 3) {
            bf16_t* U = (bf16_t*)(ws + OFF_U);
            GE_FOR_PERM({ const int tr = u.pm * 256 + row; const float r = rs[tr]; const int c = pn * 256 + col8;
                *(u32x4*)(U + ((size_t)(c >> 4) * 1024 + (tr >> 5)) * 640 + (tr & 31) * 16 + (c & 15)) = pack8(acc[ai][bj][m][0] * r, acc[ai][bj][m][1] * r); })
        } else if (pn < 18) {
            const int k = (pn - 3) / 3; const size_t off = k == 0 ? OFF_ZS : (k == 1 ? OFF_Q : (k == 2 ? OFF_K : (k == 3 ? OFF_V : OFF_ZA)));
            bf16_t* D = (bf16_t*)(ws + off); const bool silu = (k == 0 || k == 4); const float sc = k == 1 ? 0.125f : 1.0f;
            const int cb = (pn - 3 - 3 * k) * 256;
            GE_FOR_PERM({ const int tr = u.pm * 256 + row; const float r = rs[tr]; f32x4 v0 = acc[ai][bj][m][0] * r, v1 = acc[ai][bj][m][1] * r;
                if (silu) { v0 = silu4(v0); v1 = silu4(v1); } v0 = v0 * sc; v1 = v1 * sc;
                *(u32x4*)(D + (size_t)tr * 768 + cb + col8) = pack8(v0, v1); })
        } else {
            const bool isz = pn >= 20; bf16_t* D = (bf16_t*)(ws + (isz ? OFF_ZM : OFF_QM)); const int cb = (pn - (isz ? 20 : 18)) * 256; const float sc = isz ? 1.0f : 0.08838834764831845f;
            GE_FOR_PERM({ const int tr = u.pm * 256 + row; const float r = rs[tr]; f32x4 v0 = acc[ai][bj][m][0] * r, v1 = acc[ai][bj][m][1] * r;
                if (isz) { v0 = silu4(v0); v1 = silu4(v1); } v0 = v0 * sc; v1 = v1 * sc;
                *(u32x4*)(D + (size_t)tr * 512 + cb + col8) = pack8(v0, v1); })
        }
    }
};
struct PS_Sched {
    int c; const unsigned char* ws;
    __device__ __forceinline__ bool unit(int i, Unit& u) const { if (i != 0 || c >= BATCH * NG) return false; u.type = 0; u.g = c % NG; u.pm = c / NG; u.pn = 0; return true; }
    __device__ __forceinline__ int nseg(const Unit&) const { return 1; }
    __device__ __forceinline__ void seg(const Unit& u, int, Seg& s) const {
        s.A = (const char*)((const bf16_t*)(ws + OFF_U) + ((size_t)u.g * 1024 + u.pm * 256) * 640); s.B = (const char*)((const bf16_t*)(ws + OFF_TAB + TAB_WST) + (size_t)u.g * 128 * 512);
        s.a_h = 128 * 1280; s.b_h = 128 * 1024; s.a_k = 128; s.b_k = 128; s.npairs = 4; s.amode = A_STD; s.bmode = B_STD; s.lda2 = 1280; s.ldb2 = 1024;
    }
};
struct PS_Epi {
    unsigned char* ws;
    __device__ __forceinline__ void seg_end(Acc&, const Unit&, int, int, int, int, int) const {}
    __device__ __forceinline__ void finish(Acc&, const Unit&, int, int, int, int) const {}
    __device__ __forceinline__ void after_drain(Acc& acc, const Unit& u, LAS unsigned char* lds, int wr, int wc, int fr, int fq) const {
        LAS float* Sl = (LAS float*)lds;
#pragma unroll
        for (int ai = 0; ai < 2; ++ai)
#pragma unroll
            for (int m = 0; m < 4; ++m)
#pragma unroll
                for (int n = 0; n < 2; ++n) *(LAS f32x4*)(Sl + (ai * HALF + wr * 64 + m * 16 + fr) * 128 + wc * 32 + 16 * n + 4 * fq) = acc[ai][0][m][n];
        asm volatile("s_waitcnt lgkmcnt(0)" ::: "memory"); __builtin_amdgcn_s_barrier(); asm volatile("" ::: "memory");
        if (wr * 4 + wc == 0) {
            const float* AQ = (const float*)(ws + OFF_TAB + TAB_AQ); const int p = fq * 16 + fr; const float ar = AQ[(u.g * 64 + p) * 2], ai_ = AQ[(u.g * 64 + p) * 2 + 1];
            float xr = 0.f, xi = 0.f; bf16_t* up = (bf16_t*)(ws + OFF_U) + ((size_t)u.g * 1024 + u.pm * 256) * 640 + 512 + p;
            for (int c = 0; c < 256; ++c) {
                up[(size_t)c * 640] = (bf16_t)f2bf(xr); up[(size_t)c * 640 + 64] = (bf16_t)f2bf(xi);
                const float sr = Sl[c * 128 + p], si = Sl[c * 128 + 64 + p];
                const float nxr = ar * xr - ai_ * xi + sr, nxi = ar * xi + ai_ * xr + si; xr = nxr; xi = nxi;
            }
        }
    }
};
struct PY_Sched {
    int G, c; const unsigned char* ws;
    __device__ __forceinline__ bool unit(int i, Unit& u) const {
        const int L = i * G + c; if (L >= 2 * BATCH * NG) return false;
        const int q = L % (BATCH * NG); u.type = 0; u.pn = L < BATCH * NG ? 1 : 0; u.g = q % NG; u.pm = q / NG; return true;
    }
    __device__ __forceinline__ int nseg(const Unit&) const { return 2; }
    __device__ __forceinline__ void seg(const Unit& u, int si, Seg& s) const {
        const char* Arow = (const char*)((const bf16_t*)(ws + OFF_U) + ((size_t)u.g * 1024 + u.pm * 256) * 640);
        s.a_h = 128 * 1280; s.a_k = 128; s.amode = A_STD; s.lda2 = 1280;
        if (si == 0) { s.A = Arow; s.B = (const char*)((const bf16_t*)(ws + OFF_TAB + TAB_TOEP) + (size_t)u.g * 48 * 256) + (16 * u.pn + 13) * 512; s.b_h = 8 * 512; s.b_k = -2048; s.npairs = 2 * (u.pn + 1); s.bmode = B_TOEP; s.ldb2 = 0; }
        else { s.A = Arow + 1024; s.B = (const char*)((const bf16_t*)(ws + OFF_TAB + TAB_CST) + ((size_t)u.g * 512 + u.pn * 256) * 128); s.b_h = 128 * 256; s.b_k = 128; s.npairs = 1; s.bmode = B_PERM; s.ldb2 = 256; }
    }
};
struct PY_Epi {
    unsigned char* ws;
    __device__ __forceinline__ void seg_end(Acc&, const Unit&, int, int, int, int, int) const {}
    __device__ __forceinline__ void after_drain(Acc&, const Unit&, LAS unsigned char*, int, int, int, int) const {}
    __device__ __forceinline__ void finish(Acc& acc, const Unit& u, int wr, int wc, int fr, int fq) const {
        bf16_t* base = (bf16_t*)(ws + OFF_Y) + (size_t)u.g * T * 16 + (size_t)(u.pm * 256) * 512 + u.pn * 256;
        GE_FOR_PERM({ *(u32x4*)(base + (size_t)row * 512 + col8) = pack8(gelu4(acc[ai][bj][m][0]), gelu4(acc[ai][bj][m][1])); })
    }
};
struct PG_Sched {
    int G, c; const unsigned char *ws, *wl;
    __device__ __forceinline__ bool unit(int i, Unit& u) const { u.type = 0; u.g = 0; return static_tile(i, G, c, T / 256, 3, u.pm, u.pn); }
    __device__ __forceinline__ int nseg(const Unit&) const { return 1; }
    __device__ __forceinline__ void seg(const Unit& u, int, Seg& s) const {
        s.A = (const char*)(ws + OFF_Y) + (size_t)u.pm * 256 * 32; s.B = (const char*)(wl + WO_GLU) + (size_t)u.pn * 256 * 1536;
        s.a_h = 128 * 32; s.a_k = 4 * T * 32; s.amode = A_GM; s.lda2 = 0; s.b_h = 128 * 1536; s.b_k = 128; s.bmode = B_PERM; s.ldb2 = 1536; s.npairs = 6;
    }
};
struct PG_Epi {
    unsigned char* ws; const float* b;
    __device__ __forceinline__ void seg_end(Acc&, const Unit&, int, int, int, int, int) const {}
    __device__ __forceinline__ void after_drain(Acc&, const Unit&, LAS unsigned char*, int, int, int, int) const {}
    __device__ __forceinline__ void finish(Acc& acc, const Unit& u, int wr, int wc, int fr, int fq) const {
        const bf16_t* Y = (const bf16_t*)(ws + OFF_Y); bf16_t* ZS = (bf16_t*)(ws + OFF_ZS);
        GE_FOR_PERM({ const int tr = u.pm * 256 + row, c = u.pn * 256 + col8;
            f32x4 y0, y1, z0, z1; unpack8(*(const u32x4*)(Y + ((size_t)(c >> 4) * T + tr) * 16 + (c & 15)), y0, y1);
            u32x4* zp = (u32x4*)(ZS + (size_t)tr * 768 + c); unpack8(*zp, z0, z1);
            const f32x4 b0 = *(const f32x4*)(b + c), b1 = *(const f32x4*)(b + c + 4);
            *zp = pack8(y0 * sigm4(acc[ai][bj][m][0] + b0) * z0, y1 * sigm4(acc[ai][bj][m][1] + b1) * z1); })
    }
};
struct PM_Sched {
    int G, c; const unsigned char *ws, *wl;
    __device__ __forceinline__ bool unit(int i, Unit& u) const { const int t = i / 6; u.type = i - 6 * t; u.g = 0; return static_tile(t, G, c, T / 256, 4, u.pm, u.pn); }
    __device__ __forceinline__ int nseg(const Unit&) const { return 1; }
    __device__ __forceinline__ void seg(const Unit& u, int, Seg& s) const {
        s.a_k = 128; s.b_k = 128; s.amode = A_STD; s.bmode = B_PERM;
        if ((u.type & 1) == 0) { s.A = (const char*)(ws + OFF_XB) + (size_t)u.pm * 256 * 2048; s.B = (const char*)(wl + WO_IN) + (size_t)(N_A1 + (u.type >> 1) * 1024 + u.pn * 256) * 2048; s.lda2 = 2048; s.ldb2 = 2048; s.npairs = 8; }
        else if (u.type == 1) { s.A = (const char*)(ws + OFF_ZS) + (size_t)u.pm * 256 * 1536; s.B = (const char*)(wl + WO_B1) + (size_t)u.pn * 256 * 1536; s.lda2 = 1536; s.ldb2 = 1536; s.npairs = 6; }
        else if (u.type == 3) { s.A = (const char*)(ws + OFF_Q) + (size_t)u.pm * 256 * 1536; s.B = (const char*)(wl + WO_B2) + (size_t)u.pn * 256 * 1536; s.lda2 = 1536; s.ldb2 = 1536; s.npairs = 6; }
        else { s.A = (const char*)(ws + OFF_QM) + (size_t)u.pm * 256 * 1024; s.B = (const char*)(wl + WO_B3) + (size_t)u.pn * 256 * 1024; s.lda2 = 1024; s.ldb2 = 1024; s.npairs = 4; }
        s.a_h = 128 * (int)s.lda2; s.b_h = 128 * (int)s.ldb2;
    }
};
typedef _Float16 f16x8 __attribute__((ext_vector_type(8)));
struct PM_Epi {
    unsigned char* ws; const float* bg; int c;
    __device__ __forceinline__ void seg_end(Acc&, const Unit&, int, int, int, int, int) const {}
    __device__ __forceinline__ void after_drain(Acc&, const Unit&, LAS unsigned char*, int, int, int, int) const {}
    __device__ __forceinline__ void finish(Acc& acc, const Unit& u, int wr, int wc, int fr, int fq) const {
        const int t_ = (wr * 4 + wc) * 64 + fq * 16 + fr;
        GAS unsigned char* st = (GAS unsigned char*)(ws + OFF_V + (size_t)c * 393216);
        if ((u.type & 1) == 0) {
            const float* bgs = bg + (u.type >> 1) * 1024 + u.pn * 256; const float* rs = (const float*)(ws + OFF_RS);
            GE_FOR_PERM({ const float r = rs[u.pm * 256 + row]; const f32x4 b0 = *(const f32x4*)(bgs + col8), b1 = *(const f32x4*)(bgs + col8 + 4);
                const f32x4 g0 = sigm4(acc[ai][bj][m][0] * r + b0), g1 = sigm4(acc[ai][bj][m][1] * r + b1); f16x8 h;
                h[0] = (_Float16)g0[0]; h[1] = (_Float16)g0[1]; h[2] = (_Float16)g0[2]; h[3] = (_Float16)g0[3]; h[4] = (_Float16)g1[0]; h[5] = (_Float16)g1[1]; h[6] = (_Float16)g1[2]; h[7] = (_Float16)g1[3];
                *(GAS f16x8*)(st + ((ai * 2 + bj) * 4 + m) * 8192 + t_ * 16) = h; })
        } else {
            GE_FOR_PERM({ const int idx = (ai * 2 + bj) * 4 + m; const f16x8 h = *(const GAS f16x8*)(st + idx * 8192 + t_ * 16);
                f32x4 v0 = acc[ai][bj][m][0], v1 = acc[ai][bj][m][1];
                _Pragma("unroll") for (int e = 0; e < 4; ++e) { v0[e] *= (float)h[e]; v1[e] *= (float)h[4 + e]; }
                GAS f32x4* ps = (GAS f32x4*)(st + 131072 + idx * 16384 + t_ * 32);
                if (u.type > 1) { v0 = v0 + ps[0]; v1 = v1 + ps[1]; }
                if (u.type < 5) { ps[0] = v0; ps[1] = v1; }
                else *(u32x4*)((bf16_t*)(ws + OFF_MERGED) + (size_t)(u.pm * 256 + row) * 1024 + u.pn * 256 + col8) = pack8(v0, v1); })
        }
    }
};
struct PO_Sched {
    int G, c; const unsigned char *ws, *wl;
    __device__ __forceinline__ bool unit(int i, Unit& u) const { u.type = 0; u.g = 0; return static_tile(i, G, c, T / 256, 4, u.pm, u.pn); }
    __device__ __forceinline__ int nseg(const Unit&) const { return 1; }
    __device__ __forceinline__ void seg(const Unit& u, int, Seg& s) const {
        s.A = (const char*)(ws + OFF_MERGED) + (size_t)u.pm * 256 * 2048; s.B = (const char*)(wl + WO_OUT) + (size_t)u.pn * 256 * 2048;
        s.a_h = 128 * 2048; s.b_h = 128 * 2048; s.a_k = 128; s.b_k = 128; s.npairs = 8; s.amode = A_STD; s.bmode = B_STD; s.lda2 = 2048; s.ldb2 = 2048;
    }
};
struct PO_Epi {
    const float* xold; float* xnew;
    __device__ __forceinline__ void seg_end(Acc&, const Unit&, int, int, int, int, int) const {}
    __device__ __forceinline__ void after_drain(Acc&, const Unit&, LAS unsigned char*, int, int, int, int) const {}
    __device__ __forceinline__ void finish(Acc& acc, const Unit& u, int wr, int wc, int fr, int fq) const {
#pragma unroll
        for (int ai = 0; ai < 2; ++ai)
#pragma unroll
            for (int m = 0; m < 4; ++m) { const size_t ro = (size_t)(u.pm * 256 + ai * HALF + wr * 64 + m * 16 + fr) * 1024 + u.pn * 256 + wc * 32 + 4 * fq;
#pragma unroll
                for (int bj = 0; bj < 2; ++bj)
#pragma unroll
                    for (int n = 0; n < 2; ++n) { const size_t o = ro + bj * HALF + n * 16; *(f32x4*)(xnew + o) = *(const f32x4*)(xold + o) + acc[ai][bj][m][n]; }
                asm volatile("" ::: "memory"); }
    }
};
}

__device__ __forceinline__ void cpow(float lmag, double rev1, int k, float& re, float& im) {
    const float m = expf((float)k * lmag); double r = (double)k * rev1; r -= rint(r);
    const float a = (float)(r * 6.283185307179586476925286766559); re = m * cosf(a); im = m * sinf(a);
}
__device__ __forceinline__ void tabgen(unsigned char* tab, const float* __restrict__ lam_re, const float* __restrict__ lam_im, const float* __restrict__ log_dt, const float* __restrict__ b_re, const float* __restrict__ b_im,
                                       const float* __restrict__ c_re, const float* __restrict__ c_im, const float* __restrict__ dvec, LAS float* scr, int gw, int ngw, int lane) {
    bf16_t* TOEP = (bf16_t*)(tab + TAB_TOEP); bf16_t* CST = (bf16_t*)(tab + TAB_CST); bf16_t* WST = (bf16_t*)(tab + TAB_WST); float* AQ = (float*)(tab + TAB_AQ);
    for (int item = gw; item < NG * 32; item += ngw) {
        const int g = item >> 5, d = item & 31, p = lane;
        const float dt = expf(log_dt[g]); const float lre = lam_re[g * 64 + p], lim = lam_im[g * 64 + p];
        const float lmag = lre * dt; const double rev1 = (double)lim * (double)dt * 0.15915494309189533576888376337251;
        float fr, fi;
        {
            double r = rev1; r -= rint(r); const float bq = (float)(r * 6.283185307179586476925286766559);
            const float em1 = expm1f(lmag), sb2 = sinf(0.5f * bq); const float nr = em1 * cosf(bq) - 2.f * sb2 * sb2, ni = (em1 + 1.f) * sinf(bq);
            const float den = lre * lre + lim * lim; fr = (nr * lre + ni * lim) / den; fi = (ni * lre - nr * lim) / den;
        }
        float bbr[16], bbi[16];
#pragma unroll
        for (int h = 0; h < 16; ++h) { const float br = b_re[(g * 64 + p) * 16 + h], bi = b_im[(g * 64 + p) * 16 + h]; bbr[h] = fr * br - fi * bi; bbi[h] = fr * bi + fi * br; }
        float pr, pi;
        cpow(lmag, rev1, 31 - d, pr, pi);
        {
            unsigned wre[8], wim[8];
#pragma unroll
            for (int h = 0; h < 16; h += 2) { wre[h >> 1] = pk2(pr * bbr[h] - pi * bbi[h], pr * bbr[h + 1] - pi * bbi[h + 1]); wim[h >> 1] = pk2(pr * bbi[h] + pi * bbr[h], pr * bbi[h + 1] + pi * bbr[h + 1]); }
            u32x4* o0 = (u32x4*)(WST + ((size_t)g * 128 + p) * 512 + d * 16); u32x4* o1 = (u32x4*)(WST + ((size_t)g * 128 + 64 + p) * 512 + d * 16);
            o0[0] = (u32x4){wre[0], wre[1], wre[2], wre[3]}; o0[1] = (u32x4){wre[4], wre[5], wre[6], wre[7]};
            o1[0] = (u32x4){wim[0], wim[1], wim[2], wim[3]}; o1[1] = (u32x4){wim[4], wim[5], wim[6], wim[7]};
        }
        cpow(lmag, rev1, d + 1, pr, pi);
#pragma unroll 2
        for (int hq = 0; hq < 16; ++hq) { const float cr = c_re[(g * 16 + hq) * 64 + p], ci = c_im[(g * 16 + hq) * 64 + p];
            bf16_t* o = CST + ((size_t)g * 512 + d * 16 + hq) * 128; o[p] = (bf16_t)f2bf(cr * pr - ci * pi); o[64 + p] = (bf16_t)f2bf(-(cr * pi + ci * pr)); }
        cpow(lmag, rev1, d, pr, pi);
#pragma unroll
        for (int h = 0; h < 16; ++h) { scr[(p * 16 + h) * 2] = pr * bbr[h] - pi * bbi[h]; scr[(p * 16 + h) * 2 + 1] = pr * bbi[h] + pi * bbr[h]; }
        asm volatile("s_waitcnt lgkmcnt(0)" ::: "memory");
        {
            const int hq = lane >> 2, h0 = (lane & 3) * 4; float a0 = 0.f, a1 = 0.f, a2 = 0.f, a3 = 0.f;
            for (int q = 0; q < 64; ++q) { const float cr = c_re[(g * 16 + hq) * 64 + q], ci = c_im[(g * 16 + hq) * 64 + q]; const LAS float* s = scr + (q * 16 + h0) * 2;
                a0 += cr * s[0] - ci * s[1]; a1 += cr * s[2] - ci * s[3]; a2 += cr * s[4] - ci * s[5]; a3 += cr * s[6] - ci * s[7]; }
            if (d == 0) { const float dd = dvec[g * 16 + hq]; if (hq == h0) a0 += dd; if (hq == h0 + 1) a1 += dd; if (hq == h0 + 2) a2 += dd; if (hq == h0 + 3) a3 += dd; }
            *(u32x2*)(TOEP + ((size_t)g * 48 + 16 + d) * 256 + hq * 16 + h0) = (u32x2){pk2(a0, a1), pk2(a2, a3)};
            if (d < 16) *(u32x2*)(TOEP + ((size_t)g * 48 + d) * 256 + hq * 16 + h0) = (u32x2){0u, 0u};
        }
        asm volatile("s_waitcnt lgkmcnt(0)" ::: "memory");
        if (d == 0) { cpow(lmag, rev1, 32, pr, pi); AQ[(g * 64 + p) * 2] = pr; AQ[(g * 64 + p) * 2 + 1] = pi; }
    }
}

constexpr int PTR_OFF = MISC_OFF + 256;
__device__ __forceinline__ const float* ld_inptr(LAS unsigned char* lds, int k) {
    const unsigned long long v = ((volatile LAS unsigned long long*)(lds + PTR_OFF))[k];
    const unsigned lo = __builtin_amdgcn_readfirstlane((unsigned)v), hi = __builtin_amdgcn_readfirstlane((unsigned)(v >> 32));
    return (const float*)(((unsigned long long)hi << 32) | lo);
}
struct Args { const float* in[23]; float* out; unsigned char* ws; int ph_lo, ph_hi; };
__global__ void __launch_bounds__(NTHREADS, 2) mega_fwd(Args args) {
    extern __shared__ __attribute__((aligned(16))) unsigned char lds_raw[];
    LAS unsigned char* lds = (LAS unsigned char*)lds_raw;
    const int G_ = gridDim.x, ngw = G_ * NWAVES;
#define PHASE_IDS() const int tid = fresh_tid(), lane = tid & 63, wave = __builtin_amdgcn_readfirstlane(tid >> 6), cb = fresh_bid(), gw = cb * NWAVES + wave; (void)lane; (void)gw; (void)tid; \
        unsigned char* ws = fresh_ptr(args.ws); unsigned char* out_p = fresh_ptr((unsigned char*)args.out); (void)ws; (void)out_p
    for (int u = threadIdx.x; u < (LDS_BYTES - LDSCTL_OFF) / 4; u += NTHREADS) ((LAS unsigned*)(lds + LDSCTL_OFF))[u] = 0u;
    __syncthreads();
    if (threadIdx.x == 0) {
#pragma unroll
        for (int k = 0; k < 23; ++k) ((volatile LAS unsigned long long*)(lds + PTR_OFF))[k] = (unsigned long long)args.in[k];
    }
    __syncthreads();
#define INP(k) ld_inptr(lds, k)
    XcdBarrier bar = xcd_barrier_post((unsigned*)args.ws + CW_BAR, (volatile LAS unsigned*)(lds + MISC_OFF) + 8);
#define xout ((float*)out_p)
#define rs ((float*)(ws + OFF_RS))
#define rs_mem ((float*)(ws + OFF_RSMEM))
#define lse ((float*)(ws + OFF_LSE))
#define XB ((bf16_t*)(ws + OFF_XB))
#define U ((bf16_t*)(ws + OFF_U))
#define ZM ((bf16_t*)(ws + OFF_ZM))
#define ZS ((bf16_t*)(ws + OFF_ZS))
#define Q ((bf16_t*)(ws + OFF_Q))
#define Kb ((bf16_t*)(ws + OFF_K))
#define V ((bf16_t*)(ws + OFF_V))
#define ZA ((bf16_t*)(ws + OFF_ZA))
#define QM ((bf16_t*)(ws + OFF_QM))
#define Y ((bf16_t*)(ws + OFF_Y))
#define MG ((bf16_t*)(ws + OFF_MERGED))
#define MEMB ((bf16_t*)(ws + OFF_MEMB))
#define tab (ws + OFF_TAB)
    #define x INP(0)
#define mem INP(1)
#define norm_g INP(2)
#define mem_norm_g INP(3)
#define w_in INP(4)
#define b_gate INP(5)
#define lam_re INP(6)
#define lam_im INP(7)
#define log_dt INP(8)
#define b_re INP(9)
#define b_im INP(10)
#define c_re INP(11)
#define c_im INP(12)
#define ssm_d INP(13)
#define w_glu INP(14)
#define b_glu INP(15)
#define w_mem_kv INP(16)
#define w_br_ssm INP(17)
#define w_br_attn INP(18)
#define w_br_mem INP(19)
#define w_out INP(20)
#define rel_bias INP(21)
#define final_g INP(22)
#define WL(l, o) ((bf16_t*)(ws + OFF_W + (size_t)(l) * W_STRIDE + (o)))
#define GRID_BAR() xcd_barrier(bar)
#define TABGEN(l) tabgen(tab, lam_re + (l) * NG * NP, lam_im + (l) * NG * NP, log_dt + (l) * NG, b_re + (size_t)(l) * NG * NP * HG, b_im + (size_t)(l) * NG * NP * HG, \
                         c_re + (size_t)(l) * NG * HG * NP, c_im + (size_t)(l) * NG * HG * NP, ssm_d + (l) * D_SSM, (LAS float*)(lds + wave * 16384), gw, ngw, lane)
    {
        PHASE_IDS();
        LAS float* scr = (LAS float*)(lds + wave * 16384);
        for (int l = 0; l < DEPTH; ++l) {
            constexpr int I_IN = (1024 / 64) * (D_IN / 32), I_GLU = (768 / 64) * (768 / 32), I_B12 = (768 / 64) * (1024 / 32), I_B3 = (512 / 64) * (1024 / 32), I_SQ = (1024 / 64) * (1024 / 32);
            constexpr int NIT = I_IN + I_GLU + 2 * I_B12 + I_B3 + 2 * I_SQ;
            for (int it = gw; it < NIT; it += ngw) {
                int r = it;
                if (r < I_IN) { transpose_item(w_in + (size_t)l * 1024 * D_IN, 1024, D_IN, WL(l, WO_IN), 1024, norm_g + l * 1024, scr, r, lane); continue; } r -= I_IN;
                if (r < I_GLU) { transpose_item(w_glu + (size_t)l * 768 * 768, 768, 768, WL(l, WO_GLU), 768, nullptr, scr, r, lane); continue; } r -= I_GLU;
                if (r < I_B12) { transpose_item(w_br_ssm + (size_t)l * 768 * 1024, 768, 1024, WL(l, WO_B1), 768, nullptr, scr, r, lane); continue; } r -= I_B12;
                if (r < I_B12) { transpose_item(w_br_attn + (size_t)l * 768 * 1024, 768, 1024, WL(l, WO_B2), 768, nullptr, scr, r, lane); continue; } r -= I_B12;
                if (r < I_B3) { transpose_item(w_br_mem + (size_t)l * 512 * 1024, 512, 1024, WL(l, WO_B3), 512, nullptr, scr, r, lane); continue; } r -= I_B3;
                if (r < I_SQ) { transpose_item(w_out + (size_t)l * 1024 * 1024, 1024, 1024, WL(l, WO_OUT), 1024, nullptr, scr, r, lane); continue; } r -= I_SQ;
                transpose_item(w_mem_kv + (size_t)l * 1024 * 1024, 1024, 1024, WL(l, WO_MKV), 1024, mem_norm_g + l * 1024, scr, r, lane);
            }
        }
        for (int m = gw; m < T; m += ngw) rownorm_row(x, XB, rs, m, lane);
        for (int m = gw; m < BATCH * MEM_LEN; m += ngw) rownorm_row(mem, MEMB, rs_mem, m, lane);
        TABGEN(0);
    }
    GRID_BAR();
#pragma unroll 1
    for (int l = 0; l < DEPTH; ++l) {
#define KVM ((bf16_t*)(ws + OFF_KVM + (size_t)l * 2 * MiB))
        {
            PHASE_IDS();
            if (l > 0) { TABGEN(l); __syncthreads(); }
            ge::PA_Sched S{G_, cb, ws, ws + OFF_W + (size_t)l * W_STRIDE};
            ge::PA_Epi E{ws, l};
            ge::gemm_run(lds, S, E);
        }
        GRID_BAR();
        { PHASE_IDS(); attn_ref(Q, Kb, V, rel_bias, lse, gw, ngw, lane); }
        { PHASE_IDS(); memattn_ref(QM, KVM, ZM, gw, ngw, lane); }
        {
            PHASE_IDS();
            ge::PS_Sched S{cb, ws};
            ge::PS_Epi E{ws};
            ge::gemm_run(lds, S, E);
        }
        GRID_BAR();
        { PHASE_IDS(); for (int tok = gw; tok < T; tok += ngw) attn_final_tok(Q, lse, ZA, tok, lane); }
        {
            PHASE_IDS();
            ge::PY_Sched S{G_, cb, ws};
            ge::PY_Epi E{ws};
            ge::gemm_run(lds, S, E);
        }
        GRID_BAR();
        {
            PHASE_IDS();
            ge::PG_Sched S{G_, cb, ws, ws + OFF_W + (size_t)l * W_STRIDE};
            ge::PG_Epi E{ws, b_glu + l * 768};
            ge::gemm_run(lds, S, E);
        }
        GRID_BAR();
        {
            PHASE_IDS();
            ge::PM_Sched S{G_, cb, ws, ws + OFF_W + (size_t)l * W_STRIDE};
            ge::PM_Epi E{ws, b_gate + l * 3072, cb};
            ge::gemm_run(lds, S, E);
        }
        GRID_BAR();
        {
            PHASE_IDS();
            ge::PO_Sched S{G_, cb, ws, ws + OFF_W + (size_t)l * W_STRIDE};
            ge::PO_Epi E{l == 0 ? x : xout, xout};
            ge::gemm_run(lds, S, E);
        }
        GRID_BAR();
        { PHASE_IDS();
          if (l + 1 < DEPTH) { for (int m = gw; m < T; m += ngw) rownorm_row(xout, XB, rs, m, lane); }
          else { for (int m = gw; m < T; m += ngw) final_norm_row(xout, final_g, m, lane); } }
        if (l + 1 < DEPTH) GRID_BAR();
    }
}

extern "C" void kernel_launch(void* const* d_in, const int* in_sizes, int n_in, void* d_out, int out_size, void* d_ws, size_t ws_size, hipStream_t stream) {
    static int grid = 0;
    if (grid == 0) {
        if (n_in != 23 || ws_size < WS_NEED || out_size != T * D_MODEL) { fprintf(stderr, "kernel_launch: unexpected shapes (n_in %d, ws %zu, out %d)\n", n_in, ws_size, out_size); grid = -1; return; }
        int dev = 0, cus = 0, per_cu = 0;
        if (hipGetDevice(&dev) != hipSuccess || hipDeviceGetAttribute(&cus, hipDeviceAttributeMultiprocessorCount, dev) != hipSuccess) { grid = -1; return; }
        if (hipFuncSetAttribute((const void*)mega_fwd, hipFuncAttributeMaxDynamicSharedMemorySize, LDS_BYTES) != hipSuccess) { fprintf(stderr, "kernel_launch: hipFuncSetAttribute failed\n"); grid = -1; return; }
        if (hipOccupancyMaxActiveBlocksPerMultiprocessor(&per_cu, (const void*)mega_fwd, NTHREADS, LDS_BYTES) != hipSuccess || per_cu < 1) { fprintf(stderr, "kernel_launch: occupancy query says %d blocks/CU\n", per_cu); per_cu = 1; }
        (void)hipGetLastError();
        grid = cus * 1;
    }
    if (grid < 0) return;
    (void)hipMemsetAsync(d_ws, 0, CTL_ZERO_BYTES, stream);
    Args a{};
    for (int i = 0; i < 23; ++i) a.in[i] = (const float*)d_in[i];
    a.out = (float*)d_out; a.ws = (unsigned char*)d_ws; a.ph_lo = 0; a.ph_hi = 0;
    hipLaunchKernelGGL(mega_fwd, dim3(grid), dim3(NTHREADS), LDS_BYTES, stream, a);
}
```

```cpp
#include <hip/hip_runtime.h>
#include <cstdint>
#include <cstdio>

typedef unsigned short bf16_t;
typedef short bf16x8 __attribute__((ext_vector_type(8)));
typedef float f32x4 __attribute__((ext_vector_type(4)));
typedef float f32x16 __attribute__((ext_vector_type(16)));
typedef unsigned u32x4 __attribute__((ext_vector_type(4)));
typedef unsigned u32x2 __attribute__((ext_vector_type(2)));

constexpr int D_MODEL = 1024, BATCH = 4, SEQ = 8192, DEPTH = 2, T = BATCH * SEQ;
constexpr int D_SSM = 768, NG = 48, HG = 16, NP = 64;
constexpr int NH = 12, HD = 64, D_ATTN = 768;
constexpr int MEM_LEN = 256, MH = 4, MHD = 128, D_MEM = 512;
constexpr int D_IN = 8704, N_A1 = 5632;
constexpr float EPS = 1e-6f;

constexpr size_t MiB = 1u << 20;
constexpr size_t OFF_RS = 1 * MiB, OFF_RSMEM = 1 * MiB + 256 * 1024, OFF_LSE = 2 * MiB;
constexpr size_t OFF_W = 4 * MiB, W_STRIDE = 27 * MiB;
constexpr size_t WO_IN = 0, WO_GLU = 17 * MiB, WO_B1 = WO_GLU + 1179648, WO_B2 = WO_B1 + 1572864, WO_B3 = WO_B2 + 1572864, WO_OUT = WO_B3 + 1048576, WO_MKV = WO_OUT + 2 * MiB;
static_assert(WO_MKV + 2 * MiB <= W_STRIDE, "weights");
constexpr size_t OFF_KVM = 58 * MiB, OFF_MEMB = 62 * MiB, OFF_XB = 64 * MiB, OFF_U = 128 * MiB, OFF_ZM = 188 * MiB, OFF_ZS = 220 * MiB, OFF_Q = 268 * MiB,
                 OFF_K = 316 * MiB, OFF_V = 364 * MiB, OFF_ZA = 412 * MiB, OFF_QM = 460 * MiB, OFF_TAB = 492 * MiB, WS_NEED = 512 * MiB;
constexpr size_t OFF_Y = OFF_K, OFF_MERGED = OFF_U;

__device__ __forceinline__ unsigned f2bf(float f) { unsigned u = __builtin_bit_cast(unsigned, f); return (u + 0x7fffu + ((u >> 16) & 1u)) >> 16; }
__device__ __forceinline__ unsigned pk2(float lo, float hi) { return f2bf(lo) | (f2bf(hi) << 16); }
__device__ __forceinline__ float bflo(unsigned u) { return __builtin_bit_cast(float, u << 16); }
__device__ __forceinline__ float bfhi(unsigned u) { return __builtin_bit_cast(float, u & 0xffff0000u); }
__device__ __forceinline__ float bf2f(bf16_t h) { return __builtin_bit_cast(float, (unsigned)h << 16); }
__device__ __forceinline__ float sigmoidf_(float x) { return 1.f / (1.f + __expf(-x)); }
__device__ __forceinline__ float siluf_(float x) { return x * sigmoidf_(x); }
__device__ __forceinline__ float gelu_tanh(float y) { return 0.5f * y * (1.f + tanhf(0.7978845608028654f * (y + 0.044715f * y * y * y))); }
__device__ __forceinline__ float wave_sum(float v) {
#pragma unroll
    for (int o = 1; o < 64; o <<= 1) v += __shfl_xor(v, o);
    return v;
}
__device__ __forceinline__ float wave_max(float v) {
#pragma unroll
    for (int o = 1; o < 64; o <<= 1) v = fmaxf(v, __shfl_xor(v, o));
    return v;
}

#define GAS __attribute__((address_space(1)))
#define LAS __attribute__((address_space(3)))
constexpr int NWAVES = 8, NTHREADS = 512;
constexpr int RING_BYTES = 131072, LDS_BYTES = 147456, LDSCTL_OFF = LDS_BYTES - 1024, MISC_OFF = LDSCTL_OFF + 320;
constexpr size_t CTL_ZERO_BYTES = 1 * MiB; constexpr int CW_BAR = 4096;

#define XB_TMO      128
#define XB_XCNT(j)  (256  + 64 * (j))
#define XB_XSUB(j)  (1280 + 64 * (j))
#define XB_XGEN(j)  (2304 + 64 * (j))
#define XB_TOP      3328
#define XB_TOPGEN   3392
#define XCD_BAR_WORDS 3456
#define XB_SPIN_CAP (1u << 18)
__device__ __forceinline__ unsigned xb_ld(unsigned* p)              { return __hip_atomic_load(p, __ATOMIC_RELAXED, __HIP_MEMORY_SCOPE_AGENT); }
__device__ __forceinline__ unsigned xb_add(unsigned* p, unsigned v) { return __hip_atomic_fetch_add(p, v, __ATOMIC_RELAXED, __HIP_MEMORY_SCOPE_AGENT); }
__device__ __forceinline__ unsigned xb_xcc_id() { return (unsigned)__builtin_amdgcn_s_getreg((3 << 11) | 20) & 0xFu; }
#define XB_SPIN(cond, bar) do { unsigned _sp = 0; while (cond) { __builtin_amdgcn_s_sleep(1); \
    if ((++_sp & 255u) == 0u) { if (xb_ld(&(bar)[XB_TMO])) break; if (_sp > XB_SPIN_CAP) { atomicAdd(&(bar)[XB_TMO], 1u); break; } } } } while (0)
struct XcdBarrier { unsigned* bar; unsigned x; volatile LAS unsigned* st; };
__device__ __forceinline__ XcdBarrier xcd_barrier_post(unsigned* bar, volatile LAS unsigned* st) {
    XcdBarrier b; b.bar = bar; b.x = xb_xcc_id(); b.st = st;
    if (threadIdx.x == 0) (void)xb_add(&bar[XB_XCNT(b.x)], 1u);
    return b;
}
__device__ __forceinline__ void xcd_barrier_complete(unsigned* bar, unsigned x, unsigned& nloc, unsigned& nx) {
    const unsigned G = gridDim.x * gridDim.y * gridDim.z;
    unsigned sum, cnt, mine, sp = 0u;
    for (;;) {
        sum = 0u; cnt = 0u; mine = 0u;
#pragma unroll
        for (unsigned j = 0; j < 16; ++j) { const unsigned c = xb_ld(&bar[XB_XCNT(j)]); sum += c; cnt += (c > 0u) ? 1u : 0u; mine = (j == x) ? c : mine; }
        if (sum == G) break;
        __builtin_amdgcn_s_sleep(1);
        if ((++sp & 255u) == 0u) { if (xb_ld(&bar[XB_TMO])) break; if (sp > XB_SPIN_CAP) { atomicAdd(&bar[XB_TMO], 1u); break; } }
    }
    nloc = mine > 0u ? mine : 1u; nx = cnt > 0u ? cnt : 1u;
}
__device__ __forceinline__ void xcd_barrier(const XcdBarrier& b) {
    asm volatile("s_waitcnt vmcnt(0)" ::: "memory");
    __syncthreads();
    if (threadIdx.x == 0) {
        unsigned* bar = b.bar;
        __builtin_amdgcn_s_waitcnt(0);
        unsigned nloc = b.st[0], nx = b.st[1];
        if (nloc == 0u) { xcd_barrier_complete(bar, b.x, nloc, nx); b.st[0] = nloc; b.st[1] = nx; }
        const unsigned old = xb_add(&bar[XB_XSUB(b.x)], 1u);
        const unsigned gen = old / nloc;
        if (old + 1u == (gen + 1u) * nloc) {
            __builtin_amdgcn_fence(__ATOMIC_RELEASE, "agent");
            asm volatile("s_waitcnt vmcnt(0)" ::: "memory");
            const unsigned og = xb_add(&bar[XB_TOP], 1u);
            const unsigned tg = og / nx;
            if (og + 1u == (tg + 1u) * nx) xb_add(&bar[XB_TOPGEN], 1u);
            else XB_SPIN(xb_ld(&bar[XB_TOPGEN]) == tg, bar);
            __builtin_amdgcn_fence(__ATOMIC_ACQUIRE, "agent");
            xb_add(&bar[XB_XGEN(b.x)], 1u);
            asm volatile("s_waitcnt vmcnt(0)" ::: "memory");
        } else {
            XB_SPIN(xb_ld(&bar[XB_XGEN(b.x)]) == gen, bar);
            __builtin_amdgcn_fence(__ATOMIC_ACQUIRE, "agent");
            asm volatile("s_waitcnt vmcnt(0)" ::: "memory");
        }
    }
    __syncthreads();
}

__device__ __forceinline__ void transpose_item(const float* __restrict__ W, int K, int N, bf16_t* __restrict__ WT, int ldt, const float* __restrict__ kscale, LAS float* scr, int item, int lane) {
    const int nblk = N / 32, kb = item / nblk, nb = item % nblk, k0 = 64 * kb, n0 = 32 * nb;
#pragma unroll 8
    for (int i = 0; i < 32; ++i) { const int kk = 2 * i + (lane >> 5); const float s = kscale ? kscale[k0 + kk] : 1.f; scr[kk * 33 + (lane & 31)] = W[(size_t)(k0 + kk) * N + n0 + (lane & 31)] * s; }
    asm volatile("s_waitcnt lgkmcnt(0)" ::: "memory");
    const int c = lane & 7;
#pragma unroll
    for (int j = 0; j < 4; ++j) { const int n = (lane >> 3) + 8 * j; const LAS float* s = scr + (8 * c) * 33 + n;
        u32x4 o; o.x = pk2(s[0 * 33], s[1 * 33]); o.y = pk2(s[2 * 33], s[3 * 33]); o.z = pk2(s[4 * 33], s[5 * 33]); o.w = pk2(s[6 * 33], s[7 * 33]);
        *(u32x4*)(WT + (size_t)(n0 + n) * ldt + k0 + 8 * c) = o; }
    asm volatile("s_waitcnt lgkmcnt(0)" ::: "memory");
}
__device__ __forceinline__ void rownorm_row(const float* __restrict__ x, bf16_t* __restrict__ xb, float* __restrict__ rs, int row, int lane) {
    const f32x4* xr = (const f32x4*)(x + (size_t)row * 1024) + lane;
    f32x4 v[4]; float s = 0.f;
#pragma unroll
    for (int j = 0; j < 4; ++j) { v[j] = xr[64 * j]; s += (v[j].x * v[j].x + v[j].y * v[j].y) + (v[j].z * v[j].z + v[j].w * v[j].w); }
    s = wave_sum(s);
    u32x2* o = (u32x2*)(xb + (size_t)row * 1024) + lane;
#pragma unroll
    for (int j = 0; j < 4; ++j) o[64 * j] = (u32x2){pk2(v[j].x, v[j].y), pk2(v[j].z, v[j].w)};
    if (lane == 0) rs[row] = 1.0f / sqrtf(s * (1.f / 1024.f) + EPS);
}
__device__ __forceinline__ void final_norm_row(float* __restrict__ x, const float* __restrict__ g, int row, int lane) {
    f32x4* xr = (f32x4*)(x + (size_t)row * 1024) + lane; const f32x4* gr = (const f32x4*)g + lane;
    f32x4 v[4]; float s = 0.f;
#pragma unroll
    for (int j = 0; j < 4; ++j) { v[j] = xr[64 * j]; s += (v[j].x * v[j].x + v[j].y * v[j].y) + (v[j].z * v[j].z + v[j].w * v[j].w); }
    s = wave_sum(s); const float r = 1.0f / sqrtf(s * (1.f / 1024.f) + EPS);
#pragma unroll
    for (int j = 0; j < 4; ++j) xr[64 * j] = v[j] * r * gr[64 * j];
}

struct EpiA1 {
    const float* rs; bf16_t *U, *ZS, *Q, *Kb, *V, *ZA, *QM, *ZM;
    __device__ __forceinline__ void operator()(int m, int n, f32x4 v) const {
        v = v * rs[m]; bf16_t* dst; bool silu = false; float sc = 1.f;
        if (n < 768) dst = U + (size_t)m * 768 + n;
        else if (n < 1536) { dst = ZS + (size_t)m * 768 + (n - 768); silu = true; }
        else if (n < 2304) { dst = Q + (size_t)m * 768 + (n - 1536); sc = 0.125f; }
        else if (n < 3072) dst = Kb + (size_t)m * 768 + (n - 2304);
        else if (n < 3840) dst = V + (size_t)m * 768 + (n - 3072);
        else if (n < 4608) { dst = ZA + (size_t)m * 768 + (n - 3840); silu = true; }
        else if (n < 5120) { dst = QM + (size_t)m * 512 + (n - 4608); sc = 0.08838834764831845f; }
        else { dst = ZM + (size_t)m * 512 + (n - 5120); silu = true; }
        if (silu) { v.x = siluf_(v.x); v.y = siluf_(v.y); v.z = siluf_(v.z); v.w = siluf_(v.w); }
        v = v * sc;
        *(u32x2*)dst = (u32x2){pk2(v.x, v.y), pk2(v.z, v.w)};
    }
};
struct EpiKvm {
    const float* rs; bf16_t* O;
    __device__ __forceinline__ void operator()(int m, int n, f32x4 v) const { v = v * rs[m]; *(u32x2*)(O + (size_t)m * 1024 + n) = (u32x2){pk2(v.x, v.y), pk2(v.z, v.w)}; }
};
struct EpiGlu {
    const bf16_t* Y; bf16_t* ZS; const float* b;
    __device__ __forceinline__ void operator()(int m, int n, f32x4 v) const {
        const u32x2 y = *(const u32x2*)(Y + (size_t)m * 768 + n); u32x2* zp = (u32x2*)(ZS + (size_t)m * 768 + n); const u32x2 z = *zp; const f32x4 bb = *(const f32x4*)(b + n);
        const float o0 = bflo(y.x) * sigmoidf_(v.x + bb.x) * bflo(z.x), o1 = bfhi(y.x) * sigmoidf_(v.y + bb.y) * bfhi(z.x);
        const float o2 = bflo(y.y) * sigmoidf_(v.z + bb.z) * bflo(z.y), o3 = bfhi(y.y) * sigmoidf_(v.w + bb.w) * bfhi(z.y);
        *zp = (u32x2){pk2(o0, o1), pk2(o2, o3)};
    }
};
struct EpiOut {
    const float* xold; float* xnew;
    __device__ __forceinline__ void operator()(int m, int n, f32x4 v) const { const size_t o = (size_t)m * 1024 + n; *(f32x4*)(xnew + o) = *(const f32x4*)(xold + o) + v; }
};
template <class Epi>
__device__ __forceinline__ void wgemm(const bf16_t* __restrict__ A, int lda, const bf16_t* __restrict__ Bt, int ldb, int M, int N, int K, const Epi& epi, int gw, int ngw, int lane) {
    const int r = lane & 31, hi = lane >> 5; const int ntn = N / 64, ntiles = (M / 64) * ntn;
    for (int tile = gw; tile < ntiles; tile += ngw) {
        const int m0 = (tile / ntn) * 64, n0 = (tile % ntn) * 64;
        f32x16 acc[2][2];
#pragma unroll
        for (int i = 0; i < 2; ++i)
#pragma unroll
            for (int j = 0; j < 2; ++j)
#pragma unroll
                for (int q = 0; q < 16; ++q) acc[i][j][q] = 0.f;
        const bf16_t* ap = A + (size_t)(m0 + r) * lda + 8 * hi;
        const bf16_t* bp = Bt + (size_t)(n0 + r) * ldb + 8 * hi;
        for (int k = 0; k < K; k += 16) {
            const bf16x8 a0 = *(const bf16x8*)(ap + k), a1 = *(const bf16x8*)(ap + (size_t)32 * lda + k);
            const bf16x8 b0 = *(const bf16x8*)(bp + k), b1 = *(const bf16x8*)(bp + (size_t)32 * ldb + k);
            acc[0][0] = __builtin_amdgcn_mfma_f32_32x32x16_bf16(b0, a0, acc[0][0], 0, 0, 0);
            acc[0][1] = __builtin_amdgcn_mfma_f32_32x32x16_bf16(b1, a0, acc[0][1], 0, 0, 0);
            acc[1][0] = __builtin_amdgcn_mfma_f32_32x32x16_bf16(b0, a1, acc[1][0], 0, 0, 0);
            acc[1][1] = __builtin_amdgcn_mfma_f32_32x32x16_bf16(b1, a1, acc[1][1], 0, 0, 0);
        }
#pragma unroll
        for (int mi = 0; mi < 2; ++mi)
#pragma unroll
            for (int ni = 0; ni < 2; ++ni)
#pragma unroll
                for (int q = 0; q < 4; ++q)
                    epi(m0 + 32 * mi + r, n0 + 32 * ni + 8 * q + 4 * hi, (f32x4){acc[mi][ni][4 * q], acc[mi][ni][4 * q + 1], acc[mi][ni][4 * q + 2], acc[mi][ni][4 * q + 3]});
    }
}
__device__ __forceinline__ void merge_ref(const bf16_t* __restrict__ XB, const float* __restrict__ rs, const bf16_t* __restrict__ WinT, const float* __restrict__ bg,
                                          const bf16_t* __restrict__ OS, const bf16_t* __restrict__ OA, const bf16_t* __restrict__ OM,
                                          const bf16_t* __restrict__ W1, const bf16_t* __restrict__ W2, const bf16_t* __restrict__ W3, bf16_t* __restrict__ MG, int gw, int ngw, int lane) {
    const int r = lane & 31, hi = lane >> 5;
    for (int tile = gw; tile < (T / 32) * 32; tile += ngw) {
        const int m0 = (tile >> 5) * 32, n0 = (tile & 31) * 32;
        f32x16 L0, L1, L2, P0, P1, P2;
#pragma unroll
        for (int q = 0; q < 16; ++q) { L0[q] = 0.f; L1[q] = 0.f; L2[q] = 0.f; P0[q] = 0.f; P1[q] = 0.f; P2[q] = 0.f; }
        {
            const bf16_t* ap = XB + (size_t)(m0 + r) * 1024 + 8 * hi; const bf16_t* bp = WinT + (size_t)(N_A1 + n0 + r) * 1024 + 8 * hi;
            for (int k = 0; k < 1024; k += 16) {
                const bf16x8 a = *(const bf16x8*)(ap + k);
                L0 = __builtin_amdgcn_mfma_f32_32x32x16_bf16(*(const bf16x8*)(bp + k), a, L0, 0, 0, 0);
                L1 = __builtin_amdgcn_mfma_f32_32x32x16_bf16(*(const bf16x8*)(bp + (size_t)1024 * 1024 + k), a, L1, 0, 0, 0);
                L2 = __builtin_amdgcn_mfma_f32_32x32x16_bf16(*(const bf16x8*)(bp + (size_t)2048 * 1024 + k), a, L2, 0, 0, 0);
            }
        }
        {
            const bf16_t* ap = OS + (size_t)(m0 + r) * 768 + 8 * hi; const bf16_t* bp = W1 + (size_t)(n0 + r) * 768 + 8 * hi;
            for (int k = 0; k < 768; k += 16) P0 = __builtin_amdgcn_mfma_f32_32x32x16_bf16(*(const bf16x8*)(bp + k), *(const bf16x8*)(ap + k), P0, 0, 0, 0);
        }
        {
            const bf16_t* ap = OA + (size_t)(m0 + r) * 768 + 8 * hi; const bf16_t* bp = W2 + (size_t)(n0 + r) * 768 + 8 * hi;
            for (int k = 0; k < 768; k += 16) P1 = __builtin_amdgcn_mfma_f32_32x32x16_bf16(*(const bf16x8*)(bp + k), *(const bf16x8*)(ap + k), P1, 0, 0, 0);
        }
        {
            const bf16_t* ap = OM + (size_t)(m0 + r) * 512 + 8 * hi; const bf16_t* bp = W3 + (size_t)(n0 + r) * 512 + 8 * hi;
            for (int k = 0; k < 512; k += 16) P2 = __builtin_amdgcn_mfma_f32_32x32x16_bf16(*(const bf16x8*)(bp + k), *(const bf16x8*)(ap + k), P2, 0, 0, 0);
        }
        const int m = m0 + r; const float rsm = rs[m];
#pragma unroll
        for (int q = 0; q < 4; ++q) {
            const int n = n0 + 8 * q + 4 * hi; float o[4];
#pragma unroll
            for (int e = 0; e < 4; ++e) {
                const int rg = 4 * q + e;
                const float g0 = sigmoidf_(rsm * L0[rg] + bg[n + e]), g1 = sigmoidf_(rsm * L1[rg] + bg[1024 + n + e]), g2 = sigmoidf_(rsm * L2[rg] + bg[2048 + n + e]);
                o[e] = g0 * P0[rg] + g1 * P1[rg] + g2 * P2[rg];
            }
            *(u32x2*)(MG + (size_t)m * 1024 + n) = (u32x2){pk2(o[0], o[1]), pk2(o[2], o[3])};
        }
    }
}

__device__ __forceinline__ void ssm_ref(int b, int g, int lane, LAS float* xs, const bf16_t* __restrict__ U, bf16_t* __restrict__ Y, const float* __restrict__ lam_re, const float* __restrict__ lam_im,
                                        const float* __restrict__ log_dt, const float* __restrict__ b_re, const float* __restrict__ b_im,
                                        const float* __restrict__ c_re, const float* __restrict__ c_im, const float* __restrict__ dvec) {
    const float dt = expf(log_dt[g]); const float lre = lam_re[g * 64 + lane], lim = lam_im[g * 64 + lane];
    const float mag = expf(lre * dt); const float ar = mag * cosf(lim * dt), ai = mag * sinf(lim * dt);
    const float den = lre * lre + lim * lim, nr = ar - 1.0f, ni = ai;
    const float fr = (nr * lre + ni * lim) / den, fi = (ni * lre - nr * lim) / den;
    float bbr[16], bbi[16];
#pragma unroll
    for (int h = 0; h < 16; ++h) { const float br = b_re[(g * 64 + lane) * 16 + h], bi = b_im[(g * 64 + lane) * 16 + h]; bbr[h] = fr * br - fi * bi; bbi[h] = fr * bi + fi * br; }
    const int hq = lane & 15, part = lane >> 4;
    float cr[16], ci[16];
#pragma unroll
    for (int i = 0; i < 16; ++i) { cr[i] = c_re[(g * 16 + hq) * 64 + part * 16 + i]; ci[i] = c_im[(g * 16 + hq) * 64 + part * 16 + i]; }
    const float dd = dvec[g * 16 + hq];
    float xr = 0.f, xi = 0.f;
    const bf16_t* up = U + (size_t)b * SEQ * 768 + g * 16; bf16_t* yp = Y + (size_t)b * SEQ * 768 + g * 16;
    for (int t = 0; t < SEQ; ++t) {
        const u32x4 ua = *(const u32x4*)(up + (size_t)t * 768), ub = *(const u32x4*)(up + (size_t)t * 768 + 8);
        const float uh = bf2f(up[(size_t)t * 768 + hq]);
        float u[16];
        u[0] = bflo(ua.x); u[1] = bfhi(ua.x); u[2] = bflo(ua.y); u[3] = bfhi(ua.y); u[4] = bflo(ua.z); u[5] = bfhi(ua.z); u[6] = bflo(ua.w); u[7] = bfhi(ua.w);
        u[8] = bflo(ub.x); u[9] = bfhi(ub.x); u[10] = bflo(ub.y); u[11] = bfhi(ub.y); u[12] = bflo(ub.z); u[13] = bfhi(ub.z); u[14] = bflo(ub.w); u[15] = bfhi(ub.w);
        float bur = 0.f, bui = 0.f;
#pragma unroll
        for (int h = 0; h < 16; ++h) { bur += bbr[h] * u[h]; bui += bbi[h] * u[h]; }
        const float nxr = ar * xr - ai * xi + bur, nxi = ar * xi + ai * xr + bui; xr = nxr; xi = nxi;
        xs[lane] = xr; xs[64 + lane] = xi;
        asm volatile("s_waitcnt lgkmcnt(0)" ::: "memory");
        float acc = 0.f;
#pragma unroll
        for (int i = 0; i < 16; ++i) acc += cr[i] * xs[part * 16 + i] - ci[i] * xs[64 + part * 16 + i];
        acc += __shfl_xor(acc, 16); acc += __shfl_xor(acc, 32);
        asm volatile("s_waitcnt lgkmcnt(0)" ::: "memory");
        if (lane < 16) yp[(size_t)t * 768 + lane] = (bf16_t)f2bf(gelu_tanh(acc + dd * uh));
    }
}

__device__ __forceinline__ int rel_bucket(int n) {
    if (n < 16) return n;
    const float v = logf((float)n / 16.0f) / 4.852030263919617f * 16.0f;
    const int lg = 16 + (int)v; return lg < 31 ? lg : 31;
}
__device__ __forceinline__ float dot8(const u32x4 a, const u32x4 b) {
    return bflo(a.x) * bflo(b.x) + bfhi(a.x) * bfhi(b.x) + bflo(a.y) * bflo(b.y) + bfhi(a.y) * bfhi(b.y) + bflo(a.z) * bflo(b.z) + bfhi(a.z) * bfhi(b.z) + bflo(a.w) * bflo(b.w) + bfhi(a.w) * bfhi(b.w);
}
__device__ __forceinline__ void attn_ref(bf16_t* Q, const bf16_t* __restrict__ Kb, const bf16_t* __restrict__ V, const float* __restrict__ rel_bias, float* __restrict__ lse, int gw, int ngw, int lane) {
    for (int item = gw; item < T * NH; item += ngw) {
        const int head = item % NH, tok = item / NH, t = tok % SEQ, row0 = tok - t;
        const int grp = head >> 2, r = grp == 0 ? 1 : (grp == 1 ? 4 : 16);
        bf16_t* qp = Q + (size_t)tok * 768 + head * 64;
        u32x4 qv[8];
#pragma unroll
        for (int i = 0; i < 8; ++i) qv[i] = ((const u32x4*)qp)[i];
        float s[3]; bool ok[3];
#pragma unroll
        for (int sl = 0; sl < 3; ++sl) {
            const int j = sl * 64 + lane, p = t - j * r; ok[sl] = (j <= 128) && (p >= 0); s[sl] = -1e30f;
            if (ok[sl]) {
                const u32x4* kp = (const u32x4*)(Kb + (size_t)(row0 + p) * 768 + head * 64); float d = 0.f;
#pragma unroll
                for (int i = 0; i < 8; ++i) d += dot8(qv[i], kp[i]);
                s[sl] = d + rel_bias[rel_bucket(j * r) * NH + head];
            }
        }
        const float m = wave_max(fmaxf(fmaxf(s[0], s[1]), s[2]));
        float e[3];
#pragma unroll
        for (int sl = 0; sl < 3; ++sl) e[sl] = ok[sl] ? __expf(s[sl] - m) : 0.f;
        const float l = wave_sum(e[0] + e[1] + e[2]);
        float o = 0.f;
#pragma unroll
        for (int sl = 0; sl < 3; ++sl) {
            for (int jj = 0; jj < 64; ++jj) {
                const int j = sl * 64 + jj, p = t - j * r; if (j > 128 || p < 0) break;
                const float pj = __shfl(e[sl], jj);
                o += pj * bf2f(V[(size_t)(row0 + p) * 768 + head * 64 + lane]);
            }
        }
        qp[lane] = (bf16_t)f2bf(o / l);
        if (lane == 0) lse[(size_t)tok * NH + head] = m + logf(l);
    }
}
__device__ __forceinline__ void attn_final_tok(bf16_t* __restrict__ Q, const float* __restrict__ lse, const bf16_t* __restrict__ ZA, int tok, int lane) {
    const float* lp = lse + (size_t)tok * NH;
    for (int c = lane * 4; c < 768; c += 256) {
        const int head = c >> 6, hh = head & 3; const float l0 = lp[hh], l1 = lp[4 + hh], l2 = lp[8 + hh];
        const float mx = fmaxf(fmaxf(l0, l1), l2); const float e0 = __expf(l0 - mx), e1 = __expf(l1 - mx), e2 = __expf(l2 - mx);
        const float mine = head < 4 ? e0 : (head < 8 ? e1 : e2); const float al = mine / (e0 + e1 + e2);
        u32x2* qp = (u32x2*)(Q + (size_t)tok * 768 + c); const u32x2 o = *qp; const u32x2 z = *(const u32x2*)(ZA + (size_t)tok * 768 + c);
        *qp = (u32x2){pk2(bflo(o.x) * al * bflo(z.x), bfhi(o.x) * al * bfhi(z.x)), pk2(bflo(o.y) * al * bflo(z.y), bfhi(o.y) * al * bfhi(z.y))};
    }
}
__device__ __forceinline__ void memattn_ref(bf16_t* QM, const bf16_t* __restrict__ KVM, const bf16_t* __restrict__ ZM, int gw, int ngw, int lane) {
    for (int item = gw; item < T * MH; item += ngw) {
        const int head = item & 3, tok = item >> 2, b = tok / SEQ;
        bf16_t* qp = QM + (size_t)tok * 512 + head * 128;
        u32x4 qv[16];
#pragma unroll
        for (int i = 0; i < 16; ++i) qv[i] = ((const u32x4*)qp)[i];
        float s[4];
#pragma unroll
        for (int sl = 0; sl < 4; ++sl) {
            const int j = sl * 64 + lane; const u32x4* kp = (const u32x4*)(KVM + (size_t)(b * 256 + j) * 1024 + head * 128); float d = 0.f;
#pragma unroll
            for (int i = 0; i < 16; ++i) d += dot8(qv[i], kp[i]);
            s[sl] = d;
        }
        const float m = wave_max(fmaxf(fmaxf(s[0], s[1]), fmaxf(s[2], s[3])));
        float e[4];
#pragma unroll
        for (int sl = 0; sl < 4; ++sl) e[sl] = __expf(s[sl] - m);
        const float l = wave_sum((e[0] + e[1]) + (e[2] + e[3]));
        float o0 = 0.f, o1 = 0.f;
#pragma unroll
        for (int sl = 0; sl < 4; ++sl)
            for (int jj = 0; jj < 64; ++jj) {
                const int j = sl * 64 + jj; const float pj = __shfl(e[sl], jj);
                const bf16_t* vp = KVM + (size_t)(b * 256 + j) * 1024 + 512 + head * 128;
                o0 += pj * bf2f(vp[lane]); o1 += pj * bf2f(vp[64 + lane]);
            }
        const bf16_t* zp = ZM + (size_t)tok * 512 + head * 128;
        qp[lane] = (bf16_t)f2bf(o0 / l * bf2f(zp[lane])); qp[64 + lane] = (bf16_t)f2bf(o1 / l * bf2f(zp[64 + lane]));
    }
}

constexpr size_t TAB_TOEP = 0, TAB_CST = 2 * MiB, TAB_WST = 8 * MiB, TAB_AQ = 15 * MiB;
__device__ __forceinline__ int fresh_tid() { int t = threadIdx.x; asm volatile("" : "+v"(t)); return t; }
__device__ __forceinline__ unsigned char* fresh_ptr(unsigned char* p) { asm volatile("" : "+s"(p)); return p; }
__device__ __forceinline__ int fresh_bid() { int b = blockIdx.x; asm volatile("" : "+s"(b)); return b; }
namespace ge {
constexpr int BM = 256, BK = 64, HALF = 128, HTB = HALF * BK * 2, STAGE_BYTES = 8 * HTB;
__device__ __forceinline__ int lds_byte(int r, int c) { const int st = (r >> 4) * 2 + (c >> 5), rr = r & 15, cc = c & 31, ob = rr * 64 + cc * 2; return st * 1024 + (ob ^ (((ob >> 9) & 1) << 5)); }
__device__ __forceinline__ void stage_rc(int b, int& R, int& C) { const int st = b / 1024, sb = b % 1024, swz = sb ^ (((sb >> 9) & 1) << 5); R = (st >> 1) * 16 + swz / 64; C = (st & 1) * 32 + (swz % 64) / 2; }
__device__ __forceinline__ int perm32(int rho) { const int n = rho >> 4, i = rho & 15; return 8 * (i >> 2) + 4 * n + (i & 3); }
enum { A_STD = 0, A_GM = 1 };
enum { B_STD = 0, B_PERM = 1, B_TOEP = 2 };
struct Seg { const char* A; const char* B; int a_h, b_h, a_k, b_k, npairs, amode, bmode; unsigned lda2, ldb2; };
struct Unit { int type, pm, pn, g; };
typedef f32x4 Acc[2][2][4][2];

template <class Sched, class Epi>
__device__ __forceinline__ void gemm_run(LAS unsigned char* lds, const Sched& S, const Epi& E) {
    const int tid = fresh_tid(), wid = __builtin_amdgcn_readfirstlane(tid >> 6), lane = tid & 63, wr = wid >> 2, wc = wid & 3, fr = lane & 15, fq = lane >> 4;
    const unsigned ldsw = (unsigned)wid * 1024u;
    const int aoff = lds_byte(wr * 64 + fr, fq * 8), boff = lds_byte(wc * 32 + fr, fq * 8);
#define GE_SA(b, h) (((b) * 2 + (h)) * HTB)
#define GE_SB(b, h) ((4 + (b) * 2 + (h)) * HTB)
#define GE_STAGE(bufoff, gbase, voff) do { _Pragma("unroll") for (int _i = 0; _i < 2; ++_i) \
        __builtin_amdgcn_global_load_lds((const unsigned*)((const char*)(gbase) + (voff)[_i]), (LAS unsigned*)(lds + (bufoff) + ldsw + _i * 8192), 16, 0, 0); } while (0)
#define GE_LDA(dst, b, h) do { _Pragma("unroll") for (int m = 0; m < 4; ++m) _Pragma("unroll") for (int k = 0; k < 2; ++k) dst[m][k] = *(const LAS bf16x8*)(lds + GE_SA(b, h) + aoff + m * 2048 + k * 1024); } while (0)
#define GE_LDB(dst, b, h) do { _Pragma("unroll") for (int n = 0; n < 2; ++n) _Pragma("unroll") for (int k = 0; k < 2; ++k) dst[n][k] = *(const LAS bf16x8*)(lds + GE_SB(b, h) + boff + n * 2048 + k * 1024); } while (0)
#define GE_MMA(ai, bj, At, Bt) do { __builtin_amdgcn_s_setprio(1); _Pragma("unroll") for (int m = 0; m < 4; ++m) _Pragma("unroll") for (int n = 0; n < 2; ++n) _Pragma("unroll") for (int k = 0; k < 2; ++k) \
        acc[ai][bj][m][n] = __builtin_amdgcn_mfma_f32_16x16x32_bf16(Bt[n][k], At[m][k], acc[ai][bj][m][n], 0, 0, 0); __builtin_amdgcn_s_setprio(0); } while (0)
#define GE_WAIT_V(n) asm volatile("s_waitcnt vmcnt(" #n ")" ::: "memory")
#define GE_WAIT_L(n) asm volatile("s_waitcnt lgkmcnt(" #n ")" ::: "memory")
#define GE_BAR __builtin_amdgcn_s_barrier()
#define GE_SCHED __builtin_amdgcn_sched_barrier(0)
#define GE_VOFFS(sg, va, vb) do { _Pragma("unroll") for (int _i = 0; _i < 2; ++_i) { int R_, C_; stage_rc(tid * 16 + _i * 8192, R_, C_); const int Rp_ = (R_ & ~31) + perm32(R_ & 31); \
        va[_i] = (sg).amode == A_GM ? (unsigned)(R_ * 32 + (C_ >> 4) * (T * 32) + (C_ & 15) * 2) : (unsigned)R_ * (sg).lda2 + (unsigned)(C_ * 2); \
        vb[_i] = (sg).bmode == B_TOEP ? (unsigned)((((Rp_ >> 4) - (C_ >> 4) + 3) * 256 + (Rp_ & 15) * 16 + (C_ & 15)) * 2) : (unsigned)((sg).bmode == B_PERM ? Rp_ : R_) * (sg).ldb2 + (unsigned)(C_ * 2); } } while (0)
    Unit nu; int nui = 0;
    if (!S.unit(0, nu)) return;
    Seg ns; int nsi = 0, npi = 0; S.seg(nu, 0, ns);
    const char* npa = ns.A; const char* npb = ns.B; unsigned nva[2], nvb[2]; GE_VOFFS(ns, nva, nvb);
    bool nreal = true;
    Unit cu; int csi; bool c_lastseg, c_lastunit; const char* c_a1h; unsigned cva[2];
#define GE_ADVANCE() do { ++npi; if (npi < ns.npairs) { npa += 2 * ns.a_k; npb += 2 * ns.b_k; } else { npi = 0; ++nsi; \
        if (nsi >= S.nseg(nu)) { nsi = 0; Unit tu; if (S.unit(nui + 1, tu)) { ++nui; nu = tu; } else nreal = false; } \
        S.seg(nu, nsi, ns); npa = ns.A; npb = ns.B; GE_VOFFS(ns, nva, nvb); } } while (0)
#define GE_SHIFT() do { cu = nu; csi = nsi; c_lastseg = (npi == ns.npairs - 1); c_lastunit = c_lastseg && (nsi == S.nseg(nu) - 1); \
        c_a1h = npa + ns.a_k + ns.a_h; cva[0] = nva[0]; cva[1] = nva[1]; GE_ADVANCE(); } while (0)
    Acc acc;
#pragma unroll
    for (int a = 0; a < 2; ++a)
#pragma unroll
        for (int b = 0; b < 2; ++b)
#pragma unroll
            for (int m = 0; m < 4; ++m)
#pragma unroll
                for (int n = 0; n < 2; ++n) acc[a][b][m][n] = (f32x4){0.f, 0.f, 0.f, 0.f};
    bf16x8 At[4][2], B0[2][2], B1[2][2];
    GE_STAGE(GE_SB(0, 0), npb, nvb); GE_STAGE(GE_SB(0, 1), npb + ns.b_h, nvb); GE_STAGE(GE_SA(0, 0), npa, nva); GE_STAGE(GE_SA(0, 1), npa + ns.a_h, nva);
    if (wr == 1) GE_BAR;
    GE_WAIT_V(2); GE_BAR;
    GE_STAGE(GE_SB(1, 0), npb + ns.b_k, nvb); GE_STAGE(GE_SA(1, 0), npa + ns.a_k, nva); GE_STAGE(GE_SB(1, 1), npb + ns.b_k + ns.b_h, nvb);
    GE_WAIT_V(6); GE_BAR;
    GE_SHIFT();
    for (;;) {
        GE_LDB(B0, 0, 0); GE_LDB(B1, 0, 1); GE_SCHED; GE_LDA(At, 0, 0); GE_STAGE(GE_SA(1, 1), c_a1h, cva);
        GE_WAIT_V(8); GE_WAIT_L(0); GE_BAR; GE_MMA(0, 0, At, B0); GE_MMA(0, 1, At, B1); GE_BAR; GE_SCHED;
        GE_LDA(At, 0, 1); GE_STAGE(GE_SB(0, 0), npb, nvb); GE_STAGE(GE_SB(0, 1), npb + ns.b_h, nvb); GE_STAGE(GE_SA(0, 0), npa, nva);
        GE_WAIT_V(8); GE_WAIT_L(0); GE_BAR; GE_MMA(1, 0, At, B0); GE_MMA(1, 1, At, B1); GE_BAR; GE_SCHED;
        GE_LDB(B0, 1, 0); GE_LDB(B1, 1, 1); GE_SCHED; GE_LDA(At, 1, 0); GE_STAGE(GE_SA(0, 1), npa + ns.a_h, nva);
        GE_WAIT_V(8); GE_WAIT_L(0); GE_BAR; GE_MMA(0, 0, At, B0); GE_MMA(0, 1, At, B1); GE_BAR; GE_SCHED;
        GE_LDA(At, 1, 1); GE_STAGE(GE_SB(1, 0), npb + ns.b_k, nvb); GE_STAGE(GE_SB(1, 1), npb + ns.b_k + ns.b_h, nvb); GE_STAGE(GE_SA(1, 0), npa + ns.a_k, nva);
        GE_WAIT_V(8); GE_WAIT_L(0); GE_BAR; GE_MMA(1, 0, At, B0); GE_MMA(1, 1, At, B1); GE_BAR; GE_SCHED;
        if (c_lastunit) {
            if (wr == 0) GE_BAR;
            { int fr_ = fr, fq_ = fq; asm volatile("" : "+v"(fr_), "+v"(fq_)); E.finish(acc, cu, wr, wc, fr_, fq_); }
            if (!nreal) break;
#pragma unroll
            for (int a = 0; a < 2; ++a)
#pragma unroll
                for (int b = 0; b < 2; ++b)
#pragma unroll
                    for (int m = 0; m < 4; ++m)
#pragma unroll
                        for (int n = 0; n < 2; ++n) acc[a][b][m][n] = (f32x4){0.f, 0.f, 0.f, 0.f};
            if (wr == 1) GE_BAR;
        } else if (c_lastseg) {
            { int fr_ = fr, fq_ = fq; asm volatile("" : "+v"(fr_), "+v"(fq_)); E.seg_end(acc, cu, csi, wr, wc, fr_, fq_); }
        }
        GE_SHIFT();
    }
    GE_WAIT_V(0);
    GE_BAR;
    { int fr_ = fr, fq_ = fq; asm volatile("" : "+v"(fr_), "+v"(fq_)); E.after_drain(acc, cu, lds, wr, wc, fr_, fq_); }
#undef GE_SA
#undef GE_SB
#undef GE_STAGE
#undef GE_LDA
#undef GE_LDB
#undef GE_MMA
#undef GE_WAIT_V
#undef GE_WAIT_L
#undef GE_BAR
#undef GE_SCHED
#undef GE_VOFFS
#undef GE_ADVANCE
#undef GE_SHIFT
}
__device__ __forceinline__ bool static_tile(int i, int G, int c, int nM, int nN, int& pm, int& pn) {
    const int nwg = nM * nN; const long L = (long)i * G + c; if (L >= nwg) return false;
    int wgid = (int)L; { const int q = nwg / 8, r = nwg % 8, xcd = wgid % 8, off = wgid / 8; wgid = (xcd < r ? xcd * (q + 1) : r * (q + 1) + (xcd - r) * q) + off; }
    const int nig = 8 * nN, gid = wgid / nig, fm = gid * 8, gsz = (nM - fm) < 8 ? (nM - fm) : 8;
    pm = fm + ((wgid % nig) % gsz); pn = (wgid % nig) / gsz; return true;
}
__device__ __forceinline__ unsigned cvt_pk_bf16(float lo, float hi) { unsigned r; asm volatile("v_cvt_pk_bf16_f32 %0, %1, %2" : "=v"(r) : "v"(lo), "v"(hi)); return r; }
__device__ __forceinline__ u32x4 pack8(const f32x4 a, const f32x4 b) { u32x4 w; w.x = cvt_pk_bf16(a[0], a[1]); w.y = cvt_pk_bf16(a[2], a[3]); w.z = cvt_pk_bf16(b[0], b[1]); w.w = cvt_pk_bf16(b[2], b[3]); return w; }
__device__ __forceinline__ void unpack8(const u32x4 w, f32x4& a, f32x4& b) { a = (f32x4){bflo(w.x), bfhi(w.x), bflo(w.y), bfhi(w.y)}; b = (f32x4){bflo(w.z), bfhi(w.z), bflo(w.w), bfhi(w.w)}; }
__device__ __forceinline__ float fsigm(float x) { return __builtin_amdgcn_rcpf(1.f + __builtin_amdgcn_exp2f(-1.4426950408889634f * x)); }
__device__ __forceinline__ float fgelu(float y) { return y * fsigm(1.5957691216057308f * (y + 0.044715f * y * y * y)); }
__device__ __forceinline__ f32x4 silu4(f32x4 v) { return (f32x4){v[0] * fsigm(v[0]), v[1] * fsigm(v[1]), v[2] * fsigm(v[2]), v[3] * fsigm(v[3])}; }
__device__ __forceinline__ f32x4 sigm4(f32x4 v) { return (f32x4){fsigm(v[0]), fsigm(v[1]), fsigm(v[2]), fsigm(v[3])}; }
__device__ __forceinline__ f32x4 gelu4(f32x4 v) { return (f32x4){fgelu(v[0]), fgelu(v[1]), fgelu(v[2]), fgelu(v[3])}; }
#define GE_FOR_PERM(...) _Pragma("unroll") for (int ai = 0; ai < 2; ++ai) _Pragma("unroll") for (int m = 0; m < 4; ++m) _Pragma("unroll") for (int bj = 0; bj < 2; ++bj) { \
        const int row = ai * HALF + wr * 64 + m * 16 + fr, col8 = bj * HALF + wc * 32 + 8 * fq; __VA_ARGS__ asm volatile("" ::: "memory"); }

struct PA_Sched {
    int G, c; const unsigned char *ws, *wl;
    __device__ __forceinline__ bool unit(int i, Unit& u) const {
        constexpr int nwg = (T / 256) * (N_A1 / 256); const int nA = c < nwg ? (nwg - c + G - 1) / G : 0;
        if (i < nA) { u.type = 0; u.g = 0; return static_tile(i, G, c, T / 256, N_A1 / 256, u.pm, u.pn); }
        if (i == nA && c < 16) { u.type = 1; u.pm = c >> 2; u.pn = c & 3; u.g = 0; return true; }
        return false;
    }
    __device__ __forceinline__ int nseg(const Unit&) const { return 1; }
    __device__ __forceinline__ void seg(const Unit& u, int, Seg& s) const {
        s.A = (const char*)(ws + (u.type == 0 ? OFF_XB : OFF_MEMB)) + (size_t)u.pm * 256 * 2048; s.B = (const char*)(wl + (u.type == 0 ? WO_IN : WO_MKV)) + (size_t)u.pn * 256 * 2048;
        s.a_h = 128 * 2048; s.b_h = 128 * 2048; s.a_k = 128; s.b_k = 128; s.npairs = 8; s.amode = A_STD; s.bmode = B_PERM; s.lda2 = 2048; s.ldb2 = 2048;
    }
};
struct PA_Epi {
    unsigned char* ws; int l;
    __device__ __forceinline__ void seg_end(Acc&, const Unit&, int, int, int, int, int) const {}
    __device__ __forceinline__ void after_drain(Acc&, const Unit&, LAS unsigned char*, int, int, int, int) const {}
    __device__ __forceinline__ void finish(Acc& acc, const Unit& u, int wr, int wc, int fr, int fq) const {
        const int pn = u.pn;
        if (u.type == 1) {
            const float* rsm = (const float*)(ws + OFF_RSMEM); bf16_t* KVM = (bf16_t*)(ws + OFF_KVM + (size_t)l * 2 * MiB);
            GE_FOR_PERM({ const int tr = u.pm * 256 + row; const float r = rsm[tr]; *(u32x4*)(KVM + (size_t)tr * 1024 + pn * 256 + col8) = pack8(acc[ai][bj][m][0] * r, acc[ai][bj][m][1] * r); })
            return;
        }
        const float* rs = (const float*)(ws + OFF_RS);
        if (pn < 3) {
            bf16_t* U = (bf16_t*)(ws + OFF_U);
            GE_FOR_PERM({ const int tr = u.pm * 256 + row; const float r = rs[tr]; const int c = pn * 256 + col8;
                *(u32x4*)(U + ((size_t)(c >> 4) * 1024 + (tr >> 5)) * 640 + (tr & 31) * 16 + (c & 15)) = pack8(acc[ai][bj][m][0] * r, acc[ai][bj][m][1] * r); })
        } else if (pn < 18) {
            const int k = (pn - 3) / 3; const size_t off = k == 0 ? OFF_ZS : (k == 1 ? OFF_Q : (k == 2 ? OFF_K : (k == 3 ? OFF_V : OFF_ZA)));
            bf16_t* D = (bf16_t*)(ws + off); const bool silu = (k == 0 || k == 4); const float sc = k == 1 ? 0.125f * 1.4426950408889634f : 1.0f;
            const int cb = (pn - 3 - 3 * k) * 256;
            GE_FOR_PERM({ const int tr = u.pm * 256 + row; const float r = rs[tr]; f32x4 v0 = acc[ai][bj][m][0] * r, v1 = acc[ai][bj][m][1] * r;
                if (silu) { v0 = silu4(v0); v1 = silu4(v1); } v0 = v0 * sc; v1 = v1 * sc;
                *(u32x4*)(D + (size_t)tr * 768 + cb + col8) = pack8(v0, v1); })
        } else {
            const bool isz = pn >= 20; bf16_t* D = (bf16_t*)(ws + (isz ? OFF_ZM : OFF_QM)); const int cb = (pn - (isz ? 20 : 18)) * 256; const float sc = isz ? 1.0f : 0.08838834764831845f * 1.4426950408889634f;
            GE_FOR_PERM({ const int tr = u.pm * 256 + row; const float r = rs[tr]; f32x4 v0 = acc[ai][bj][m][0] * r, v1 = acc[ai][bj][m][1] * r;
                if (isz) { v0 = silu4(v0); v1 = silu4(v1); } v0 = v0 * sc; v1 = v1 * sc;
                *(u32x4*)(D + (size_t)tr * 512 + cb + col8) = pack8(v0, v1); })
        }
    }
};
struct PS_Sched {
    int c; const unsigned char* ws;
    __device__ __forceinline__ bool unit(int i, Unit& u) const { if (i != 0 || c >= BATCH * NG) return false; u.type = 0; u.g = c % NG; u.pm = c / NG; u.pn = 0; return true; }
    __device__ __forceinline__ int nseg(const Unit&) const { return 1; }
    __device__ __forceinline__ void seg(const Unit& u, int, Seg& s) const {
        s.A = (const char*)((const bf16_t*)(ws + OFF_U) + ((size_t)u.g * 1024 + u.pm * 256) * 640); s.B = (const char*)((const bf16_t*)(ws + OFF_TAB + TAB_WST) + (size_t)u.g * 128 * 512);
        s.a_h = 128 * 1280; s.b_h = 128 * 1024; s.a_k = 128; s.b_k = 128; s.npairs = 4; s.amode = A_STD; s.bmode = B_STD; s.lda2 = 1280; s.ldb2 = 1024;
    }
};
struct PS_Epi {
    unsigned char* ws;
    __device__ __forceinline__ void seg_end(Acc&, const Unit&, int, int, int, int, int) const {}
    __device__ __forceinline__ void finish(Acc&, const Unit&, int, int, int, int) const {}
    __device__ __forceinline__ void after_drain(Acc& acc, const Unit& u, LAS unsigned char* lds, int wr, int wc, int fr, int fq) const {
        LAS float* Sl = (LAS float*)lds;
#pragma unroll
        for (int ai = 0; ai < 2; ++ai)
#pragma unroll
            for (int m = 0; m < 4; ++m)
#pragma unroll
                for (int n = 0; n < 2; ++n) *(LAS f32x4*)(Sl + (ai * HALF + wr * 64 + m * 16 + fr) * 128 + wc * 32 + 16 * n + 4 * fq) = acc[ai][0][m][n];
        asm volatile("s_waitcnt lgkmcnt(0)" ::: "memory"); __builtin_amdgcn_s_barrier(); asm volatile("" ::: "memory");
        if (wr * 4 + wc == 0) {
            const float* AQ = (const float*)(ws + OFF_TAB + TAB_AQ); const int p = fq * 16 + fr; const float ar = AQ[(u.g * 64 + p) * 2], ai_ = AQ[(u.g * 64 + p) * 2 + 1];
            float xr = 0.f, xi = 0.f; bf16_t* up = (bf16_t*)(ws + OFF_U) + ((size_t)u.g * 1024 + u.pm * 256) * 640 + 512 + p;
            for (int c = 0; c < 256; ++c) {
                up[(size_t)c * 640] = (bf16_t)f2bf(xr); up[(size_t)c * 640 + 64] = (bf16_t)f2bf(xi);
                const float sr = Sl[c * 128 + p], si = Sl[c * 128 + 64 + p];
                const float nxr = ar * xr - ai_ * xi + sr, nxi = ar * xi + ai_ * xr + si; xr = nxr; xi = nxi;
            }
        }
    }
};
struct PY_Sched {
    int G, c; const unsigned char* ws;
    __device__ __forceinline__ bool unit(int i, Unit& u) const {
        const int L = i * G + c; if (L >= 2 * BATCH * NG) return false;
        const int q = L % (BATCH * NG); u.type = 0; u.pn = L < BATCH * NG ? 1 : 0; u.g = q % NG; u.pm = q / NG; return true;
    }
    __device__ __forceinline__ int nseg(const Unit&) const { return 2; }
    __device__ __forceinline__ void seg(const Unit& u, int si, Seg& s) const {
        const char* Arow = (const char*)((const bf16_t*)(ws + OFF_U) + ((size_t)u.g * 1024 + u.pm * 256) * 640);
        s.a_h = 128 * 1280; s.a_k = 128; s.amode = A_STD; s.lda2 = 1280;
        if (si == 0) { s.A = Arow; s.B = (const char*)((const bf16_t*)(ws + OFF_TAB + TAB_TOEP) + (size_t)u.g * 48 * 256) + (16 * u.pn + 13) * 512; s.b_h = 8 * 512; s.b_k = -2048; s.npairs = 2 * (u.pn + 1); s.bmode = B_TOEP; s.ldb2 = 0; }
        else { s.A = Arow + 1024; s.B = (const char*)((const bf16_t*)(ws + OFF_TAB + TAB_CST) + ((size_t)u.g * 512 + u.pn * 256) * 128); s.b_h = 128 * 256; s.b_k = 128; s.npairs = 1; s.bmode = B_PERM; s.ldb2 = 256; }
    }
};
struct PY_Epi {
    unsigned char* ws;
    __device__ __forceinline__ void seg_end(Acc&, const Unit&, int, int, int, int, int) const {}
    __device__ __forceinline__ void after_drain(Acc&, const Unit&, LAS unsigned char*, int, int, int, int) const {}
    __device__ __forceinline__ void finish(Acc& acc, const Unit& u, int wr, int wc, int fr, int fq) const {
        bf16_t* base = (bf16_t*)(ws + OFF_Y) + (size_t)u.g * T * 16 + (size_t)(u.pm * 256) * 512 + u.pn * 256;
        GE_FOR_PERM({ *(u32x4*)(base + (size_t)row * 512 + col8) = pack8(gelu4(acc[ai][bj][m][0]), gelu4(acc[ai][bj][m][1])); })
    }
};
struct PG_Sched {
    int G, c; const unsigned char *ws, *wl;
    __device__ __forceinline__ bool unit(int i, Unit& u) const { u.type = 0; u.g = 0; return static_tile(i, G, c, T / 256, 3, u.pm, u.pn); }
    __device__ __forceinline__ int nseg(const Unit&) const { return 1; }
    __device__ __forceinline__ void seg(const Unit& u, int, Seg& s) const {
        s.A = (const char*)(ws + OFF_Y) + (size_t)u.pm * 256 * 32; s.B = (const char*)(wl + WO_GLU) + (size_t)u.pn * 256 * 1536;
        s.a_h = 128 * 32; s.a_k = 4 * T * 32; s.amode = A_GM; s.lda2 = 0; s.b_h = 128 * 1536; s.b_k = 128; s.bmode = B_PERM; s.ldb2 = 1536; s.npairs = 6;
    }
};
struct PG_Epi {
    unsigned char* ws; const float* b;
    __device__ __forceinline__ void seg_end(Acc&, const Unit&, int, int, int, int, int) const {}
    __device__ __forceinline__ void after_drain(Acc&, const Unit&, LAS unsigned char*, int, int, int, int) const {}
    __device__ __forceinline__ void finish(Acc& acc, const Unit& u, int wr, int wc, int fr, int fq) const {
        const bf16_t* Y = (const bf16_t*)(ws + OFF_Y); bf16_t* ZS = (bf16_t*)(ws + OFF_ZS);
        GE_FOR_PERM({ const int tr = u.pm * 256 + row, c = u.pn * 256 + col8;
            f32x4 y0, y1, z0, z1; unpack8(*(const u32x4*)(Y + ((size_t)(c >> 4) * T + tr) * 16 + (c & 15)), y0, y1);
            u32x4* zp = (u32x4*)(ZS + (size_t)tr * 768 + c); unpack8(*zp, z0, z1);
            const f32x4 b0 = *(const f32x4*)(b + c), b1 = *(const f32x4*)(b + c + 4);
            *zp = pack8(y0 * sigm4(acc[ai][bj][m][0] + b0) * z0, y1 * sigm4(acc[ai][bj][m][1] + b1) * z1); })
    }
};
struct PM_Sched {
    int G, c; const unsigned char *ws, *wl;
    __device__ __forceinline__ bool unit(int i, Unit& u) const { const int t = i / 6; u.type = i - 6 * t; u.g = 0; return static_tile(t, G, c, T / 256, 4, u.pm, u.pn); }
    __device__ __forceinline__ int nseg(const Unit&) const { return 1; }
    __device__ __forceinline__ void seg(const Unit& u, int, Seg& s) const {
        s.a_k = 128; s.b_k = 128; s.amode = A_STD; s.bmode = B_PERM;
        if ((u.type & 1) == 0) { s.A = (const char*)(ws + OFF_XB) + (size_t)u.pm * 256 * 2048; s.B = (const char*)(wl + WO_IN) + (size_t)(N_A1 + (u.type >> 1) * 1024 + u.pn * 256) * 2048; s.lda2 = 2048; s.ldb2 = 2048; s.npairs = 8; }
        else if (u.type == 1) { s.A = (const char*)(ws + OFF_ZS) + (size_t)u.pm * 256 * 1536; s.B = (const char*)(wl + WO_B1) + (size_t)u.pn * 256 * 1536; s.lda2 = 1536; s.ldb2 = 1536; s.npairs = 6; }
        else if (u.type == 3) { s.A = (const char*)(ws + OFF_Q) + (size_t)u.pm * 256 * 1536; s.B = (const char*)(wl + WO_B2) + (size_t)u.pn * 256 * 1536; s.lda2 = 1536; s.ldb2 = 1536; s.npairs = 6; }
        else { s.A = (const char*)(ws + OFF_QM) + (size_t)u.pm * 256 * 1024; s.B = (const char*)(wl + WO_B3) + (size_t)u.pn * 256 * 1024; s.lda2 = 1024; s.ldb2 = 1024; s.npairs = 4; }
        s.a_h = 128 * (int)s.lda2; s.b_h = 128 * (int)s.ldb2;
    }
};
typedef _Float16 f16x8 __attribute__((ext_vector_type(8)));
struct PM_Epi {
    unsigned char* ws; const float* bg; int c;
    __device__ __forceinline__ void seg_end(Acc&, const Unit&, int, int, int, int, int) const {}
    __device__ __forceinline__ void after_drain(Acc&, const Unit&, LAS unsigned char*, int, int, int, int) const {}
    __device__ __forceinline__ void finish(Acc& acc, const Unit& u, int wr, int wc, int fr, int fq) const {
        const int t_ = (wr * 4 + wc) * 64 + fq * 16 + fr;
        GAS unsigned char* st = (GAS unsigned char*)(ws + OFF_V + (size_t)c * 393216);
        if ((u.type & 1) == 0) {
            const float* bgs = bg + (u.type >> 1) * 1024 + u.pn * 256; const float* rs = (const float*)(ws + OFF_RS);
            GE_FOR_PERM({ const float r = rs[u.pm * 256 + row]; const f32x4 b0 = *(const f32x4*)(bgs + col8), b1 = *(const f32x4*)(bgs + col8 + 4);
                const f32x4 g0 = sigm4(acc[ai][bj][m][0] * r + b0), g1 = sigm4(acc[ai][bj][m][1] * r + b1); f16x8 h;
                h[0] = (_Float16)g0[0]; h[1] = (_Float16)g0[1]; h[2] = (_Float16)g0[2]; h[3] = (_Float16)g0[3]; h[4] = (_Float16)g1[0]; h[5] = (_Float16)g1[1]; h[6] = (_Float16)g1[2]; h[7] = (_Float16)g1[3];
                *(GAS f16x8*)(st + ((ai * 2 + bj) * 4 + m) * 8192 + t_ * 16) = h; })
        } else {
            GE_FOR_PERM({ const int idx = (ai * 2 + bj) * 4 + m; const f16x8 h = *(const GAS f16x8*)(st + idx * 8192 + t_ * 16);
                f32x4 v0 = acc[ai][bj][m][0], v1 = acc[ai][bj][m][1];
                _Pragma("unroll") for (int e = 0; e < 4; ++e) { v0[e] *= (float)h[e]; v1[e] *= (float)h[4 + e]; }
                GAS f32x4* ps = (GAS f32x4*)(st + 131072 + idx * 16384 + t_ * 32);
                if (u.type > 1) { v0 = v0 + ps[0]; v1 = v1 + ps[1]; }
                if (u.type < 5) { ps[0] = v0; ps[1] = v1; }
                else *(u32x4*)((bf16_t*)(ws + OFF_MERGED) + (size_t)(u.pm * 256 + row) * 1024 + u.pn * 256 + col8) = pack8(v0, v1); })
        }
    }
};
struct PO_Sched {
    int G, c; const unsigned char *ws, *wl;
    __device__ __forceinline__ bool unit(int i, Unit& u) const { u.type = 0; u.g = 0; return static_tile(i, G, c, T / 256, 4, u.pm, u.pn); }
    __device__ __forceinline__ int nseg(const Unit&) const { return 1; }
    __device__ __forceinline__ void seg(const Unit& u, int, Seg& s) const {
        s.A = (const char*)(ws + OFF_MERGED) + (size_t)u.pm * 256 * 2048; s.B = (const char*)(wl + WO_OUT) + (size_t)u.pn * 256 * 2048;
        s.a_h = 128 * 2048; s.b_h = 128 * 2048; s.a_k = 128; s.b_k = 128; s.npairs = 8; s.amode = A_STD; s.bmode = B_STD; s.lda2 = 2048; s.ldb2 = 2048;
    }
};
struct PO_Epi {
    const float* xold; float* xnew;
    __device__ __forceinline__ void seg_end(Acc&, const Unit&, int, int, int, int, int) const {}
    __device__ __forceinline__ void after_drain(Acc&, const Unit&, LAS unsigned char*, int, int, int, int) const {}
    __device__ __forceinline__ void finish(Acc& acc, const Unit& u, int wr, int wc, int fr, int fq) const {
#pragma unroll
        for (int ai = 0; ai < 2; ++ai)
#pragma unroll
            for (int m = 0; m < 4; ++m) { const size_t ro = (size_t)(u.pm * 256 + ai * HALF + wr * 64 + m * 16 + fr) * 1024 + u.pn * 256 + wc * 32 + 4 * fq;
#pragma unroll
                for (int bj = 0; bj < 2; ++bj)
#pragma unroll
                    for (int n = 0; n < 2; ++n) { const size_t o = ro + bj * HALF + n * 16; *(f32x4*)(xnew + o) = *(const f32x4*)(xold + o) + acc[ai][bj][m][n]; }
                asm volatile("" ::: "memory"); }
    }
};
}

__device__ __forceinline__ void cpow(float lmag, double rev1, int k, float& re, float& im) {
    const float m = expf((float)k * lmag); double r = (double)k * rev1; r -= rint(r);
    const float a = (float)(r * 6.283185307179586476925286766559); re = m * cosf(a); im = m * sinf(a);
}
__device__ __forceinline__ void tabgen(unsigned char* tab, const float* __restrict__ lam_re, const float* __restrict__ lam_im, const float* __restrict__ log_dt, const float* __restrict__ b_re, const float* __restrict__ b_im,
                                       const float* __restrict__ c_re, const float* __restrict__ c_im, const float* __restrict__ dvec, LAS float* scr, int gw, int ngw, int lane) {
    bf16_t* TOEP = (bf16_t*)(tab + TAB_TOEP); bf16_t* CST = (bf16_t*)(tab + TAB_CST); bf16_t* WST = (bf16_t*)(tab + TAB_WST); float* AQ = (float*)(tab + TAB_AQ);
    for (int item = gw; item < NG * 32; item += ngw) {
        const int g = item >> 5, d = item & 31, p = lane;
        const float dt = expf(log_dt[g]); const float lre = lam_re[g * 64 + p], lim = lam_im[g * 64 + p];
        const float lmag = lre * dt; const double rev1 = (double)lim * (double)dt * 0.15915494309189533576888376337251;
        float fr, fi;
        {
            double r = rev1; r -= rint(r); const float bq = (float)(r * 6.283185307179586476925286766559);
            const float em1 = expm1f(lmag), sb2 = sinf(0.5f * bq); const float nr = em1 * cosf(bq) - 2.f * sb2 * sb2, ni = (em1 + 1.f) * sinf(bq);
            const float den = lre * lre + lim * lim; fr = (nr * lre + ni * lim) / den; fi = (ni * lre - nr * lim) / den;
        }
        float bbr[16], bbi[16];
#pragma unroll
        for (int h = 0; h < 16; ++h) { const float br = b_re[(g * 64 + p) * 16 + h], bi = b_im[(g * 64 + p) * 16 + h]; bbr[h] = fr * br - fi * bi; bbi[h] = fr * bi + fi * br; }
        float pr, pi;
        cpow(lmag, rev1, 31 - d, pr, pi);
        {
            unsigned wre[8], wim[8];
#pragma unroll
            for (int h = 0; h < 16; h += 2) { wre[h >> 1] = pk2(pr * bbr[h] - pi * bbi[h], pr * bbr[h + 1] - pi * bbi[h + 1]); wim[h >> 1] = pk2(pr * bbi[h] + pi * bbr[h], pr * bbi[h + 1] + pi * bbr[h + 1]); }
            u32x4* o0 = (u32x4*)(WST + ((size_t)g * 128 + p) * 512 + d * 16); u32x4* o1 = (u32x4*)(WST + ((size_t)g * 128 + 64 + p) * 512 + d * 16);
            o0[0] = (u32x4){wre[0], wre[1], wre[2], wre[3]}; o0[1] = (u32x4){wre[4], wre[5], wre[6], wre[7]};
            o1[0] = (u32x4){wim[0], wim[1], wim[2], wim[3]}; o1[1] = (u32x4){wim[4], wim[5], wim[6], wim[7]};
        }
        cpow(lmag, rev1, d + 1, pr, pi);
#pragma unroll 2
        for (int hq = 0; hq < 16; ++hq) { const float cr = c_re[(g * 16 + hq) * 64 + p], ci = c_im[(g * 16 + hq) * 64 + p];
            bf16_t* o = CST + ((size_t)g * 512 + d * 16 + hq) * 128; o[p] = (bf16_t)f2bf(cr * pr - ci * pi); o[64 + p] = (bf16_t)f2bf(-(cr * pi + ci * pr)); }
        cpow(lmag, rev1, d, pr, pi);
#pragma unroll
        for (int h = 0; h < 16; ++h) { scr[(p * 16 + h) * 2] = pr * bbr[h] - pi * bbi[h]; scr[(p * 16 + h) * 2 + 1] = pr * bbi[h] + pi * bbr[h]; }
        asm volatile("s_waitcnt lgkmcnt(0)" ::: "memory");
        {
            const int hq = lane >> 2, h0 = (lane & 3) * 4; float a0 = 0.f, a1 = 0.f, a2 = 0.f, a3 = 0.f;
            for (int q = 0; q < 64; ++q) { const float cr = c_re[(g * 16 + hq) * 64 + q], ci = c_im[(g * 16 + hq) * 64 + q]; const LAS float* s = scr + (q * 16 + h0) * 2;
                a0 += cr * s[0] - ci * s[1]; a1 += cr * s[2] - ci * s[3]; a2 += cr * s[4] - ci * s[5]; a3 += cr * s[6] - ci * s[7]; }
            if (d == 0) { const float dd = dvec[g * 16 + hq]; if (hq == h0) a0 += dd; if (hq == h0 + 1) a1 += dd; if (hq == h0 + 2) a2 += dd; if (hq == h0 + 3) a3 += dd; }
            *(u32x2*)(TOEP + ((size_t)g * 48 + 16 + d) * 256 + hq * 16 + h0) = (u32x2){pk2(a0, a1), pk2(a2, a3)};
            if (d < 16) *(u32x2*)(TOEP + ((size_t)g * 48 + d) * 256 + hq * 16 + h0) = (u32x2){0u, 0u};
        }
        asm volatile("s_waitcnt lgkmcnt(0)" ::: "memory");
        if (d == 0) { cpow(lmag, rev1, 32, pr, pi); AQ[(g * 64 + p) * 2] = pr; AQ[(g * 64 + p) * 2 + 1] = pi; }
    }
}

namespace at {
__device__ __forceinline__ int crow(int r, int hi) { return (r & 3) + 8 * (r >> 2) + 4 * hi; }
__device__ __forceinline__ unsigned cvtpk(float lo, float hi) { unsigned r; asm volatile("v_cvt_pk_bf16_f32 %0, %1, %2" : "=v"(r) : "v"(lo), "v"(hi)); return r; }
constexpr float LOG2E = 1.4426950408889634f, LN2 = 0.6931471805599453f;
constexpr int D_VTS = 388;
constexpr int D_LK = 0, D_LVT = 49152, D_LBIAS = D_LVT + 64 * D_VTS * 2, D_LSCR = D_LBIAS + 1024, D_LEND = D_LSCR + 8 * 128;
static_assert(D_LEND <= 146432, "dilated attention LDS");
__device__ __forceinline__ void dil_unit(LAS unsigned char* lds, unsigned char* ws, const float* __restrict__ rel_bias, int b, int head, int r, int s, int np, int tid) {
    const int lane = tid & 63, wave = __builtin_amdgcn_readfirstlane(tid >> 6), r32 = lane & 31, hi = lane >> 5;
    bf16_t* Q = (bf16_t*)(ws + OFF_Q); const bf16_t* Kb = (const bf16_t*)(ws + OFF_K); const bf16_t* V = (const bf16_t*)(ws + OFF_V); float* lse = (float*)(ws + OFF_LSE);
    const size_t rowbase = (size_t)b * SEQ; const int M0 = np * 256, mk0 = M0 - 128;
#pragma unroll
    for (int i = 0; i < 6; ++i) {
        const int idx = tid + 512 * i, key = idx >> 3, ch = idx & 7, mk = mk0 + key; u32x4 kv = (u32x4){0u, 0u, 0u, 0u};
        if (mk >= 0) kv = *(const u32x4*)(Kb + (rowbase + (size_t)mk * r + s) * 768 + head * 64 + ch * 8);
        *(LAS u32x4*)(lds + D_LK + key * 128 + ((ch ^ ((key >> 1) & 7)) << 4)) = kv;
    }
#pragma unroll
    for (int i = 0; i < 3; ++i) {
        const int idx = tid + 512 * i, key = (idx >> 3) * 2, ch = idx & 7, mk = mk0 + key; u32x4 v0 = (u32x4){0u, 0u, 0u, 0u}, v1 = v0;
        if (mk >= 0) { const bf16_t* vp = V + (rowbase + (size_t)mk * r + s) * 768 + head * 64 + ch * 8; v0 = *(const u32x4*)vp; v1 = *(const u32x4*)(vp + (size_t)r * 768); }
        LAS unsigned* vt = (LAS unsigned*)(lds + D_LVT + ((ch * 8) * D_VTS + key) * 2);
        vt[0 * (D_VTS / 2)] = (v0.x & 0xffffu) | (v1.x << 16); vt[1 * (D_VTS / 2)] = (v0.x >> 16) | (v1.x & 0xffff0000u);
        vt[2 * (D_VTS / 2)] = (v0.y & 0xffffu) | (v1.y << 16); vt[3 * (D_VTS / 2)] = (v0.y >> 16) | (v1.y & 0xffff0000u);
        vt[4 * (D_VTS / 2)] = (v0.z & 0xffffu) | (v1.z << 16); vt[5 * (D_VTS / 2)] = (v0.z >> 16) | (v1.z & 0xffff0000u);
        vt[6 * (D_VTS / 2)] = (v0.w & 0xffffu) | (v1.w << 16); vt[7 * (D_VTS / 2)] = (v0.w >> 16) | (v1.w & 0xffff0000u);
    }
    if (tid < 129) ((LAS float*)(lds + D_LBIAS))[tid] = rel_bias[rel_bucket(tid * r) * NH + head] * LOG2E;
    const size_t qtok = rowbase + (size_t)(M0 + 32 * wave + r32) * r + s;
    bf16x8 qf[4];
#pragma unroll
    for (int ks = 0; ks < 4; ++ks) qf[ks] = *(const bf16x8*)(Q + qtok * 768 + head * 64 + 16 * ks + 8 * hi);
    __syncthreads();
    f32x16 S[5];
#pragma unroll
    for (int t = 0; t < 5; ++t) {
#pragma unroll
        for (int q = 0; q < 16; ++q) S[t][q] = 0.f;
        const int key = 32 * (wave + t) + r32; const LAS unsigned char* kp = lds + D_LK + key * 128; const int sw = (key >> 1) & 7;
#pragma unroll
        for (int ks = 0; ks < 4; ++ks) S[t] = __builtin_amdgcn_mfma_f32_32x32x16_bf16(*(const LAS bf16x8*)(kp + (((2 * ks + hi) ^ sw) << 4)), qf[ks], S[t], 0, 0, 0);
    }
    const LAS float* biasl = (const LAS float*)(lds + D_LBIAS);
    float mx = -1e30f;
#pragma unroll
    for (int t = 0; t < 5; ++t)
#pragma unroll
        for (int q = 0; q < 16; ++q) {
            const int kk = crow(q, hi), delta = 128 + r32 - 32 * t - kk; const bool ok = (delta >= 0) && (delta <= 128) && (mk0 + 32 * (wave + t) + kk >= 0);
            const int di = delta < 0 ? 0 : (delta > 128 ? 128 : delta);
            const float v = ok ? S[t][q] + biasl[di] : -1e30f; S[t][q] = v; mx = fmaxf(mx, v);
        }
    mx = fmaxf(mx, __shfl_xor(mx, 32));
    float lsum = 0.f; unsigned pk[5][8];
#pragma unroll
    for (int t = 0; t < 5; ++t) {
#pragma unroll
        for (int q = 0; q < 16; ++q) { const float p = __builtin_amdgcn_exp2f(S[t][q] - mx); S[t][q] = p; lsum += p; }
#pragma unroll
        for (int q = 0; q < 8; ++q) pk[t][q] = cvtpk(S[t][2 * q], S[t][2 * q + 1]);
    }
    lsum += __shfl_xor(lsum, 32);
    f32x16 O[2];
#pragma unroll
    for (int d0 = 0; d0 < 2; ++d0)
#pragma unroll
        for (int q = 0; q < 16; ++q) O[d0][q] = 0.f;
#pragma unroll
    for (int t = 0; t < 5; ++t)
#pragma unroll
        for (int s2 = 0; s2 < 2; ++s2) {
            const bf16x8 A = __builtin_bit_cast(bf16x8, (u32x4){pk[t][4 * s2], pk[t][4 * s2 + 1], pk[t][4 * s2 + 2], pk[t][4 * s2 + 3]});
#pragma unroll
            for (int d0 = 0; d0 < 2; ++d0) {
                const LAS unsigned char* vp = lds + D_LVT + ((32 * d0 + r32) * D_VTS + 32 * (wave + t) + 16 * s2 + 4 * hi) * 2;
                const u32x2 lo = *(const LAS u32x2*)vp, hi2 = *(const LAS u32x2*)(vp + 16);
                O[d0] = __builtin_amdgcn_mfma_f32_32x32x16_bf16(A, __builtin_bit_cast(bf16x8, (u32x4){lo.x, lo.y, hi2.x, hi2.y}), O[d0], 0, 0, 0);
            }
        }
    LAS float* scr = (LAS float*)(lds + D_LSCR + wave * 128);
    if (hi == 0) { scr[r32] = __builtin_amdgcn_rcpf(lsum); lse[qtok * NH + head] = (mx + __builtin_amdgcn_logf(lsum)) * LN2; }
    __syncthreads();
    LAS bf16_t* stg = (LAS bf16_t*)(lds + D_LK + wave * 4096);
#pragma unroll
    for (int q = 0; q < 16; ++q) { const int orow = crow(q, hi); const float ri = scr[orow];
        stg[orow * 64 + r32] = (bf16_t)f2bf(O[0][q] * ri); stg[orow * 64 + 32 + r32] = (bf16_t)f2bf(O[1][q] * ri); }
    asm volatile("s_waitcnt lgkmcnt(0)" ::: "memory");
#pragma unroll
    for (int i = 0; i < 4; ++i) { const int row = i * 8 + (lane >> 3), ch = lane & 7;
        *(u32x4*)(Q + (rowbase + (size_t)(M0 + 32 * wave + row) * r + s) * 768 + head * 64 + ch * 8) = *(const LAS u32x4*)(stg + row * 64 + ch * 8); }
    __syncthreads();
}
constexpr int M_VTS = 260;
constexpr int M_LK = 0, M_LVT = 65536, M_LSCR = M_LVT + 128 * M_VTS * 2, M_LEND = M_LSCR + 8 * 128;
static_assert(M_LEND <= 146432, "memory attention LDS");
__device__ __forceinline__ void mem_unit(LAS unsigned char* lds, unsigned char* ws, int l, int b, int head, int qb, int tid) {
    const int lane = tid & 63, wave = __builtin_amdgcn_readfirstlane(tid >> 6), r32 = lane & 31, hi = lane >> 5;
    bf16_t* QM = (bf16_t*)(ws + OFF_QM); const bf16_t* ZM = (const bf16_t*)(ws + OFF_ZM); const bf16_t* KVM = (const bf16_t*)(ws + OFF_KVM + (size_t)l * 2 * MiB) + (size_t)b * 256 * 1024 + head * 128;
#pragma unroll
    for (int i = 0; i < 8; ++i) {
        const int idx = tid + 512 * i, key = idx >> 4, ch = idx & 15;
        *(LAS u32x4*)(lds + M_LK + key * 256 + ((ch ^ (key & 15)) << 4)) = *(const u32x4*)(KVM + (size_t)key * 1024 + ch * 8);
    }
#pragma unroll
    for (int i = 0; i < 4; ++i) {
        const int idx = tid + 512 * i, key = (idx >> 4) * 2, ch = idx & 15; const bf16_t* vp = KVM + (size_t)key * 1024 + 512 + ch * 8;
        const u32x4 v0 = *(const u32x4*)vp, v1 = *(const u32x4*)(vp + 1024);
        LAS unsigned* vt = (LAS unsigned*)(lds + M_LVT + ((ch * 8) * M_VTS + key) * 2);
        vt[0 * (M_VTS / 2)] = (v0.x & 0xffffu) | (v1.x << 16); vt[1 * (M_VTS / 2)] = (v0.x >> 16) | (v1.x & 0xffff0000u);
        vt[2 * (M_VTS / 2)] = (v0.y & 0xffffu) | (v1.y << 16); vt[3 * (M_VTS / 2)] = (v0.y >> 16) | (v1.y & 0xffff0000u);
        vt[4 * (M_VTS / 2)] = (v0.z & 0xffffu) | (v1.z << 16); vt[5 * (M_VTS / 2)] = (v0.z >> 16) | (v1.z & 0xffff0000u);
        vt[6 * (M_VTS / 2)] = (v0.w & 0xffffu) | (v1.w << 16); vt[7 * (M_VTS / 2)] = (v0.w >> 16) | (v1.w & 0xffff0000u);
    }
    const size_t qrow0 = (size_t)b * SEQ + qb * 256 + 32 * wave;
    __syncthreads();
    f32x16 S[8];
#pragma unroll
    for (int t = 0; t < 8; ++t)
#pragma unroll
        for (int q = 0; q < 16; ++q) S[t][q] = 0.f;
#pragma unroll
    for (int ks = 0; ks < 8; ++ks) {
        const bf16x8 qf = *(const bf16x8*)(QM + (qrow0 + r32) * 512 + head * 128 + 16 * ks + 8 * hi);
#pragma unroll
        for (int t = 0; t < 8; ++t) { const int key = 32 * t + r32;
            S[t] = __builtin_amdgcn_mfma_f32_32x32x16_bf16(*(const LAS bf16x8*)(lds + M_LK + key * 256 + (((2 * ks + hi) ^ (key & 15)) << 4)), qf, S[t], 0, 0, 0); }
    }
    float mx = -1e30f;
#pragma unroll
    for (int t = 0; t < 8; ++t)
#pragma unroll
        for (int q = 0; q < 16; ++q) mx = fmaxf(mx, S[t][q]);
    mx = fmaxf(mx, __shfl_xor(mx, 32));
    float lsum = 0.f; unsigned pk[8][8];
#pragma unroll
    for (int t = 0; t < 8; ++t) {
#pragma unroll
        for (int q = 0; q < 16; ++q) { const float p = __builtin_amdgcn_exp2f(S[t][q] - mx); S[t][q] = p; lsum += p; }
#pragma unroll
        for (int q = 0; q < 8; ++q) pk[t][q] = cvtpk(S[t][2 * q], S[t][2 * q + 1]);
    }
    lsum += __shfl_xor(lsum, 32);
    f32x16 O[4];
#pragma unroll
    for (int d0 = 0; d0 < 4; ++d0)
#pragma unroll
        for (int q = 0; q < 16; ++q) O[d0][q] = 0.f;
#pragma unroll
    for (int t = 0; t < 8; ++t)
#pragma unroll
        for (int s2 = 0; s2 < 2; ++s2) {
            const bf16x8 A = __builtin_bit_cast(bf16x8, (u32x4){pk[t][4 * s2], pk[t][4 * s2 + 1], pk[t][4 * s2 + 2], pk[t][4 * s2 + 3]});
#pragma unroll
            for (int d0 = 0; d0 < 4; ++d0) {
                const LAS unsigned char* vp = lds + M_LVT + ((32 * d0 + r32) * M_VTS + 32 * t + 16 * s2 + 4 * hi) * 2;
                const u32x2 lo = *(const LAS u32x2*)vp, hi2 = *(const LAS u32x2*)(vp + 16);
                O[d0] = __builtin_amdgcn_mfma_f32_32x32x16_bf16(A, __builtin_bit_cast(bf16x8, (u32x4){lo.x, lo.y, hi2.x, hi2.y}), O[d0], 0, 0, 0);
            }
        }
    LAS float* scr = (LAS float*)(lds + M_LSCR + wave * 128);
    if (hi == 0) scr[r32] = __builtin_amdgcn_rcpf(lsum);
    __syncthreads();
    LAS bf16_t* stg = (LAS bf16_t*)(lds + M_LK + wave * 8192);
#pragma unroll
    for (int q = 0; q < 16; ++q) { const int orow = crow(q, hi); const float ri = scr[orow];
#pragma unroll
        for (int d0 = 0; d0 < 4; ++d0) stg[orow * 128 + 32 * d0 + r32] = (bf16_t)f2bf(O[d0][q] * ri); }
    asm volatile("s_waitcnt lgkmcnt(0)" ::: "memory");
#pragma unroll
    for (int i = 0; i < 8; ++i) { const int row = i * 4 + (lane >> 4), ch = lane & 15; const size_t go = (qrow0 + row) * 512 + head * 128 + ch * 8;
        const u32x4 o = *(const LAS u32x4*)(stg + row * 128 + ch * 8), z = *(const u32x4*)(ZM + go);
        *(u32x4*)(QM + go) = (u32x4){pk2(bflo(o.x) * bflo(z.x), bfhi(o.x) * bfhi(z.x)), pk2(bflo(o.y) * bflo(z.y), bfhi(o.y) * bfhi(z.y)),
                                     pk2(bflo(o.z) * bflo(z.z), bfhi(o.z) * bfhi(z.z)), pk2(bflo(o.w) * bflo(z.w), bfhi(o.w) * bfhi(z.w))}; }
    __syncthreads();
}
}

constexpr int PTR_OFF = MISC_OFF + 256;
__device__ __forceinline__ const float* ld_inptr(LAS unsigned char* lds, int k) {
    const unsigned long long v = ((volatile LAS unsigned long long*)(lds + PTR_OFF))[k];
    const unsigned lo = __builtin_amdgcn_readfirstlane((unsigned)v), hi = __builtin_amdgcn_readfirstlane((unsigned)(v >> 32));
    return (const float*)(((unsigned long long)hi << 32) | lo);
}
struct Args { const float* in[23]; float* out; unsigned char* ws; int ph_lo, ph_hi; };
__global__ void __launch_bounds__(NTHREADS, 2) mega_fwd(Args args) {
    extern __shared__ __attribute__((aligned(16))) unsigned char lds_raw[];
    LAS unsigned char* lds = (LAS unsigned char*)lds_raw;
    const int G_ = gridDim.x, ngw = G_ * NWAVES;
#define PHASE_IDS() const int tid = fresh_tid(), lane = tid & 63, wave = __builtin_amdgcn_readfirstlane(tid >> 6), cb = fresh_bid(), gw = cb * NWAVES + wave; (void)lane; (void)gw; (void)tid; \
        unsigned char* ws = fresh_ptr(args.ws); unsigned char* out_p = fresh_ptr((unsigned char*)args.out); (void)ws; (void)out_p
    for (int u = threadIdx.x; u < (LDS_BYTES - LDSCTL_OFF) / 4; u += NTHREADS) ((LAS unsigned*)(lds + LDSCTL_OFF))[u] = 0u;
    __syncthreads();
    if (threadIdx.x == 0) {
#pragma unroll
        for (int k = 0; k < 23; ++k) ((volatile LAS unsigned long long*)(lds + PTR_OFF))[k] = (unsigned long long)args.in[k];
    }
    __syncthreads();
#define INP(k) ld_inptr(lds, k)
    XcdBarrier bar = xcd_barrier_post((unsigned*)args.ws + CW_BAR, (volatile LAS unsigned*)(lds + MISC_OFF) + 8);
#define xout ((float*)out_p)
#define rs ((float*)(ws + OFF_RS))
#define rs_mem ((float*)(ws + OFF_RSMEM))
#define lse ((float*)(ws + OFF_LSE))
#define XB ((bf16_t*)(ws + OFF_XB))
#define U ((bf16_t*)(ws + OFF_U))
#define ZM ((bf16_t*)(ws + OFF_ZM))
#define ZS ((bf16_t*)(ws + OFF_ZS))
#define Q ((bf16_t*)(ws + OFF_Q))
#define Kb ((bf16_t*)(ws + OFF_K))
#define V ((bf16_t*)(ws + OFF_V))
#define ZA ((bf16_t*)(ws + OFF_ZA))
#define QM ((bf16_t*)(ws + OFF_QM))
#define Y ((bf16_t*)(ws + OFF_Y))
#define MG ((bf16_t*)(ws + OFF_MERGED))
#define MEMB ((bf16_t*)(ws + OFF_MEMB))
#define tab (ws + OFF_TAB)
    #define x INP(0)
#define mem INP(1)
#define norm_g INP(2)
#define mem_norm_g INP(3)
#define w_in INP(4)
#define b_gate INP(5)
#define lam_re INP(6)
#define lam_im INP(7)
#define log_dt INP(8)
#define b_re INP(9)
#define b_im INP(10)
#define c_re INP(11)
#define c_im INP(12)
#define ssm_d INP(13)
#define w_glu INP(14)
#define b_glu INP(15)
#define w_mem_kv INP(16)
#define w_br_ssm INP(17)
#define w_br_attn INP(18)
#define w_br_mem INP(19)
#define w_out INP(20)
#define rel_bias INP(21)
#define final_g INP(22)
#define WL(l, o) ((bf16_t*)(ws + OFF_W + (size_t)(l) * W_STRIDE + (o)))
#define GRID_BAR() xcd_barrier(bar)
#define TABGEN(l) tabgen(tab, lam_re + (l) * NG * NP, lam_im + (l) * NG * NP, log_dt + (l) * NG, b_re + (size_t)(l) * NG * NP * HG, b_im + (size_t)(l) * NG * NP * HG, \
                         c_re + (size_t)(l) * NG * HG * NP, c_im + (size_t)(l) * NG * HG * NP, ssm_d + (l) * D_SSM, (LAS float*)(lds + wave * 16384), gw, ngw, lane)
    {
        PHASE_IDS();
        LAS float* scr = (LAS float*)(lds + wave * 16384);
        for (int l = 0; l < DEPTH; ++l) {
            constexpr int I_IN = (1024 / 64) * (D_IN / 32), I_GLU = (768 / 64) * (768 / 32), I_B12 = (768 / 64) * (1024 / 32), I_B3 = (512 / 64) * (1024 / 32), I_SQ = (1024 / 64) * (1024 / 32);
            constexpr int NIT = I_IN + I_GLU + 2 * I_B12 + I_B3 + 2 * I_SQ;
            for (int it = gw; it < NIT; it += ngw) {
                int r = it;
                if (r < I_IN) { transpose_item(w_in + (size_t)l * 1024 * D_IN, 1024, D_IN, WL(l, WO_IN), 1024, norm_g + l * 1024, scr, r, lane); continue; } r -= I_IN;
                if (r < I_GLU) { transpose_item(w_glu + (size_t)l * 768 * 768, 768, 768, WL(l, WO_GLU), 768, nullptr, scr, r, lane); continue; } r -= I_GLU;
                if (r < I_B12) { transpose_item(w_br_ssm + (size_t)l * 768 * 1024, 768, 1024, WL(l, WO_B1), 768, nullptr, scr, r, lane); continue; } r -= I_B12;
                if (r < I_B12) { transpose_item(w_br_attn + (size_t)l * 768 * 1024, 768, 1024, WL(l, WO_B2), 768, nullptr, scr, r, lane); continue; } r -= I_B12;
                if (r < I_B3) { transpose_item(w_br_mem + (size_t)l * 512 * 1024, 512, 1024, WL(l, WO_B3), 512, nullptr, scr, r, lane); continue; } r -= I_B3;
                if (r < I_SQ) { transpose_item(w_out + (size_t)l * 1024 * 1024, 1024, 1024, WL(l, WO_OUT), 1024, nullptr, scr, r, lane); continue; } r -= I_SQ;
                transpose_item(w_mem_kv + (size_t)l * 1024 * 1024, 1024, 1024, WL(l, WO_MKV), 1024, mem_norm_g + l * 1024, scr, r, lane);
            }
        }
        for (int m = gw; m < T; m += ngw) rownorm_row(x, XB, rs, m, lane);
        for (int m = gw; m < BATCH * MEM_LEN; m += ngw) rownorm_row(mem, MEMB, rs_mem, m, lane);
        TABGEN(0);
    }
    GRID_BAR();
#pragma unroll 1
    for (int l = 0; l < DEPTH; ++l) {
#define KVM ((bf16_t*)(ws + OFF_KVM + (size_t)l * 2 * MiB))
        {
            PHASE_IDS();
            if (l > 0) { TABGEN(l); __syncthreads(); }
            ge::PA_Sched S{G_, cb, ws, ws + OFF_W + (size_t)l * W_STRIDE};
            ge::PA_Epi E{ws, l};
            ge::gemm_run(lds, S, E);
        }
        GRID_BAR();
        {
            PHASE_IDS();
            for (int ui = cb; ui < BATCH * NH * 32; ui += G_) {
                const int u32i = ui & 31, bh = ui >> 5, head = bh % NH, b = bh / NH, grp = head >> 2, r = grp == 0 ? 1 : (grp == 1 ? 4 : 16), ppr = 32 / r;
                at::dil_unit(lds, ws, rel_bias, b, head, r, u32i / ppr, u32i % ppr, tid);
            }
        }
        {
            PHASE_IDS();
            for (int ui = cb; ui < BATCH * MH * 32; ui += G_) at::mem_unit(lds, ws, l, ui >> 7, (ui >> 5) & 3, ui & 31, tid);
        }
        {
            PHASE_IDS();
            ge::PS_Sched S{cb, ws};
            ge::PS_Epi E{ws};
            ge::gemm_run(lds, S, E);
        }
        GRID_BAR();
        { PHASE_IDS(); for (int tok = gw; tok < T; tok += ngw) attn_final_tok(Q, lse, ZA, tok, lane); }
        {
            PHASE_IDS();
            ge::PY_Sched S{G_, cb, ws};
            ge::PY_Epi E{ws};
            ge::gemm_run(lds, S, E);
        }
        GRID_BAR();
        {
            PHASE_IDS();
            ge::PG_Sched S{G_, cb, ws, ws + OFF_W + (size_t)l * W_STRIDE};
            ge::PG_Epi E{ws, b_glu + l * 768};
            ge::gemm_run(lds, S, E);
        }
        GRID_BAR();
        {
            PHASE_IDS();
            ge::PM_Sched S{G_, cb, ws, ws + OFF_W + (size_t)l * W_STRIDE};
            ge::PM_Epi E{ws, b_gate + l * 3072, cb};
            ge::gemm_run(lds, S, E);
        }
        GRID_BAR();
        {
            PHASE_IDS();
            ge::PO_Sched S{G_, cb, ws, ws + OFF_W + (size_t)l * W_STRIDE};
            ge::PO_Epi E{l == 0 ? x : xout, xout};
            ge::gemm_run(lds, S, E);
        }
        GRID_BAR();
        { PHASE_IDS();
          if (l + 1 < DEPTH) { for (int m = gw; m < T; m += ngw) rownorm_row(xout, XB, rs, m, lane); }
          else { for (int m = gw; m < T; m += ngw) final_norm_row(xout, final_g, m, lane); } }
        if (l + 1 < DEPTH) GRID_BAR();
    }
}

extern "C" void kernel_launch(void* const* d_in, const int* in_sizes, int n_in, void* d_out, int out_size, void* d_ws, size_t ws_size, hipStream_t stream) {
    static int grid = 0;
    if (grid == 0) {
        if (n_in != 23 || ws_size < WS_NEED || out_size != T * D_MODEL) { fprintf(stderr, "kernel_launch: unexpected shapes (n_in %d, ws %zu, out %d)\n", n_in, ws_size, out_size); grid = -1; return; }
        int dev = 0, cus = 0, per_cu = 0;
        if (hipGetDevice(&dev) != hipSuccess || hipDeviceGetAttribute(&cus, hipDeviceAttributeMultiprocessorCount, dev) != hipSuccess) { grid = -1; return; }
        if (hipFuncSetAttribute((const void*)mega_fwd, hipFuncAttributeMaxDynamicSharedMemorySize, LDS_BYTES) != hipSuccess) { fprintf(stderr, "kernel_launch: hipFuncSetAttribute failed\n"); grid = -1; return; }
        if (hipOccupancyMaxActiveBlocksPerMultiprocessor(&per_cu, (const void*)mega_fwd, NTHREADS, LDS_BYTES) != hipSuccess || per_cu < 1) { fprintf(stderr, "kernel_launch: occupancy query says %d blocks/CU\n", per_cu); per_cu = 1; }
        (void)hipGetLastError();
        grid = cus * 1;
    }
    if (grid < 0) return;
    (void)hipMemsetAsync(d_ws, 0, CTL_ZERO_BYTES, stream);
    Args a{};
    for (int i = 0; i < 23; ++i) a.in[i] = (const float*)d_in[i];
    a.out = (float*)d_out; a.ws = (unsigned char*)d_ws; a.ph_lo = 0; a.ph_hi = 0;
    hipLaunchKernelGGL(mega_fwd, dim3(grid), dim3(NTHREADS), LDS_BYTES, stream, a);
}
```

```cpp
#include <hip/hip_runtime.h>
#include <cstdint>
#include <cstdio>

typedef unsigned short bf16_t;
typedef short bf16x8 __attribute__((ext_vector_type(8)));
typedef float f32x4 __attribute__((ext_vector_type(4)));
typedef float f32x16 __attribute__((ext_vector_type(16)));
typedef unsigned u32x4 __attribute__((ext_vector_type(4)));
typedef unsigned u32x2 __attribute__((ext_vector_type(2)));

constexpr int D_MODEL = 1024, BATCH = 4, SEQ = 8192, DEPTH = 2, T = BATCH * SEQ;
constexpr int D_SSM = 768, NG = 48, HG = 16, NP = 64;
constexpr int NH = 12, HD = 64, D_ATTN = 768;
constexpr int MEM_LEN = 256, MH = 4, MHD = 128, D_MEM = 512;
constexpr int D_IN = 8704, N_A1 = 5632;
constexpr float EPS = 1e-6f;

constexpr size_t MiB = 1u << 20;
constexpr size_t OFF_RS = 1 * MiB, OFF_RSMEM = 1 * MiB + 256 * 1024, OFF_LSE = 2 * MiB;
constexpr size_t OFF_W = 4 * MiB, W_STRIDE = 27 * MiB;
constexpr size_t WO_IN = 0, WO_GLU = 17 * MiB, WO_B1 = WO_GLU + 1179648, WO_B2 = WO_B1 + 1572864, WO_B3 = WO_B2 + 1572864, WO_OUT = WO_B3 + 1048576, WO_MKV = WO_OUT + 2 * MiB;
static_assert(WO_MKV + 2 * MiB <= W_STRIDE, "weights");
constexpr size_t OFF_KVM = 58 * MiB, OFF_MEMB = 62 * MiB, OFF_XB = 64 * MiB, OFF_U = 128 * MiB, OFF_ZM = 188 * MiB, OFF_ZS = 220 * MiB, OFF_Q = 268 * MiB,
                 OFF_K = 316 * MiB, OFF_V = 364 * MiB, OFF_ZA = 412 * MiB, OFF_QM = 460 * MiB, OFF_TAB = 492 * MiB, WS_NEED = 512 * MiB;
constexpr size_t OFF_Y = OFF_K, OFF_MERGED = OFF_U;

__device__ __forceinline__ unsigned f2bf(float f) { unsigned u = __builtin_bit_cast(unsigned, f); return (u + 0x7fffu + ((u >> 16) & 1u)) >> 16; }
__device__ __forceinline__ unsigned pk2(float lo, float hi) { return f2bf(lo) | (f2bf(hi) << 16); }
__device__ __forceinline__ float bflo(unsigned u) { return __builtin_bit_cast(float, u << 16); }
__device__ __forceinline__ float bfhi(unsigned u) { return __builtin_bit_cast(float, u & 0xffff0000u); }
__device__ __forceinline__ float bf2f(bf16_t h) { return __builtin_bit_cast(float, (unsigned)h << 16); }
__device__ __forceinline__ float sigmoidf_(float x) { return 1.f / (1.f + __expf(-x)); }
__device__ __forceinline__ float siluf_(float x) { return x * sigmoidf_(x); }
__device__ __forceinline__ float gelu_tanh(float y) { return 0.5f * y * (1.f + tanhf(0.7978845608028654f * (y + 0.044715f * y * y * y))); }
__device__ __forceinline__ float wave_sum(float v) {
#pragma unroll
    for (int o = 1; o < 64; o <<= 1) v += __shfl_xor(v, o);
    return v;
}
__device__ __forceinline__ float wave_max(float v) {
#pragma unroll
    for (int o = 1; o < 64; o <<= 1) v = fmaxf(v, __shfl_xor(v, o));
    return v;
}

#define GAS __attribute__((address_space(1)))
#define LAS __attribute__((address_space(3)))
constexpr int NWAVES = 8, NTHREADS = 512;
constexpr int RING_BYTES = 131072, LDS_BYTES = 147456, LDSCTL_OFF = LDS_BYTES - 1024, MISC_OFF = LDSCTL_OFF + 320;
constexpr size_t CTL_ZERO_BYTES = 1 * MiB; constexpr int CW_BAR = 4096;

#define XB_TMO      128
#define XB_XCNT(j)  (256  + 64 * (j))
#define XB_XSUB(j)  (1280 + 64 * (j))
#define XB_XGEN(j)  (2304 + 64 * (j))
#define XB_TOP      3328
#define XB_TOPGEN   3392
#define XCD_BAR_WORDS 3456
#define XB_SPIN_CAP (1u << 18)
__device__ __forceinline__ unsigned xb_ld(unsigned* p)              { return __hip_atomic_load(p, __ATOMIC_RELAXED, __HIP_MEMORY_SCOPE_AGENT); }
__device__ __forceinline__ unsigned xb_add(unsigned* p, unsigned v) { return __hip_atomic_fetch_add(p, v, __ATOMIC_RELAXED, __HIP_MEMORY_SCOPE_AGENT); }
__device__ __forceinline__ unsigned xb_xcc_id() { return (unsigned)__builtin_amdgcn_s_getreg((3 << 11) | 20) & 0xFu; }
#define XB_SPIN(cond, bar) do { unsigned _sp = 0; while (cond) { __builtin_amdgcn_s_sleep(1); \
    if ((++_sp & 255u) == 0u) { if (xb_ld(&(bar)[XB_TMO])) break; if (_sp > XB_SPIN_CAP) { atomicAdd(&(bar)[XB_TMO], 1u); break; } } } } while (0)
struct XcdBarrier { unsigned* bar; unsigned x; volatile LAS unsigned* st; };
__device__ __forceinline__ XcdBarrier xcd_barrier_post(unsigned* bar, volatile LAS unsigned* st) {
    XcdBarrier b; b.bar = bar; b.x = xb_xcc_id(); b.st = st;
    if (threadIdx.x == 0) (void)xb_add(&bar[XB_XCNT(b.x)], 1u);
    return b;
}
__device__ __forceinline__ void xcd_barrier_complete(unsigned* bar, unsigned x, unsigned& nloc, unsigned& nx) {
    const unsigned G = gridDim.x * gridDim.y * gridDim.z;
    unsigned sum, cnt, mine, sp = 0u;
    for (;;) {
        sum = 0u; cnt = 0u; mine = 0u;
#pragma unroll
        for (unsigned j = 0; j < 16; ++j) { const unsigned c = xb_ld(&bar[XB_XCNT(j)]); sum += c; cnt += (c > 0u) ? 1u : 0u; mine = (j == x) ? c : mine; }
        if (sum == G) break;
        __builtin_amdgcn_s_sleep(1);
        if ((++sp & 255u) == 0u) { if (xb_ld(&bar[XB_TMO])) break; if (sp > XB_SPIN_CAP) { atomicAdd(&bar[XB_TMO], 1u); break; } }
    }
    nloc = mine > 0u ? mine : 1u; nx = cnt > 0u ? cnt : 1u;
}
__device__ __forceinline__ void xcd_barrier(const XcdBarrier& b) {
    asm volatile("s_waitcnt vmcnt(0)" ::: "memory");
    __syncthreads();
    if (threadIdx.x == 0) {
        unsigned* bar = b.bar;
        __builtin_amdgcn_s_waitcnt(0);
        unsigned nloc = b.st[0], nx = b.st[1];
        if (nloc == 0u) { xcd_barrier_complete(bar, b.x, nloc, nx); b.st[0] = nloc; b.st[1] = nx; }
        const unsigned old = xb_add(&bar[XB_XSUB(b.x)], 1u);
        const unsigned gen = old / nloc;
        if (old + 1u == (gen + 1u) * nloc) {
            __builtin_amdgcn_fence(__ATOMIC_RELEASE, "agent");
            asm volatile("s_waitcnt vmcnt(0)" ::: "memory");
            const unsigned og = xb_add(&bar[XB_TOP], 1u);
            const unsigned tg = og / nx;
            if (og + 1u == (tg + 1u) * nx) xb_add(&bar[XB_TOPGEN], 1u);
            else XB_SPIN(xb_ld(&bar[XB_TOPGEN]) == tg, bar);
            __builtin_amdgcn_fence(__ATOMIC_ACQUIRE, "agent");
            xb_add(&bar[XB_XGEN(b.x)], 1u);
            asm volatile("s_waitcnt vmcnt(0)" ::: "memory");
        } else {
            XB_SPIN(xb_ld(&bar[XB_XGEN(b.x)]) == gen, bar);
            __builtin_amdgcn_fence(__ATOMIC_ACQUIRE, "agent");
            asm volatile("s_waitcnt vmcnt(0)" ::: "memory");
        }
    }
    __syncthreads();
}

__device__ __forceinline__ void transpose_item(const float* __restrict__ W, int K, int N, bf16_t* __restrict__ WT, int ldt, const float* __restrict__ kscale, LAS float* scr, int item, int lane) {
    const int nblk = N / 32, kb = item / nblk, nb = item % nblk, k0 = 64 * kb, n0 = 32 * nb;
#pragma unroll
    for (int i = 0; i < 32; ++i) { const int kk = 2 * i + (lane >> 5); const float s = kscale ? kscale[k0 + kk] : 1.f; scr[kk * 33 + (lane & 31)] = W[(size_t)(k0 + kk) * N + n0 + (lane & 31)] * s; }
    asm volatile("s_waitcnt lgkmcnt(0)" ::: "memory");
    const int c = lane & 7;
#pragma unroll
    for (int j = 0; j < 4; ++j) { const int n = (lane >> 3) + 8 * j; const LAS float* s = scr + (8 * c) * 33 + n;
        u32x4 o; o.x = pk2(s[0 * 33], s[1 * 33]); o.y = pk2(s[2 * 33], s[3 * 33]); o.z = pk2(s[4 * 33], s[5 * 33]); o.w = pk2(s[6 * 33], s[7 * 33]);
        *(u32x4*)(WT + (size_t)(n0 + n) * ldt + k0 + 8 * c) = o; }
    asm volatile("s_waitcnt lgkmcnt(0)" ::: "memory");
}
__device__ __forceinline__ void rownorm_row(const float* __restrict__ x, bf16_t* __restrict__ xb, float* __restrict__ rs, int row, int lane, float* __restrict__ sq4 = nullptr) {
    const f32x4* xr = (const f32x4*)(x + (size_t)row * 1024) + lane;
    f32x4 v[4]; float s = 0.f;
#pragma unroll
    for (int j = 0; j < 4; ++j) { v[j] = xr[64 * j]; s += (v[j].x * v[j].x + v[j].y * v[j].y) + (v[j].z * v[j].z + v[j].w * v[j].w); }
    s = wave_sum(s);
    u32x2* o = (u32x2*)(xb + (size_t)row * 1024) + lane;
#pragma unroll
    for (int j = 0; j < 4; ++j) o[64 * j] = (u32x2){pk2(v[j].x, v[j].y), pk2(v[j].z, v[j].w)};
    if (lane == 0) { rs[row] = 1.0f / sqrtf(s * (1.f / 1024.f) + EPS); if (sq4) *(f32x4*)(sq4 + (size_t)row * 4) = (f32x4){s, 0.f, 0.f, 0.f}; }
}
__device__ __forceinline__ void final_norm_row(float* __restrict__ x, const float* __restrict__ g, int row, int lane) {
    f32x4* xr = (f32x4*)(x + (size_t)row * 1024) + lane; const f32x4* gr = (const f32x4*)g + lane;
    f32x4 v[4]; float s = 0.f;
#pragma unroll
    for (int j = 0; j < 4; ++j) { v[j] = xr[64 * j]; s += (v[j].x * v[j].x + v[j].y * v[j].y) + (v[j].z * v[j].z + v[j].w * v[j].w); }
    s = wave_sum(s); const float r = 1.0f / sqrtf(s * (1.f / 1024.f) + EPS);
#pragma unroll
    for (int j = 0; j < 4; ++j) xr[64 * j] = v[j] * r * gr[64 * j];
}

struct EpiA1 {
    const float* rs; bf16_t *U, *ZS, *Q, *Kb, *V, *ZA, *QM, *ZM;
    __device__ __forceinline__ void operator()(int m, int n, f32x4 v) const {
        v = v * rs[m]; bf16_t* dst; bool silu = false; float sc = 1.f;
        if (n < 768) dst = U + (size_t)m * 768 + n;
        else if (n < 1536) { dst = ZS + (size_t)m * 768 + (n - 768); silu = true; }
        else if (n < 2304) { dst = Q + (size_t)m * 768 + (n - 1536); sc = 0.125f; }
        else if (n < 3072) dst = Kb + (size_t)m * 768 + (n - 2304);
        else if (n < 3840) dst = V + (size_t)m * 768 + (n - 3072);
        else if (n < 4608) { dst = ZA + (size_t)m * 768 + (n - 3840); silu = true; }
        else if (n < 5120) { dst = QM + (size_t)m * 512 + (n - 4608); sc = 0.08838834764831845f; }
        else { dst = ZM + (size_t)m * 512 + (n - 5120); silu = true; }
        if (silu) { v.x = siluf_(v.x); v.y = siluf_(v.y); v.z = siluf_(v.z); v.w = siluf_(v.w); }
        v = v * sc;
        *(u32x2*)dst = (u32x2){pk2(v.x, v.y), pk2(v.z, v.w)};
    }
};
struct EpiKvm {
    const float* rs; bf16_t* O;
    __device__ __forceinline__ void operator()(int m, int n, f32x4 v) const { v = v * rs[m]; *(u32x2*)(O + (size_t)m * 1024 + n) = (u32x2){pk2(v.x, v.y), pk2(v.z, v.w)}; }
};
struct EpiGlu {
    const bf16_t* Y; bf16_t* ZS; const float* b;
    __device__ __forceinline__ void operator()(int m, int n, f32x4 v) const {
        const u32x2 y = *(const u32x2*)(Y + (size_t)m * 768 + n); u32x2* zp = (u32x2*)(ZS + (size_t)m * 768 + n); const u32x2 z = *zp; const f32x4 bb = *(const f32x4*)(b + n);
        const float o0 = bflo(y.x) * sigmoidf_(v.x + bb.x) * bflo(z.x), o1 = bfhi(y.x) * sigmoidf_(v.y + bb.y) * bfhi(z.x);
        const float o2 = bflo(y.y) * sigmoidf_(v.z + bb.z) * bflo(z.y), o3 = bfhi(y.y) * sigmoidf_(v.w + bb.w) * bfhi(z.y);
        *zp = (u32x2){pk2(o0, o1), pk2(o2, o3)};
    }
};
struct EpiOut {
    const float* xold; float* xnew;
    __device__ __forceinline__ void operator()(int m, int n, f32x4 v) const { const size_t o = (size_t)m * 1024 + n; *(f32x4*)(xnew + o) = *(const f32x4*)(xold + o) + v; }
};
template <class Epi>
__device__ __forceinline__ void wgemm(const bf16_t* __restrict__ A, int lda, const bf16_t* __restrict__ Bt, int ldb, int M, int N, int K, const Epi& epi, int gw, int ngw, int lane) {
    const int r = lane & 31, hi = lane >> 5; const int ntn = N / 64, ntiles = (M / 64) * ntn;
    for (int tile = gw; tile < ntiles; tile += ngw) {
        const int m0 = (tile / ntn) * 64, n0 = (tile % ntn) * 64;
        f32x16 acc[2][2];
#pragma unroll
        for (int i = 0; i < 2; ++i)
#pragma unroll
            for (int j = 0; j < 2; ++j)
#pragma unroll
                for (int q = 0; q < 16; ++q) acc[i][j][q] = 0.f;
        const bf16_t* ap = A + (size_t)(m0 + r) * lda + 8 * hi;
        const bf16_t* bp = Bt + (size_t)(n0 + r) * ldb + 8 * hi;
        for (int k = 0; k < K; k += 16) {
            const bf16x8 a0 = *(const bf16x8*)(ap + k), a1 = *(const bf16x8*)(ap + (size_t)32 * lda + k);
            const bf16x8 b0 = *(const bf16x8*)(bp + k), b1 = *(const bf16x8*)(bp + (size_t)32 * ldb + k);
            acc[0][0] = __builtin_amdgcn_mfma_f32_32x32x16_bf16(b0, a0, acc[0][0], 0, 0, 0);
            acc[0][1] = __builtin_amdgcn_mfma_f32_32x32x16_bf16(b1, a0, acc[0][1], 0, 0, 0);
            acc[1][0] = __builtin_amdgcn_mfma_f32_32x32x16_bf16(b0, a1, acc[1][0], 0, 0, 0);
            acc[1][1] = __builtin_amdgcn_mfma_f32_32x32x16_bf16(b1, a1, acc[1][1], 0, 0, 0);
        }
#pragma unroll
        for (int mi = 0; mi < 2; ++mi)
#pragma unroll
            for (int ni = 0; ni < 2; ++ni)
#pragma unroll
                for (int q = 0; q < 4; ++q)
                    epi(m0 + 32 * mi + r, n0 + 32 * ni + 8 * q + 4 * hi, (f32x4){acc[mi][ni][4 * q], acc[mi][ni][4 * q + 1], acc[mi][ni][4 * q + 2], acc[mi][ni][4 * q + 3]});
    }
}
__device__ __forceinline__ void merge_ref(const bf16_t* __restrict__ XB, const float* __restrict__ rs, const bf16_t* __restrict__ WinT, const float* __restrict__ bg,
                                          const bf16_t* __restrict__ OS, const bf16_t* __restrict__ OA, const bf16_t* __restrict__ OM,
                                          const bf16_t* __restrict__ W1, const bf16_t* __restrict__ W2, const bf16_t* __restrict__ W3, bf16_t* __restrict__ MG, int gw, int ngw, int lane) {
    const int r = lane & 31, hi = lane >> 5;
    for (int tile = gw; tile < (T / 32) * 32; tile += ngw) {
        const int m0 = (tile >> 5) * 32, n0 = (tile & 31) * 32;
        f32x16 L0, L1, L2, P0, P1, P2;
#pragma unroll
        for (int q = 0; q < 16; ++q) { L0[q] = 0.f; L1[q] = 0.f; L2[q] = 0.f; P0[q] = 0.f; P1[q] = 0.f; P2[q] = 0.f; }
        {
            const bf16_t* ap = XB + (size_t)(m0 + r) * 1024 + 8 * hi; const bf16_t* bp = WinT + (size_t)(N_A1 + n0 + r) * 1024 + 8 * hi;
            for (int k = 0; k < 1024; k += 16) {
                const bf16x8 a = *(const bf16x8*)(ap + k);
                L0 = __builtin_amdgcn_mfma_f32_32x32x16_bf16(*(const bf16x8*)(bp + k), a, L0, 0, 0, 0);
                L1 = __builtin_amdgcn_mfma_f32_32x32x16_bf16(*(const bf16x8*)(bp + (size_t)1024 * 1024 + k), a, L1, 0, 0, 0);
                L2 = __builtin_amdgcn_mfma_f32_32x32x16_bf16(*(const bf16x8*)(bp + (size_t)2048 * 1024 + k), a, L2, 0, 0, 0);
            }
        }
        {
            const bf16_t* ap = OS + (size_t)(m0 + r) * 768 + 8 * hi; const bf16_t* bp = W1 + (size_t)(n0 + r) * 768 + 8 * hi;
            for (int k = 0; k < 768; k += 16) P0 = __builtin_amdgcn_mfma_f32_32x32x16_bf16(*(const bf16x8*)(bp + k), *(const bf16x8*)(ap + k), P0, 0, 0, 0);
        }
        {
            const bf16_t* ap = OA + (size_t)(m0 + r) * 768 + 8 * hi; const bf16_t* bp = W2 + (size_t)(n0 + r) * 768 + 8 * hi;
            for (int k = 0; k < 768; k += 16) P1 = __builtin_amdgcn_mfma_f32_32x32x16_bf16(*(const bf16x8*)(bp + k), *(const bf16x8*)(ap + k), P1, 0, 0, 0);
        }
        {
            const bf16_t* ap = OM + (size_t)(m0 + r) * 512 + 8 * hi; const bf16_t* bp = W3 + (size_t)(n0 + r) * 512 + 8 * hi;
            for (int k = 0; k < 512; k += 16) P2 = __builtin_amdgcn_mfma_f32_32x32x16_bf16(*(const bf16x8*)(bp + k), *(const bf16x8*)(ap + k), P2, 0, 0, 0);
        }
        const int m = m0 + r; const float rsm = rs[m];
#pragma unroll
        for (int q = 0; q < 4; ++q) {
            const int n = n0 + 8 * q + 4 * hi; float o[4];
#pragma unroll
            for (int e = 0; e < 4; ++e) {
                const int rg = 4 * q + e;
                const float g0 = sigmoidf_(rsm * L0[rg] + bg[n + e]), g1 = sigmoidf_(rsm * L1[rg] + bg[1024 + n + e]), g2 = sigmoidf_(rsm * L2[rg] + bg[2048 + n + e]);
                o[e] = g0 * P0[rg] + g1 * P1[rg] + g2 * P2[rg];
            }
            *(u32x2*)(MG + (size_t)m * 1024 + n) = (u32x2){pk2(o[0], o[1]), pk2(o[2], o[3])};
        }
    }
}

__device__ __forceinline__ void ssm_ref(int b, int g, int lane, LAS float* xs, const bf16_t* __restrict__ U, bf16_t* __restrict__ Y, const float* __restrict__ lam_re, const float* __restrict__ lam_im,
                                        const float* __restrict__ log_dt, const float* __restrict__ b_re, const float* __restrict__ b_im,
                                        const float* __restrict__ c_re, const float* __restrict__ c_im, const float* __restrict__ dvec) {
    const float dt = expf(log_dt[g]); const float lre = lam_re[g * 64 + lane], lim = lam_im[g * 64 + lane];
    const float mag = expf(lre * dt); const float ar = mag * cosf(lim * dt), ai = mag * sinf(lim * dt);
    const float den = lre * lre + lim * lim, nr = ar - 1.0f, ni = ai;
    const float fr = (nr * lre + ni * lim) / den, fi = (ni * lre - nr * lim) / den;
    float bbr[16], bbi[16];
#pragma unroll
    for (int h = 0; h < 16; ++h) { const float br = b_re[(g * 64 + lane) * 16 + h], bi = b_im[(g * 64 + lane) * 16 + h]; bbr[h] = fr * br - fi * bi; bbi[h] = fr * bi + fi * br; }
    const int hq = lane & 15, part = lane >> 4;
    float cr[16], ci[16];
#pragma unroll
    for (int i = 0; i < 16; ++i) { cr[i] = c_re[(g * 16 + hq) * 64 + part * 16 + i]; ci[i] = c_im[(g * 16 + hq) * 64 + part * 16 + i]; }
    const float dd = dvec[g * 16 + hq];
    float xr = 0.f, xi = 0.f;
    const bf16_t* up = U + (size_t)b * SEQ * 768 + g * 16; bf16_t* yp = Y + (size_t)b * SEQ * 768 + g * 16;
    for (int t = 0; t < SEQ; ++t) {
        const u32x4 ua = *(const u32x4*)(up + (size_t)t * 768), ub = *(const u32x4*)(up + (size_t)t * 768 + 8);
        const float uh = bf2f(up[(size_t)t * 768 + hq]);
        float u[16];
        u[0] = bflo(ua.x); u[1] = bfhi(ua.x); u[2] = bflo(ua.y); u[3] = bfhi(ua.y); u[4] = bflo(ua.z); u[5] = bfhi(ua.z); u[6] = bflo(ua.w); u[7] = bfhi(ua.w);
        u[8] = bflo(ub.x); u[9] = bfhi(ub.x); u[10] = bflo(ub.y); u[11] = bfhi(ub.y); u[12] = bflo(ub.z); u[13] = bfhi(ub.z); u[14] = bflo(ub.w); u[15] = bfhi(ub.w);
        float bur = 0.f, bui = 0.f;
#pragma unroll
        for (int h = 0; h < 16; ++h) { bur += bbr[h] * u[h]; bui += bbi[h] * u[h]; }
        const float nxr = ar * xr - ai * xi + bur, nxi = ar * xi + ai * xr + bui; xr = nxr; xi = nxi;
        xs[lane] = xr; xs[64 + lane] = xi;
        asm volatile("s_waitcnt lgkmcnt(0)" ::: "memory");
        float acc = 0.f;
#pragma unroll
        for (int i = 0; i < 16; ++i) acc += cr[i] * xs[part * 16 + i] - ci[i] * xs[64 + part * 16 + i];
        acc += __shfl_xor(acc, 16); acc += __shfl_xor(acc, 32);
        asm volatile("s_waitcnt lgkmcnt(0)" ::: "memory");
        if (lane < 16) yp[(size_t)t * 768 + lane] = (bf16_t)f2bf(gelu_tanh(acc + dd * uh));
    }
}

__device__ __forceinline__ int rel_bucket(int n) {
    if (n < 16) return n;
    const float v = logf((float)n / 16.0f) / 4.852030263919617f * 16.0f;
    const int lg = 16 + (int)v; return lg < 31 ? lg : 31;
}
__device__ __forceinline__ float dot8(const u32x4 a, const u32x4 b) {
    return bflo(a.x) * bflo(b.x) + bfhi(a.x) * bfhi(b.x) + bflo(a.y) * bflo(b.y) + bfhi(a.y) * bfhi(b.y) + bflo(a.z) * bflo(b.z) + bfhi(a.z) * bfhi(b.z) + bflo(a.w) * bflo(b.w) + bfhi(a.w) * bfhi(b.w);
}
__device__ __forceinline__ void attn_ref(bf16_t* Q, const bf16_t* __restrict__ Kb, const bf16_t* __restrict__ V, const float* __restrict__ rel_bias, float* __restrict__ lse, int gw, int ngw, int lane) {
    for (int item = gw; item < T * NH; item += ngw) {
        const int head = item % NH, tok = item / NH, t = tok % SEQ, row0 = tok - t;
        const int grp = head >> 2, r = grp == 0 ? 1 : (grp == 1 ? 4 : 16);
        bf16_t* qp = Q + (size_t)tok * 768 + head * 64;
        u32x4 qv[8];
#pragma unroll
        for (int i = 0; i < 8; ++i) qv[i] = ((const u32x4*)qp)[i];
        float s[3]; bool ok[3];
#pragma unroll
        for (int sl = 0; sl < 3; ++sl) {
            const int j = sl * 64 + lane, p = t - j * r; ok[sl] = (j <= 128) && (p >= 0); s[sl] = -1e30f;
            if (ok[sl]) {
                const u32x4* kp = (const u32x4*)(Kb + (size_t)(row0 + p) * 768 + head * 64); float d = 0.f;
#pragma unroll
                for (int i = 0; i < 8; ++i) d += dot8(qv[i], kp[i]);
                s[sl] = d + rel_bias[rel_bucket(j * r) * NH + head];
            }
        }
        const float m = wave_max(fmaxf(fmaxf(s[0], s[1]), s[2]));
        float e[3];
#pragma unroll
        for (int sl = 0; sl < 3; ++sl) e[sl] = ok[sl] ? __expf(s[sl] - m) : 0.f;
        const float l = wave_sum(e[0] + e[1] + e[2]);
        float o = 0.f;
#pragma unroll
        for (int sl = 0; sl < 3; ++sl) {
            for (int jj = 0; jj < 64; ++jj) {
                const int j = sl * 64 + jj, p = t - j * r; if (j > 128 || p < 0) break;
                const float pj = __shfl(e[sl], jj);
                o += pj * bf2f(V[(size_t)(row0 + p) * 768 + head * 64 + lane]);
            }
        }
        qp[lane] = (bf16_t)f2bf(o / l);
        if (lane == 0) lse[(size_t)tok * NH + head] = m + logf(l);
    }
}
__device__ __forceinline__ void attn_final_tok(bf16_t* __restrict__ Q, const float* __restrict__ lse, const bf16_t* __restrict__ ZA, int tok, int lane) {
    const float* lp = lse + (size_t)tok * NH;
    for (int c = lane * 4; c < 768; c += 256) {
        const int head = c >> 6, hh = head & 3; const float l0 = lp[hh], l1 = lp[4 + hh], l2 = lp[8 + hh];
        const float mx = fmaxf(fmaxf(l0, l1), l2); const float e0 = __expf(l0 - mx), e1 = __expf(l1 - mx), e2 = __expf(l2 - mx);
        const float mine = head < 4 ? e0 : (head < 8 ? e1 : e2); const float al = mine / (e0 + e1 + e2);
        u32x2* qp = (u32x2*)(Q + (size_t)tok * 768 + c); const u32x2 o = *qp; const u32x2 z = *(const u32x2*)(ZA + (size_t)tok * 768 + c);
        *qp = (u32x2){pk2(bflo(o.x) * al * bflo(z.x), bfhi(o.x) * al * bfhi(z.x)), pk2(bflo(o.y) * al * bflo(z.y), bfhi(o.y) * al * bfhi(z.y))};
    }
}
__device__ __forceinline__ void memattn_ref(bf16_t* QM, const bf16_t* __restrict__ KVM, const bf16_t* __restrict__ ZM, int gw, int ngw, int lane) {
    for (int item = gw; item < T * MH; item += ngw) {
        const int head = item & 3, tok = item >> 2, b = tok / SEQ;
        bf16_t* qp = QM + (size_t)tok * 512 + head * 128;
        u32x4 qv[16];
#pragma unroll
        for (int i = 0; i < 16; ++i) qv[i] = ((const u32x4*)qp)[i];
        float s[4];
#pragma unroll
        for (int sl = 0; sl < 4; ++sl) {
            const int j = sl * 64 + lane; const u32x4* kp = (const u32x4*)(KVM + (size_t)(b * 256 + j) * 1024 + head * 128); float d = 0.f;
#pragma unroll
            for (int i = 0; i < 16; ++i) d += dot8(qv[i], kp[i]);
            s[sl] = d;
        }
        const float m = wave_max(fmaxf(fmaxf(s[0], s[1]), fmaxf(s[2], s[3])));
        float e[4];
#pragma unroll
        for (int sl = 0; sl < 4; ++sl) e[sl] = __expf(s[sl] - m);
        const float l = wave_sum((e[0] + e[1]) + (e[2] + e[3]));
        float o0 = 0.f, o1 = 0.f;
#pragma unroll
        for (int sl = 0; sl < 4; ++sl)
            for (int jj = 0; jj < 64; ++jj) {
                const int j = sl * 64 + jj; const float pj = __shfl(e[sl], jj);
                const bf16_t* vp = KVM + (size_t)(b * 256 + j) * 1024 + 512 + head * 128;
                o0 += pj * bf2f(vp[lane]); o1 += pj * bf2f(vp[64 + lane]);
            }
        const bf16_t* zp = ZM + (size_t)tok * 512 + head * 128;
        qp[lane] = (bf16_t)f2bf(o0 / l * bf2f(zp[lane])); qp[64 + lane] = (bf16_t)f2bf(o1 / l * bf2f(zp[64 + lane]));
    }
}

constexpr size_t OFF_ROWSQ = 3 * MiB + 512 * 1024;
constexpr size_t TAB_TOEP = 0, TAB_CST = 2 * MiB, TAB_WST = 8 * MiB, TAB_AQ = 15 * MiB;
__device__ __forceinline__ int fresh_tid() { int t = threadIdx.x; asm volatile("" : "+v"(t)); return t; }
__device__ __forceinline__ unsigned char* fresh_ptr(unsigned char* p) { asm volatile("" : "+s"(p)); return (unsigned char*)(GAS unsigned char*)p; }
__device__ __forceinline__ int fresh_bid() { int b = blockIdx.x; asm volatile("" : "+s"(b)); return b; }
__device__ __forceinline__ float load_rs(GAS unsigned char* ws, int, int tr) {
    const f32x4 p = ((const GAS f32x4*)(ws + OFF_ROWSQ))[tr]; return __builtin_amdgcn_rsqf(((p.x + p.y) + (p.z + p.w)) * (1.f / 1024.f) + EPS);
}
__device__ __forceinline__ void load_rs8(GAS unsigned char* ws, int row0, int wr, int fr, float (&r8)[8]) {
    f32x4 p[8];
#pragma unroll
    for (int i = 0; i < 8; ++i) p[i] = ((const GAS f32x4*)(ws + OFF_ROWSQ))[row0 + (i >> 2) * 128 + wr * 64 + (i & 3) * 16 + fr];
#pragma unroll
    for (int i = 0; i < 8; ++i) r8[i] = __builtin_amdgcn_rsqf(((p[i].x + p[i].y) + (p[i].z + p[i].w)) * (1.f / 1024.f) + EPS);
}
namespace ge {
constexpr int BM = 256, BK = 64, HALF = 128, HTB = HALF * BK * 2, STAGE_BYTES = 8 * HTB;
__device__ __forceinline__ int lds_byte(int r, int c) { const int st = (r >> 4) * 2 + (c >> 5), rr = r & 15, cc = c & 31, ob = rr * 64 + cc * 2; return st * 1024 + (ob ^ (((ob >> 9) & 1) << 5)); }
__device__ __forceinline__ void stage_rc(int b, int& R, int& C) { const int st = b / 1024, sb = b % 1024, swz = sb ^ (((sb >> 9) & 1) << 5); R = (st >> 1) * 16 + swz / 64; C = (st & 1) * 32 + (swz % 64) / 2; }
__device__ __forceinline__ int perm32(int rho) { const int n = rho >> 4, i = rho & 15; return 8 * (i >> 2) + 4 * n + (i & 3); }
enum { A_STD = 0, A_GM = 1 };
enum { B_STD = 0, B_PERM = 1, B_TOEP = 2 };
struct Seg { const char* A; const char* B; int a_h, b_h, a_k, b_k, npairs, amode, bmode; unsigned lda2, ldb2; };
struct Unit { int type, pm, pn, g; };
typedef f32x4 Acc[2][2][4][2];

template <class Sched, class Epi>
__device__ __forceinline__ void gemm_run(LAS unsigned char* lds, const Sched& S, const Epi& E) {
    const int tid = fresh_tid(), wid = __builtin_amdgcn_readfirstlane(tid >> 6), lane = tid & 63, wr = wid >> 2, wc = wid & 3, fr = lane & 15, fq = lane >> 4;
    const unsigned ldsw = (unsigned)wid * 1024u;
    const int aoff = lds_byte(wr * 64 + fr, fq * 8), boff = lds_byte(wc * 32 + fr, fq * 8);
#define GE_SA(b, h) (((b) * 2 + (h)) * HTB)
#define GE_SB(b, h) ((4 + (b) * 2 + (h)) * HTB)
#define GE_STAGE(bufoff, gbase, voff) do { _Pragma("unroll") for (int _i = 0; _i < 2; ++_i) \
        __builtin_amdgcn_global_load_lds((const unsigned*)((const char*)(gbase) + (voff)[_i]), (LAS unsigned*)(lds + (bufoff) + ldsw + _i * 8192), 16, 0, 0); } while (0)
#define GE_LDA(dst, b, h) do { _Pragma("unroll") for (int m = 0; m < 4; ++m) _Pragma("unroll") for (int k = 0; k < 2; ++k) dst[m][k] = *(const LAS bf16x8*)(lds + GE_SA(b, h) + aoff + m * 2048 + k * 1024); } while (0)
#define GE_LDB(dst, b, h) do { _Pragma("unroll") for (int n = 0; n < 2; ++n) _Pragma("unroll") for (int k = 0; k < 2; ++k) dst[n][k] = *(const LAS bf16x8*)(lds + GE_SB(b, h) + boff + n * 2048 + k * 1024); } while (0)
#define GE_MMA(ai, bj, At, Bt) do { __builtin_amdgcn_s_setprio(1); _Pragma("unroll") for (int m = 0; m < 4; ++m) _Pragma("unroll") for (int n = 0; n < 2; ++n) _Pragma("unroll") for (int k = 0; k < 2; ++k) \
        acc[ai][bj][m][n] = __builtin_amdgcn_mfma_f32_16x16x32_bf16(Bt[n][k], At[m][k], acc[ai][bj][m][n], 0, 0, 0); __builtin_amdgcn_s_setprio(0); } while (0)
#define GE_WAIT_V(n) asm volatile("s_waitcnt vmcnt(" #n ")" ::: "memory")
#define GE_WAIT_L(n) asm volatile("s_waitcnt lgkmcnt(" #n ")" ::: "memory")
#define GE_BAR __builtin_amdgcn_s_barrier()
#define GE_SCHED __builtin_amdgcn_sched_barrier(0)
#define GE_VOFFS(sg, va, vb) do { _Pragma("unroll") for (int _i = 0; _i < 2; ++_i) { int R_, C_; stage_rc(tid * 16 + _i * 8192, R_, C_); const int Rp_ = (R_ & ~31) + perm32(R_ & 31); \
        va[_i] = (sg).amode == A_GM ? (unsigned)((R_ >> 5) * 1280 + (R_ & 31) * 32 + (C_ >> 4) * (1024 * 1280) + (C_ & 15) * 2) : (unsigned)R_ * (sg).lda2 + (unsigned)(C_ * 2); \
        vb[_i] = (sg).bmode == B_TOEP ? (unsigned)((((Rp_ >> 4) - (C_ >> 4) + 3) * 256 + (Rp_ & 15) * 16 + (C_ & 15)) * 2) : (unsigned)((sg).bmode == B_PERM ? Rp_ : R_) * (sg).ldb2 + (unsigned)(C_ * 2); } } while (0)
    Unit nu; int nui = 0;
    if (!S.unit(0, nu)) return;
    Seg ns; int nsi = 0, npi = 0; S.seg(nu, 0, ns);
    const char* npa = ns.A; const char* npb = ns.B; unsigned nva[2], nvb[2]; GE_VOFFS(ns, nva, nvb);
    bool nreal = true;
    Unit cu; int csi; bool c_lastseg, c_lastunit; const char* c_a1h; unsigned cva[2];
#define GE_ADVANCE() do { ++npi; if (npi < ns.npairs) { npa += 2 * ns.a_k; npb += 2 * ns.b_k; } else { npi = 0; ++nsi; \
        if (nsi >= S.nseg(nu)) { nsi = 0; Unit tu; if (S.unit(nui + 1, tu)) { ++nui; nu = tu; } else nreal = false; } \
        S.seg(nu, nsi, ns); npa = ns.A; npb = ns.B; GE_VOFFS(ns, nva, nvb); } } while (0)
#define GE_SHIFT() do { cu = nu; csi = nsi; c_lastseg = (npi == ns.npairs - 1); c_lastunit = c_lastseg && (nsi == S.nseg(nu) - 1); \
        c_a1h = npa + ns.a_k + ns.a_h; cva[0] = nva[0]; cva[1] = nva[1]; GE_ADVANCE(); } while (0)
    Acc acc;
#pragma unroll
    for (int a = 0; a < 2; ++a)
#pragma unroll
        for (int b = 0; b < 2; ++b)
#pragma unroll
            for (int m = 0; m < 4; ++m)
#pragma unroll
                for (int n = 0; n < 2; ++n) acc[a][b][m][n] = (f32x4){0.f, 0.f, 0.f, 0.f};
    bf16x8 At[4][2], B0[2][2], B1[2][2];
    GE_STAGE(GE_SB(0, 0), npb, nvb); GE_STAGE(GE_SB(0, 1), npb + ns.b_h, nvb); GE_STAGE(GE_SA(0, 0), npa, nva); GE_STAGE(GE_SA(0, 1), npa + ns.a_h, nva);
    if (wr == 1) GE_BAR;
    GE_WAIT_V(2); GE_BAR;
    GE_STAGE(GE_SB(1, 0), npb + ns.b_k, nvb); GE_STAGE(GE_SA(1, 0), npa + ns.a_k, nva); GE_STAGE(GE_SB(1, 1), npb + ns.b_k + ns.b_h, nvb);
    GE_WAIT_V(6); GE_BAR;
    GE_SHIFT();
    for (;;) {
        GE_LDB(B0, 0, 0); GE_LDB(B1, 0, 1); GE_SCHED; GE_LDA(At, 0, 0); GE_STAGE(GE_SA(1, 1), c_a1h, cva);
        GE_WAIT_V(8); GE_WAIT_L(0); GE_BAR; GE_MMA(0, 0, At, B0); GE_MMA(0, 1, At, B1); GE_BAR; GE_SCHED;
        GE_LDA(At, 0, 1); GE_STAGE(GE_SB(0, 0), npb, nvb); GE_STAGE(GE_SB(0, 1), npb + ns.b_h, nvb); GE_STAGE(GE_SA(0, 0), npa, nva);
        GE_WAIT_V(8); GE_WAIT_L(0); GE_BAR; GE_MMA(1, 0, At, B0); GE_MMA(1, 1, At, B1); GE_BAR; GE_SCHED;
        GE_LDB(B0, 1, 0); GE_LDB(B1, 1, 1); GE_SCHED; GE_LDA(At, 1, 0); GE_STAGE(GE_SA(0, 1), npa + ns.a_h, nva);
        GE_WAIT_V(8); GE_WAIT_L(0); GE_BAR; GE_MMA(0, 0, At, B0); GE_MMA(0, 1, At, B1); GE_BAR; GE_SCHED;
        GE_LDA(At, 1, 1); GE_STAGE(GE_SB(1, 0), npb + ns.b_k, nvb); GE_STAGE(GE_SB(1, 1), npb + ns.b_k + ns.b_h, nvb); GE_STAGE(GE_SA(1, 0), npa + ns.a_k, nva);
        GE_WAIT_V(8); GE_WAIT_L(0); GE_BAR; GE_MMA(1, 0, At, B0); GE_MMA(1, 1, At, B1); GE_BAR; GE_SCHED;
        if (c_lastunit) {
            if (wr == 0) GE_BAR;
            { int fr_ = fr, fq_ = fq; asm volatile("" : "+v"(fr_), "+v"(fq_)); E.finish(acc, cu, wr, wc, fr_, fq_); }
            if (!nreal) break;
#pragma unroll
            for (int a = 0; a < 2; ++a)
#pragma unroll
                for (int b = 0; b < 2; ++b)
#pragma unroll
                    for (int m = 0; m < 4; ++m)
#pragma unroll
                        for (int n = 0; n < 2; ++n) acc[a][b][m][n] = (f32x4){0.f, 0.f, 0.f, 0.f};
            if (wr == 1) GE_BAR;
        } else if (c_lastseg) {
            { int fr_ = fr, fq_ = fq; asm volatile("" : "+v"(fr_), "+v"(fq_)); E.seg_end(acc, cu, csi, wr, wc, fr_, fq_); }
        }
        GE_SHIFT();
    }
    GE_WAIT_V(0);
    GE_BAR;
    { int fr_ = fr, fq_ = fq; asm volatile("" : "+v"(fr_), "+v"(fq_)); E.after_drain(acc, cu, lds, wr, wc, fr_, fq_); }
#undef GE_SA
#undef GE_SB
#undef GE_STAGE
#undef GE_LDA
#undef GE_LDB
#undef GE_MMA
#undef GE_WAIT_V
#undef GE_WAIT_L
#undef GE_BAR
#undef GE_SCHED
#undef GE_VOFFS
#undef GE_ADVANCE
#undef GE_SHIFT
}
__device__ __forceinline__ bool static_tile(int i, int G, int c, int nM, int nN, int& pm, int& pn) {
    const int nwg = nM * nN; const long L = (long)i * G + c; if (L >= nwg) return false;
    int wgid = (int)L; { const int q = nwg / 8, r = nwg % 8, xcd = wgid % 8, off = wgid / 8; wgid = (xcd < r ? xcd * (q + 1) : r * (q + 1) + (xcd - r) * q) + off; }
    const int nig = 8 * nN, gid = wgid / nig, fm = gid * 8, gsz = (nM - fm) < 8 ? (nM - fm) : 8;
    pm = fm + ((wgid % nig) % gsz); pn = (wgid % nig) / gsz; return true;
}
__device__ __forceinline__ unsigned cvt_pk_bf16(float lo, float hi) { unsigned r; asm volatile("v_cvt_pk_bf16_f32 %0, %1, %2" : "=v"(r) : "v"(lo), "v"(hi)); return r; }
__device__ __forceinline__ u32x4 pack8(const f32x4 a, const f32x4 b) { u32x4 w; w.x = cvt_pk_bf16(a[0], a[1]); w.y = cvt_pk_bf16(a[2], a[3]); w.z = cvt_pk_bf16(b[0], b[1]); w.w = cvt_pk_bf16(b[2], b[3]); return w; }
__device__ __forceinline__ void unpack8(const u32x4 w, f32x4& a, f32x4& b) { a = (f32x4){bflo(w.x), bfhi(w.x), bflo(w.y), bfhi(w.y)}; b = (f32x4){bflo(w.z), bfhi(w.z), bflo(w.w), bfhi(w.w)}; }
__device__ __forceinline__ float fsigm(float x) { return __builtin_amdgcn_rcpf(1.f + __builtin_amdgcn_exp2f(-1.4426950408889634f * x)); }
__device__ __forceinline__ float fgelu(float y) { return y * fsigm(1.5957691216057308f * (y + 0.044715f * y * y * y)); }
__device__ __forceinline__ f32x4 silu4(f32x4 v) { return (f32x4){v[0] * fsigm(v[0]), v[1] * fsigm(v[1]), v[2] * fsigm(v[2]), v[3] * fsigm(v[3])}; }
__device__ __forceinline__ f32x4 sigm4(f32x4 v) { return (f32x4){fsigm(v[0]), fsigm(v[1]), fsigm(v[2]), fsigm(v[3])}; }
__device__ __forceinline__ f32x4 gelu4(f32x4 v) { return (f32x4){fgelu(v[0]), fgelu(v[1]), fgelu(v[2]), fgelu(v[3])}; }
#define GE_FOR_PERM(...) _Pragma("unroll") for (int ai = 0; ai < 2; ++ai) _Pragma("unroll") for (int m = 0; m < 4; ++m) _Pragma("unroll") for (int bj = 0; bj < 2; ++bj) { \
        const int row = ai * HALF + wr * 64 + m * 16 + fr, col8 = bj * HALF + wc * 32 + 8 * fq; __VA_ARGS__ }

struct PA_Sched {
    int G, c; const unsigned char *ws, *wl;
    __device__ __forceinline__ bool unit(int i, Unit& u) const {
        constexpr int nwg = (T / 256) * (N_A1 / 256); const int nA = c < nwg ? (nwg - c + G - 1) / G : 0;
        if (i < nA) { u.type = 0; u.g = 0; return static_tile(i, G, c, T / 256, N_A1 / 256, u.pm, u.pn); }
        if (i == nA && c < 16) { u.type = 1; u.pm = c >> 2; u.pn = c & 3; u.g = 0; return true; }
        return false;
    }
    __device__ __forceinline__ int nseg(const Unit&) const { return 1; }
    __device__ __forceinline__ void seg(const Unit& u, int, Seg& s) const {
        s.A = (const char*)(ws + (u.type == 0 ? OFF_XB : OFF_MEMB)) + (size_t)u.pm * 256 * 2048; s.B = (const char*)(wl + (u.type == 0 ? WO_IN : WO_MKV)) + (size_t)u.pn * 256 * 2048;
        s.a_h = 128 * 2048; s.b_h = 128 * 2048; s.a_k = 128; s.b_k = 128; s.npairs = 8; s.amode = A_STD; s.bmode = B_PERM; s.lda2 = 2048; s.ldb2 = 2048;
    }
};
struct PA_Epi {
    GAS unsigned char* ws; int l;
    __device__ __forceinline__ void seg_end(Acc&, const Unit&, int, int, int, int, int) const {}
    __device__ __forceinline__ void after_drain(Acc&, const Unit&, LAS unsigned char*, int, int, int, int) const {}
    __device__ __forceinline__ void finish(Acc& acc, const Unit& u, int wr, int wc, int fr, int fq) const {
        const int pn = u.pn;
        float r8[8];
        if (u.type == 1) {
#pragma unroll
            for (int i = 0; i < 8; ++i) r8[i] = ((const GAS float*)(ws + OFF_RSMEM))[u.pm * 256 + (i >> 2) * HALF + wr * 64 + (i & 3) * 16 + fr];
        } else {
            load_rs8(ws, u.pm * 256, wr, fr, r8);
        }
        if (u.type == 1) {
            auto KVM = (GAS bf16_t*)(ws + OFF_KVM + (size_t)l * 2 * MiB);
            GE_FOR_PERM({ const int tr = u.pm * 256 + row; const float r = r8[ai * 4 + m]; *(GAS u32x4*)(KVM + (size_t)tr * 1024 + pn * 256 + col8) = pack8(acc[ai][bj][m][0] * r, acc[ai][bj][m][1] * r); })
            return;
        }
        if (pn < 3) {
            auto U = (GAS bf16_t*)(ws + OFF_U);
            GE_FOR_PERM({ const int tr = u.pm * 256 + row; const float r = r8[ai * 4 + m]; const int c = pn * 256 + col8;
                *(GAS u32x4*)(U + ((size_t)(c >> 4) * 1024 + (tr >> 5)) * 640 + (tr & 31) * 16 + (c & 15)) = pack8(acc[ai][bj][m][0] * r, acc[ai][bj][m][1] * r); })
        } else if (pn < 18) {
            const int k = (pn - 3) / 3; const size_t off = k == 0 ? OFF_ZS : (k == 1 ? OFF_Q : (k == 2 ? OFF_K : (k == 3 ? OFF_V : OFF_ZA)));
            auto D = (GAS bf16_t*)(ws + off); const bool silu = (k == 0 || k == 4); const float sc = k == 1 ? 0.125f * 1.4426950408889634f : 1.0f;
            const int cb = (pn - 3 - 3 * k) * 256;
            if (silu) { GE_FOR_PERM({ const int tr = u.pm * 256 + row; const float r = r8[ai * 4 + m]; *(GAS u32x4*)(D + (size_t)tr * 768 + cb + col8) = pack8(silu4(acc[ai][bj][m][0] * r), silu4(acc[ai][bj][m][1] * r)); }) }
            else { GE_FOR_PERM({ const int tr = u.pm * 256 + row; const float r = r8[ai * 4 + m] * sc; *(GAS u32x4*)(D + (size_t)tr * 768 + cb + col8) = pack8(acc[ai][bj][m][0] * r, acc[ai][bj][m][1] * r); }) }
        } else {
            const bool isz = pn >= 20; auto D = (GAS bf16_t*)(ws + (isz ? OFF_ZM : OFF_QM)); const int cb = (pn - (isz ? 20 : 18)) * 256; const float sc = isz ? 1.0f : 0.08838834764831845f * 1.4426950408889634f;
            if (isz) { GE_FOR_PERM({ const int tr = u.pm * 256 + row; const float r = r8[ai * 4 + m]; *(GAS u32x4*)(D + (size_t)tr * 512 + cb + col8) = pack8(silu4(acc[ai][bj][m][0] * r), silu4(acc[ai][bj][m][1] * r)); }) }
            else { GE_FOR_PERM({ const int tr = u.pm * 256 + row; const float r = r8[ai * 4 + m] * sc; *(GAS u32x4*)(D + (size_t)tr * 512 + cb + col8) = pack8(acc[ai][bj][m][0] * r, acc[ai][bj][m][1] * r); }) }
        }
    }
};
struct PS_Sched {
    int c; const unsigned char* ws;
    __device__ __forceinline__ bool unit(int i, Unit& u) const { if (i != 0 || c >= BATCH * NG) return false; u.type = 0; u.g = c % NG; u.pm = c / NG; u.pn = 0; return true; }
    __device__ __forceinline__ int nseg(const Unit&) const { return 1; }
    __device__ __forceinline__ void seg(const Unit& u, int, Seg& s) const {
        s.A = (const char*)((const bf16_t*)(ws + OFF_U) + ((size_t)u.g * 1024 + u.pm * 256) * 640); s.B = (const char*)((const bf16_t*)(ws + OFF_TAB + TAB_WST) + (size_t)u.g * 128 * 512);
        s.a_h = 128 * 1280; s.b_h = 128 * 1024; s.a_k = 128; s.b_k = 128; s.npairs = 4; s.amode = A_STD; s.bmode = B_STD; s.lda2 = 1280; s.ldb2 = 1024;
    }
};
struct PS_Epi {
    GAS unsigned char* ws;
    __device__ __forceinline__ void seg_end(Acc&, const Unit&, int, int, int, int, int) const {}
    __device__ __forceinline__ void finish(Acc&, const Unit&, int, int, int, int) const {}
    __device__ __forceinline__ void after_drain(Acc& acc, const Unit& u, LAS unsigned char* lds, int wr, int wc, int fr, int fq) const {
        LAS float* Sl = (LAS float*)lds;
#pragma unroll
        for (int ai = 0; ai < 2; ++ai)
#pragma unroll
            for (int m = 0; m < 4; ++m)
#pragma unroll
                for (int n = 0; n < 2; ++n) *(LAS f32x4*)(Sl + (ai * HALF + wr * 64 + m * 16 + fr) * 128 + wc * 32 + 16 * n + 4 * fq) = acc[ai][0][m][n];
        asm volatile("s_waitcnt lgkmcnt(0)" ::: "memory"); __builtin_amdgcn_s_barrier(); asm volatile("" ::: "memory");
        if (wr * 4 + wc == 0) {
            auto AQ = (const GAS float*)(ws + OFF_TAB + TAB_AQ); const int p = fq * 16 + fr; const float ar = AQ[(u.g * 64 + p) * 2], ai_ = AQ[(u.g * 64 + p) * 2 + 1];
            float xr = 0.f, xi = 0.f; auto up = (GAS bf16_t*)(ws + OFF_U) + ((size_t)u.g * 1024 + u.pm * 256) * 640 + 512 + p;
            for (int c = 0; c < 256; ++c) {
                up[(size_t)c * 640] = (bf16_t)f2bf(xr); up[(size_t)c * 640 + 64] = (bf16_t)f2bf(xi);
                const float sr = Sl[c * 128 + p], si = Sl[c * 128 + 64 + p];
                const float nxr = ar * xr - ai_ * xi + sr, nxi = ar * xi + ai_ * xr + si; xr = nxr; xi = nxi;
            }
        }
    }
};
struct PY_Sched {
    int c; const unsigned char* ws;
    __device__ __forceinline__ bool unit(int i, Unit& u) const { if (i > 1 || c >= BATCH * NG) return false; u.type = 0; u.pn = 1 - i; u.g = c % NG; u.pm = c / NG; return true; }
    __device__ __forceinline__ int nseg(const Unit&) const { return 2; }
    __device__ __forceinline__ void seg(const Unit& u, int si, Seg& s) const {
        const char* Arow = (const char*)((const bf16_t*)(ws + OFF_U) + ((size_t)u.g * 1024 + u.pm * 256) * 640);
        s.a_h = 128 * 1280; s.a_k = 128; s.amode = A_STD; s.lda2 = 1280;
        if (si == 0) { s.A = Arow; s.B = (const char*)((const bf16_t*)(ws + OFF_TAB + TAB_TOEP) + (size_t)u.g * 48 * 256) + (16 * u.pn + 13) * 512; s.b_h = 8 * 512; s.b_k = -2048; s.npairs = 2 * (u.pn + 1); s.bmode = B_TOEP; s.ldb2 = 0; }
        else { s.A = Arow + 1024; s.B = (const char*)((const bf16_t*)(ws + OFF_TAB + TAB_CST) + ((size_t)u.g * 512 + u.pn * 256) * 128); s.b_h = 128 * 256; s.b_k = 128; s.npairs = 1; s.bmode = B_PERM; s.ldb2 = 256; }
    }
};
struct PY_Epi {
    GAS unsigned char* ws;
    __device__ __forceinline__ void seg_end(Acc&, const Unit&, int, int, int, int, int) const {}
    __device__ __forceinline__ void after_drain(Acc&, const Unit&, LAS unsigned char*, int, int, int, int) const {}
    __device__ __forceinline__ void finish(Acc& acc, const Unit& u, int wr, int wc, int fr, int fq) const {
        auto base = (GAS bf16_t*)(ws + OFF_U) + ((size_t)u.g * 1024 + u.pm * 256) * 640 + u.pn * 256;
        GE_FOR_PERM({ *(GAS u32x4*)(base + (size_t)row * 640 + col8) = pack8(gelu4(acc[ai][bj][m][0]), gelu4(acc[ai][bj][m][1])); })
    }
};
struct PG_Sched {
    int G, c; const unsigned char *ws, *wl;
    __device__ __forceinline__ bool unit(int i, Unit& u) const { u.type = 0; u.g = 0; return static_tile(i, G, c, T / 256, 3, u.pm, u.pn); }
    __device__ __forceinline__ int nseg(const Unit&) const { return 1; }
    __device__ __forceinline__ void seg(const Unit& u, int, Seg& s) const {
        s.A = (const char*)(ws + OFF_U) + (size_t)u.pm * 8 * 1280; s.B = (const char*)(wl + WO_GLU) + (size_t)u.pn * 256 * 1536;
        s.a_h = 4 * 1280; s.a_k = 4 * 1024 * 1280; s.amode = A_GM; s.lda2 = 0; s.b_h = 128 * 1536; s.b_k = 128; s.bmode = B_PERM; s.ldb2 = 1536; s.npairs = 6;
    }
};
struct PG_Epi {
    GAS unsigned char* ws; const GAS float* b;
    __device__ __forceinline__ void seg_end(Acc&, const Unit&, int, int, int, int, int) const {}
    __device__ __forceinline__ void after_drain(Acc&, const Unit&, LAS unsigned char*, int, int, int, int) const {}
    __device__ __forceinline__ void finish(Acc& acc, const Unit& u, int wr, int wc, int fr, int fq) const {
        auto Y = (const GAS bf16_t*)(ws + OFF_U); auto ZS = (GAS bf16_t*)(ws + OFF_ZS);
        f32x4 bb[2][2];
#pragma unroll
        for (int j = 0; j < 2; ++j) { const int c = u.pn * 256 + j * HALF + wc * 32 + 8 * fq; bb[j][0] = *(const GAS f32x4*)(b + c); bb[j][1] = *(const GAS f32x4*)(b + c + 4); }
#pragma unroll
        for (int ai = 0; ai < 2; ++ai)
#pragma unroll
            for (int bj = 0; bj < 2; ++bj) {
                u32x4 yv[4], zv[4]; const int c = u.pn * 256 + bj * HALF + wc * 32 + 8 * fq;
#pragma unroll
                for (int m = 0; m < 4; ++m) { const int tr = u.pm * 256 + ai * HALF + wr * 64 + m * 16 + fr;
                    yv[m] = *(const GAS u32x4*)(Y + ((size_t)(c >> 4) * 1024 + (tr >> 5)) * 640 + (tr & 31) * 16 + (c & 15)); zv[m] = *(const GAS u32x4*)(ZS + (size_t)tr * 768 + c); }
#pragma unroll
                for (int m = 0; m < 4; ++m) { const int tr = u.pm * 256 + ai * HALF + wr * 64 + m * 16 + fr; f32x4 y0, y1, z0, z1; unpack8(yv[m], y0, y1); unpack8(zv[m], z0, z1);
                    *(GAS u32x4*)(ZS + (size_t)tr * 768 + c) = pack8(y0 * sigm4(acc[ai][bj][m][0] + bb[bj][0]) * z0, y1 * sigm4(acc[ai][bj][m][1] + bb[bj][1]) * z1); }
            }
    }
};
struct PM_Sched {
    int G, c; const unsigned char *ws, *wl;
    __device__ __forceinline__ bool unit(int i, Unit& u) const { const int t = i / 6; u.type = i - 6 * t; u.g = 0; return static_tile(t, G, c, T / 256, 4, u.pm, u.pn); }
    __device__ __forceinline__ int nseg(const Unit&) const { return 1; }
    __device__ __forceinline__ void seg(const Unit& u, int, Seg& s) const {
        s.a_k = 128; s.b_k = 128; s.amode = A_STD; s.bmode = B_PERM;
        if ((u.type & 1) == 0) { s.A = (const char*)(ws + OFF_XB) + (size_t)u.pm * 256 * 2048; s.B = (const char*)(wl + WO_IN) + (size_t)(N_A1 + (u.type >> 1) * 1024 + u.pn * 256) * 2048; s.lda2 = 2048; s.ldb2 = 2048; s.npairs = 8; }
        else if (u.type == 1) { s.A = (const char*)(ws + OFF_ZS) + (size_t)u.pm * 256 * 1536; s.B = (const char*)(wl + WO_B1) + (size_t)u.pn * 256 * 1536; s.lda2 = 1536; s.ldb2 = 1536; s.npairs = 6; }
        else if (u.type == 3) { s.A = (const char*)(ws + OFF_Q) + (size_t)u.pm * 256 * 1536; s.B = (const char*)(wl + WO_B2) + (size_t)u.pn * 256 * 1536; s.lda2 = 1536; s.ldb2 = 1536; s.npairs = 6; }
        else { s.A = (const char*)(ws + OFF_QM) + (size_t)u.pm * 256 * 1024; s.B = (const char*)(wl + WO_B3) + (size_t)u.pn * 256 * 1024; s.lda2 = 1024; s.ldb2 = 1024; s.npairs = 4; }
        s.a_h = 128 * (int)s.lda2; s.b_h = 128 * (int)s.ldb2;
    }
};
typedef _Float16 f16x8 __attribute__((ext_vector_type(8)));
struct PM_Epi {
    GAS unsigned char* ws; const GAS float* bg; int c, l;
    __device__ __forceinline__ void seg_end(Acc&, const Unit&, int, int, int, int, int) const {}
    __device__ __forceinline__ void after_drain(Acc&, const Unit&, LAS unsigned char*, int, int, int, int) const {}
    __device__ __forceinline__ void finish(Acc& acc, const Unit& u, int wr, int wc, int fr, int fq) const {
        const int t_ = (wr * 4 + wc) * 64 + fq * 16 + fr;
        GAS unsigned char* st = (ws + OFF_V + (size_t)c * 393216);
        if ((u.type & 1) == 0) {
            auto bgs = bg + (u.type >> 1) * 1024 + u.pn * 256;
            float r8[8]; f32x4 bb[2][2];
            load_rs8(ws, u.pm * 256, wr, fr, r8);
#pragma unroll
            for (int j = 0; j < 2; ++j) { bb[j][0] = *(const GAS f32x4*)(bgs + j * HALF + wc * 32 + 8 * fq); bb[j][1] = *(const GAS f32x4*)(bgs + j * HALF + wc * 32 + 8 * fq + 4); }
            GE_FOR_PERM({ (void)row; (void)col8; const float r = r8[ai * 4 + m]; const f32x4 b0 = bb[bj][0], b1 = bb[bj][1];
                const f32x4 g0 = sigm4(acc[ai][bj][m][0] * r + b0), g1 = sigm4(acc[ai][bj][m][1] * r + b1); f16x8 h;
                h[0] = (_Float16)g0[0]; h[1] = (_Float16)g0[1]; h[2] = (_Float16)g0[2]; h[3] = (_Float16)g0[3]; h[4] = (_Float16)g1[0]; h[5] = (_Float16)g1[1]; h[6] = (_Float16)g1[2]; h[7] = (_Float16)g1[3];
                *(GAS f16x8*)(st + ((ai * 2 + bj) * 4 + m) * 8192 + t_ * 16) = h; })
        } else if (u.type == 1) branch_fin<false, false>(acc, u, st, t_, wr, wc, fr, fq);
        else if (u.type == 3) branch_fin<true, false>(acc, u, st, t_, wr, wc, fr, fq);
        else branch_fin<true, true>(acc, u, st, t_, wr, wc, fr, fq);
    }
    template <bool ADD, bool LAST>
    __device__ __forceinline__ void branch_fin(Acc& acc, const Unit& u, GAS unsigned char* st, int t_, int wr, int wc, int fr, int fq) const {
#pragma unroll
        for (int ai = 0; ai < 2; ++ai)
#pragma unroll
            for (int bj = 0; bj < 2; ++bj) {
                f16x8 h[4]; f32x4 p0[4], p1[4];
#pragma unroll
                for (int m = 0; m < 4; ++m) { const int idx = (ai * 2 + bj) * 4 + m; h[m] = *(const GAS f16x8*)(st + idx * 8192 + t_ * 16);
                    if (ADD) { const GAS f32x4* ps = (const GAS f32x4*)(st + 131072 + idx * 16384 + t_ * 32); p0[m] = ps[0]; p1[m] = ps[1]; } }
#pragma unroll
                for (int m = 0; m < 4; ++m) { const int idx = (ai * 2 + bj) * 4 + m; f32x4 v0 = acc[ai][bj][m][0], v1 = acc[ai][bj][m][1];
#pragma unroll
                    for (int e2 = 0; e2 < 4; ++e2) { v0[e2] *= (float)h[m][e2]; v1[e2] *= (float)h[m][4 + e2]; }
                    if (ADD) { v0 = v0 + p0[m]; v1 = v1 + p1[m]; }
                    if (!LAST) { GAS f32x4* ps = (GAS f32x4*)(st + 131072 + idx * 16384 + t_ * 32); ps[0] = v0; ps[1] = v1; }
                    else { const int row = ai * HALF + wr * 64 + m * 16 + fr, col8 = bj * HALF + wc * 32 + 8 * fq;
                        *(GAS u32x4*)((GAS bf16_t*)(ws + OFF_MERGED) + (size_t)(u.pm * 256 + row) * 1024 + u.pn * 256 + col8) = pack8(v0, v1); } }
            }
    }
};
struct PO_Sched {
    int G, c; const unsigned char *ws, *wl;
    __device__ __forceinline__ bool unit(int i, Unit& u) const { u.type = 0; u.g = 0; return static_tile(i, G, c, T / 256, 4, u.pm, u.pn); }
    __device__ __forceinline__ int nseg(const Unit&) const { return 1; }
    __device__ __forceinline__ void seg(const Unit& u, int, Seg& s) const {
        s.A = (const char*)(ws + OFF_MERGED) + (size_t)u.pm * 256 * 2048; s.B = (const char*)(wl + WO_OUT) + (size_t)u.pn * 256 * 2048;
        s.a_h = 128 * 2048; s.b_h = 128 * 2048; s.a_k = 128; s.b_k = 128; s.npairs = 8; s.amode = A_STD; s.bmode = B_STD; s.lda2 = 2048; s.ldb2 = 2048;
    }
};
struct PO_Epi {
    const GAS float* xold; GAS float* xnew; GAS unsigned char* ws; int l;
    __device__ __forceinline__ void seg_end(Acc&, const Unit&, int, int, int, int, int) const {}
    __device__ __forceinline__ void after_drain(Acc&, const Unit&, LAS unsigned char*, int, int, int, int) const {}
    template <bool NEXT>
    __device__ __forceinline__ void fin(Acc& acc, const Unit& u, int wr, int wc, int fr, int fq) const {
        LAS float* part = (LAS float*)(size_t)RING_BYTES;
        auto XBo = (GAS bf16_t*)(ws + OFF_XB);
#pragma unroll
        for (int ai = 0; ai < 2; ++ai)
#pragma unroll
            for (int mh = 0; mh < 2; ++mh) {
                f32x4 xo[2][2][2];
#pragma unroll
                for (int mm = 0; mm < 2; ++mm) { const int m = mh * 2 + mm; const size_t ro = (size_t)(u.pm * 256 + ai * HALF + wr * 64 + m * 16 + fr) * 1024 + u.pn * 256 + wc * 32 + 4 * fq;
#pragma unroll
                    for (int bj = 0; bj < 2; ++bj)
#pragma unroll
                        for (int n = 0; n < 2; ++n) xo[mm][bj][n] = *(const GAS f32x4*)(xold + ro + bj * HALF + n * 16); }
#pragma unroll
                for (int mm = 0; mm < 2; ++mm) { const int m = mh * 2 + mm, row = ai * HALF + wr * 64 + m * 16 + fr; const size_t ro = (size_t)(u.pm * 256 + row) * 1024 + u.pn * 256 + wc * 32 + 4 * fq; float sq = 0.f;
#pragma unroll
                    for (int bj = 0; bj < 2; ++bj)
#pragma unroll
                        for (int n = 0; n < 2; ++n) { const size_t o = ro + bj * HALF + n * 16; const f32x4 v = xo[mm][bj][n] + acc[ai][bj][m][n]; *(GAS f32x4*)(xnew + o) = v;
                            if (NEXT) { *(GAS u32x2*)(XBo + o) = (u32x2){cvt_pk_bf16(v[0], v[1]), cvt_pk_bf16(v[2], v[3])}; sq += (v[0] * v[0] + v[1] * v[1]) + (v[2] * v[2] + v[3] * v[3]); } }
                    if (NEXT) { sq += __shfl_xor(sq, 16); sq += __shfl_xor(sq, 32); if (fq == 0) part[row * 4 + wc] = sq; } }
            }
        if (NEXT) {
            asm volatile("s_waitcnt lgkmcnt(0)" ::: "memory"); __builtin_amdgcn_s_barrier(); asm volatile("" ::: "memory");
            const int t = (wr * 4 + wc) * 64 + fq * 16 + fr;
            if (t < 256) { const f32x4 p = *(const LAS f32x4*)(part + t * 4); ((GAS float*)(ws + OFF_ROWSQ))[(size_t)(u.pm * 256 + t) * 4 + u.pn] = (p.x + p.y) + (p.z + p.w); }
            asm volatile("s_waitcnt lgkmcnt(0)" ::: "memory"); __builtin_amdgcn_s_barrier(); asm volatile("" ::: "memory");
        }
    }
    __device__ __forceinline__ void finish(Acc& acc, const Unit& u, int wr, int wc, int fr, int fq) const { if (l == 0) fin<true>(acc, u, wr, wc, fr, fq); else fin<false>(acc, u, wr, wc, fr, fq); }
};
}

__device__ __forceinline__ void cpow(float lmag, double rev1, int k, float& re, float& im) {
    const float m = expf((float)k * lmag); double r = (double)k * rev1; r -= rint(r);
    const float a = (float)(r * 6.283185307179586476925286766559); re = m * cosf(a); im = m * sinf(a);
}
__device__ __forceinline__ void tabgen(unsigned char* tab, const float* __restrict__ lam_re, const float* __restrict__ lam_im, const float* __restrict__ log_dt, const float* __restrict__ b_re, const float* __restrict__ b_im,
                                       const float* __restrict__ c_re, const float* __restrict__ c_im, const float* __restrict__ dvec, LAS float* scr, int gw, int ngw, int lane) {
    bf16_t* TOEP = (bf16_t*)(tab + TAB_TOEP); bf16_t* CST = (bf16_t*)(tab + TAB_CST); bf16_t* WST = (bf16_t*)(tab + TAB_WST); float* AQ = (float*)(tab + TAB_AQ);
    for (int item = gw; item < NG * 32; item += ngw) {
        const int g = item >> 5, d = item & 31, p = lane;
        const float dt = expf(log_dt[g]); const float lre = lam_re[g * 64 + p], lim = lam_im[g * 64 + p];
        const float lmag = lre * dt; const double rev1 = (double)lim * (double)dt * 0.15915494309189533576888376337251;
        float fr, fi;
        {
            double r = rev1; r -= rint(r); const float bq = (float)(r * 6.283185307179586476925286766559);
            const float em1 = expm1f(lmag), sb2 = sinf(0.5f * bq); const float nr = em1 * cosf(bq) - 2.f * sb2 * sb2, ni = (em1 + 1.f) * sinf(bq);
            const float den = lre * lre + lim * lim; fr = (nr * lre + ni * lim) / den; fi = (ni * lre - nr * lim) / den;
        }
        float bbr[16], bbi[16];
#pragma unroll
        for (int h = 0; h < 16; ++h) { const float br = b_re[(g * 64 + p) * 16 + h], bi = b_im[(g * 64 + p) * 16 + h]; bbr[h] = fr * br - fi * bi; bbi[h] = fr * bi + fi * br; }
        float pr, pi;
        cpow(lmag, rev1, 31 - d, pr, pi);
        {
            unsigned wre[8], wim[8];
#pragma unroll
            for (int h = 0; h < 16; h += 2) { wre[h >> 1] = pk2(pr * bbr[h] - pi * bbi[h], pr * bbr[h + 1] - pi * bbi[h + 1]); wim[h >> 1] = pk2(pr * bbi[h] + pi * bbr[h], pr * bbi[h + 1] + pi * bbr[h + 1]); }
            u32x4* o0 = (u32x4*)(WST + ((size_t)g * 128 + p) * 512 + d * 16); u32x4* o1 = (u32x4*)(WST + ((size_t)g * 128 + 64 + p) * 512 + d * 16);
            o0[0] = (u32x4){wre[0], wre[1], wre[2], wre[3]}; o0[1] = (u32x4){wre[4], wre[5], wre[6], wre[7]};
            o1[0] = (u32x4){wim[0], wim[1], wim[2], wim[3]}; o1[1] = (u32x4){wim[4], wim[5], wim[6], wim[7]};
        }
        cpow(lmag, rev1, d + 1, pr, pi);
#pragma unroll 2
        for (int hq = 0; hq < 16; ++hq) { const float cr = c_re[(g * 16 + hq) * 64 + p], ci = c_im[(g * 16 + hq) * 64 + p];
            bf16_t* o = CST + ((size_t)g * 512 + d * 16 + hq) * 128; o[p] = (bf16_t)f2bf(cr * pr - ci * pi); o[64 + p] = (bf16_t)f2bf(-(cr * pi + ci * pr)); }
        cpow(lmag, rev1, d, pr, pi);
#pragma unroll
        for (int h = 0; h < 16; ++h) { scr[(p * 16 + h) * 2] = pr * bbr[h] - pi * bbi[h]; scr[(p * 16 + h) * 2 + 1] = pr * bbi[h] + pi * bbr[h]; }
        asm volatile("s_waitcnt lgkmcnt(0)" ::: "memory");
        {
            const int hq = lane >> 2, h0 = (lane & 3) * 4; float a0 = 0.f, a1 = 0.f, a2 = 0.f, a3 = 0.f;
            for (int q = 0; q < 64; ++q) { const float cr = c_re[(g * 16 + hq) * 64 + q], ci = c_im[(g * 16 + hq) * 64 + q]; const LAS float* s = scr + (q * 16 + h0) * 2;
                a0 += cr * s[0] - ci * s[1]; a1 += cr * s[2] - ci * s[3]; a2 += cr * s[4] - ci * s[5]; a3 += cr * s[6] - ci * s[7]; }
            if (d == 0) { const float dd = dvec[g * 16 + hq]; if (hq == h0) a0 += dd; if (hq == h0 + 1) a1 += dd; if (hq == h0 + 2) a2 += dd; if (hq == h0 + 3) a3 += dd; }
            *(u32x2*)(TOEP + ((size_t)g * 48 + 16 + d) * 256 + hq * 16 + h0) = (u32x2){pk2(a0, a1), pk2(a2, a3)};
            if (d < 16) *(u32x2*)(TOEP + ((size_t)g * 48 + d) * 256 + hq * 16 + h0) = (u32x2){0u, 0u};
        }
        asm volatile("s_waitcnt lgkmcnt(0)" ::: "memory");
        if (d == 0) { cpow(lmag, rev1, 32, pr, pi); AQ[(g * 64 + p) * 2] = pr; AQ[(g * 64 + p) * 2 + 1] = pi; }
    }
}

namespace at {
__device__ __forceinline__ int crow(int r, int hi) { return (r & 3) + 8 * (r >> 2) + 4 * hi; }
__device__ __forceinline__ unsigned cvtpk(float lo, float hi) { unsigned r; asm volatile("v_cvt_pk_bf16_f32 %0, %1, %2" : "=v"(r) : "v"(lo), "v"(hi)); return r; }
constexpr float LOG2E = 1.4426950408889634f, LN2 = 0.6931471805599453f;
constexpr int D_VTS = 388;
constexpr int D_LK = 0, D_LVT = 49152, D_LBIAS = D_LVT + 64 * D_VTS * 2, D_LSCR = D_LBIAS + 1024, D_LEND = D_LSCR + 8 * 128;
static_assert(D_LEND <= 146432, "dilated attention LDS");
__device__ __forceinline__ void dil_unit(LAS unsigned char* lds, GAS unsigned char* ws, const GAS float* __restrict__ rel_bias, int b, int head, int r, int s, int np, int tid) {
    const int lane = tid & 63, wave = __builtin_amdgcn_readfirstlane(tid >> 6), r32 = lane & 31, hi = lane >> 5;
    GAS bf16_t* Q = (GAS bf16_t*)(ws + OFF_Q); const GAS bf16_t* Kb = (const GAS bf16_t*)(ws + OFF_K); const GAS bf16_t* V = (const GAS bf16_t*)(ws + OFF_V); GAS float* lse = (GAS float*)(ws + OFF_LSE);
    const size_t rowbase = (size_t)b * SEQ; const int M0 = np * 256, mk0 = M0 - 128;
#pragma unroll
    for (int i = 0; i < 6; ++i) {
        const int idx = tid + 512 * i, key = idx >> 3, ch = idx & 7, mk = mk0 + key; u32x4 kv = (u32x4){0u, 0u, 0u, 0u};
        if (mk >= 0) kv = *(const GAS u32x4*)(Kb + (rowbase + (size_t)mk * r + s) * 768 + head * 64 + ch * 8);
        *(LAS u32x4*)(lds + D_LK + key * 128 + ((ch ^ ((key >> 1) & 7)) << 4)) = kv;
    }
#pragma unroll
    for (int i = 0; i < 3; ++i) {
        const int idx = tid + 512 * i, key = (idx >> 3) * 2, ch = idx & 7, mk = mk0 + key; u32x4 v0 = (u32x4){0u, 0u, 0u, 0u}, v1 = v0;
        if (mk >= 0) { const GAS bf16_t* vp = V + (rowbase + (size_t)mk * r + s) * 768 + head * 64 + ch * 8; v0 = *(const GAS u32x4*)vp; v1 = *(const GAS u32x4*)(vp + (size_t)r * 768); }
        LAS unsigned* vt = (LAS unsigned*)(lds + D_LVT + ((ch * 8) * D_VTS + key) * 2);
        vt[0 * (D_VTS / 2)] = (v0.x & 0xffffu) | (v1.x << 16); vt[1 * (D_VTS / 2)] = (v0.x >> 16) | (v1.x & 0xffff0000u);
        vt[2 * (D_VTS / 2)] = (v0.y & 0xffffu) | (v1.y << 16); vt[3 * (D_VTS / 2)] = (v0.y >> 16) | (v1.y & 0xffff0000u);
        vt[4 * (D_VTS / 2)] = (v0.z & 0xffffu) | (v1.z << 16); vt[5 * (D_VTS / 2)] = (v0.z >> 16) | (v1.z & 0xffff0000u);
        vt[6 * (D_VTS / 2)] = (v0.w & 0xffffu) | (v1.w << 16); vt[7 * (D_VTS / 2)] = (v0.w >> 16) | (v1.w & 0xffff0000u);
    }
    if (tid < 129) ((LAS float*)(lds + D_LBIAS))[tid] = rel_bias[rel_bucket(tid * r) * NH + head] * LOG2E;
    const size_t qtok = rowbase + (size_t)(M0 + 32 * wave + r32) * r + s;
    bf16x8 qf[4];
#pragma unroll
    for (int ks = 0; ks < 4; ++ks) qf[ks] = *(const GAS bf16x8*)(Q + qtok * 768 + head * 64 + 16 * ks + 8 * hi);
    __syncthreads();
    f32x16 S[5];
#pragma unroll
    for (int t = 0; t < 5; ++t) {
#pragma unroll
        for (int q = 0; q < 16; ++q) S[t][q] = 0.f;
        const int key = 32 * (wave + t) + r32; const LAS unsigned char* kp = lds + D_LK + key * 128; const int sw = (key >> 1) & 7;
#pragma unroll
        for (int ks = 0; ks < 4; ++ks) S[t] = __builtin_amdgcn_mfma_f32_32x32x16_bf16(*(const LAS bf16x8*)(kp + (((2 * ks + hi) ^ sw) << 4)), qf[ks], S[t], 0, 0, 0);
    }
    const LAS float* biasl = (const LAS float*)(lds + D_LBIAS);
    float mx = -1e30f;
#pragma unroll
    for (int t = 0; t < 5; ++t)
#pragma unroll
        for (int q = 0; q < 16; ++q) {
            const int kk = crow(q, hi), delta = 128 + r32 - 32 * t - kk; const bool ok = (delta >= 0) && (delta <= 128) && (mk0 + 32 * (wave + t) + kk >= 0);
            const int di = delta < 0 ? 0 : (delta > 128 ? 128 : delta);
            const float v = ok ? S[t][q] + biasl[di] : -1e30f; S[t][q] = v; mx = fmaxf(mx, v);
        }
    mx = fmaxf(mx, __shfl_xor(mx, 32));
    float lsum = 0.f; unsigned pk[5][8];
#pragma unroll
    for (int t = 0; t < 5; ++t) {
#pragma unroll
        for (int q = 0; q < 16; ++q) { const float p = __builtin_amdgcn_exp2f(S[t][q] - mx); S[t][q] = p; lsum += p; }
#pragma unroll
        for (int q = 0; q < 8; ++q) pk[t][q] = cvtpk(S[t][2 * q], S[t][2 * q + 1]);
    }
    lsum += __shfl_xor(lsum, 32);
    f32x16 O[2];
#pragma unroll
    for (int d0 = 0; d0 < 2; ++d0)
#pragma unroll
        for (int q = 0; q < 16; ++q) O[d0][q] = 0.f;
#pragma unroll
    for (int t = 0; t < 5; ++t)
#pragma unroll
        for (int s2 = 0; s2 < 2; ++s2) {
            const bf16x8 A = __builtin_bit_cast(bf16x8, (u32x4){pk[t][4 * s2], pk[t][4 * s2 + 1], pk[t][4 * s2 + 2], pk[t][4 * s2 + 3]});
#pragma unroll
            for (int d0 = 0; d0 < 2; ++d0) {
                const LAS unsigned char* vp = lds + D_LVT + ((32 * d0 + r32) * D_VTS + 32 * (wave + t) + 16 * s2 + 4 * hi) * 2;
                const u32x2 lo = *(const LAS u32x2*)vp, hi2 = *(const LAS u32x2*)(vp + 16);
                O[d0] = __builtin_amdgcn_mfma_f32_32x32x16_bf16(A, __builtin_bit_cast(bf16x8, (u32x4){lo.x, lo.y, hi2.x, hi2.y}), O[d0], 0, 0, 0);
            }
        }
    LAS float* scr = (LAS float*)(lds + D_LSCR + wave * 128);
    if (hi == 0) { scr[r32] = __builtin_amdgcn_rcpf(lsum); lse[qtok * NH + head] = (mx + __builtin_amdgcn_logf(lsum)) * LN2; }
    __syncthreads();
    LAS bf16_t* stg = (LAS bf16_t*)(lds + D_LK + wave * 4096);
#pragma unroll
    for (int q = 0; q < 16; ++q) { const int orow = crow(q, hi); const float ri = scr[orow];
        stg[orow * 64 + r32] = (bf16_t)f2bf(O[0][q] * ri); stg[orow * 64 + 32 + r32] = (bf16_t)f2bf(O[1][q] * ri); }
    asm volatile("s_waitcnt lgkmcnt(0)" ::: "memory");
#pragma unroll
    for (int i = 0; i < 4; ++i) { const int row = i * 8 + (lane >> 3), ch = lane & 7;
        *(GAS u32x4*)(Q + (rowbase + (size_t)(M0 + 32 * wave + row) * r + s) * 768 + head * 64 + ch * 8) = *(const LAS u32x4*)(stg + row * 64 + ch * 8); }
    __syncthreads();
}
constexpr int M_VTS = 260;
constexpr int M_LK = 0, M_LVT = 65536, M_LSCR = M_LVT + 128 * M_VTS * 2, M_LEND = M_LSCR + 8 * 128;
static_assert(M_LEND <= 146432, "memory attention LDS");
__device__ __forceinline__ void mem_unit(LAS unsigned char* lds, GAS unsigned char* ws, int l, int b, int head, int qb, int tid) {
    const int lane = tid & 63, wave = __builtin_amdgcn_readfirstlane(tid >> 6), r32 = lane & 31, hi = lane >> 5;
    GAS bf16_t* QM = (GAS bf16_t*)(ws + OFF_QM); const GAS bf16_t* ZM = (const GAS bf16_t*)(ws + OFF_ZM); const GAS bf16_t* KVM = (const GAS bf16_t*)(ws + OFF_KVM + (size_t)l * 2 * MiB) + (size_t)b * 256 * 1024 + head * 128;
#pragma unroll
    for (int i = 0; i < 8; ++i) {
        const int idx = tid + 512 * i, key = idx >> 4, ch = idx & 15;
        *(LAS u32x4*)(lds + M_LK + key * 256 + ((ch ^ (key & 15)) << 4)) = *(const GAS u32x4*)(KVM + (size_t)key * 1024 + ch * 8);
    }
#pragma unroll
    for (int i = 0; i < 4; ++i) {
        const int idx = tid + 512 * i, key = (idx >> 4) * 2, ch = idx & 15; const GAS bf16_t* vp = KVM + (size_t)key * 1024 + 512 + ch * 8;
        const u32x4 v0 = *(const GAS u32x4*)vp, v1 = *(const GAS u32x4*)(vp + 1024);
        LAS unsigned* vt = (LAS unsigned*)(lds + M_LVT + ((ch * 8) * M_VTS + key) * 2);
        vt[0 * (M_VTS / 2)] = (v0.x & 0xffffu) | (v1.x << 16); vt[1 * (M_VTS / 2)] = (v0.x >> 16) | (v1.x & 0xffff0000u);
        vt[2 * (M_VTS / 2)] = (v0.y & 0xffffu) | (v1.y << 16); vt[3 * (M_VTS / 2)] = (v0.y >> 16) | (v1.y & 0xffff0000u);
        vt[4 * (M_VTS / 2)] = (v0.z & 0xffffu) | (v1.z << 16); vt[5 * (M_VTS / 2)] = (v0.z >> 16) | (v1.z & 0xffff0000u);
        vt[6 * (M_VTS / 2)] = (v0.w & 0xffffu) | (v1.w << 16); vt[7 * (M_VTS / 2)] = (v0.w >> 16) | (v1.w & 0xffff0000u);
    }
    const size_t qrow0 = (size_t)b * SEQ + qb * 256 + 32 * wave;
    __syncthreads();
    f32x16 S[8];
#pragma unroll
    for (int t = 0; t < 8; ++t)
#pragma unroll
        for (int q = 0; q < 16; ++q) S[t][q] = 0.f;
#pragma unroll
    for (int ks = 0; ks < 8; ++ks) {
        const bf16x8 qf = *(const GAS bf16x8*)(QM + (qrow0 + r32) * 512 + head * 128 + 16 * ks + 8 * hi);
#pragma unroll
        for (int t = 0; t < 8; ++t) { const int key = 32 * t + r32;
            S[t] = __builtin_amdgcn_mfma_f32_32x32x16_bf16(*(const LAS bf16x8*)(lds + M_LK + key * 256 + (((2 * ks + hi) ^ (key & 15)) << 4)), qf, S[t], 0, 0, 0); }
    }
    float mx = -1e30f;
#pragma unroll
    for (int t = 0; t < 8; ++t)
#pragma unroll
        for (int q = 0; q < 16; ++q) mx = fmaxf(mx, S[t][q]);
    mx = fmaxf(mx, __shfl_xor(mx, 32));
    float lsum = 0.f; unsigned pk[8][8];
#pragma unroll
    for (int t = 0; t < 8; ++t) {
#pragma unroll
        for (int q = 0; q < 16; ++q) { const float p = __builtin_amdgcn_exp2f(S[t][q] - mx); S[t][q] = p; lsum += p; }
#pragma unroll
        for (int q = 0; q < 8; ++q) pk[t][q] = cvtpk(S[t][2 * q], S[t][2 * q + 1]);
    }
    lsum += __shfl_xor(lsum, 32);
    f32x16 O[4];
#pragma unroll
    for (int d0 = 0; d0 < 4; ++d0)
#pragma unroll
        for (int q = 0; q < 16; ++q) O[d0][q] = 0.f;
#pragma unroll
    for (int t = 0; t < 8; ++t)
#pragma unroll
        for (int s2 = 0; s2 < 2; ++s2) {
            const bf16x8 A = __builtin_bit_cast(bf16x8, (u32x4){pk[t][4 * s2], pk[t][4 * s2 + 1], pk[t][4 * s2 + 2], pk[t][4 * s2 + 3]});
#pragma unroll
            for (int d0 = 0; d0 < 4; ++d0) {
                const LAS unsigned char* vp = lds + M_LVT + ((32 * d0 + r32) * M_VTS + 32 * t + 16 * s2 + 4 * hi) * 2;
                const u32x2 lo = *(const LAS u32x2*)vp, hi2 = *(const LAS u32x2*)(vp + 16);
                O[d0] = __builtin_amdgcn_mfma_f32_32x32x16_bf16(A, __builtin_bit_cast(bf16x8, (u32x4){lo.x, lo.y, hi2.x, hi2.y}), O[d0], 0, 0, 0);
            }
        }
    LAS float* scr = (LAS float*)(lds + M_LSCR + wave * 128);
    if (hi == 0) scr[r32] = __builtin_amdgcn_rcpf(lsum);
    __syncthreads();
    LAS bf16_t* stg = (LAS bf16_t*)(lds + M_LK + wave * 8192);
#pragma unroll
    for (int q = 0; q < 16; ++q) { const int orow = crow(q, hi); const float ri = scr[orow];
#pragma unroll
        for (int d0 = 0; d0 < 4; ++d0) stg[orow * 128 + 32 * d0 + r32] = (bf16_t)f2bf(O[d0][q] * ri); }
    asm volatile("s_waitcnt lgkmcnt(0)" ::: "memory");
#pragma unroll
    for (int i = 0; i < 8; ++i) { const int row = i * 4 + (lane >> 4), ch = lane & 15; const size_t go = (qrow0 + row) * 512 + head * 128 + ch * 8;
        const u32x4 o = *(const LAS u32x4*)(stg + row * 128 + ch * 8), z = *(const GAS u32x4*)(ZM + go);
        *(GAS u32x4*)(QM + go) = (u32x4){pk2(bflo(o.x) * bflo(z.x), bfhi(o.x) * bfhi(z.x)), pk2(bflo(o.y) * bflo(z.y), bfhi(o.y) * bfhi(z.y)),
                                     pk2(bflo(o.z) * bflo(z.z), bfhi(o.z) * bfhi(z.z)), pk2(bflo(o.w) * bflo(z.w), bfhi(o.w) * bfhi(z.w))}; }
    __syncthreads();
}
}

constexpr int PTR_OFF = MISC_OFF + 256;
__device__ __forceinline__ const float* ld_inptr(LAS unsigned char* lds, int k) {
    const unsigned long long v = ((volatile LAS unsigned long long*)(lds + PTR_OFF))[k];
    const unsigned lo = __builtin_amdgcn_readfirstlane((unsigned)v), hi = __builtin_amdgcn_readfirstlane((unsigned)(v >> 32));
    return (const float*)(GAS const float*)(((unsigned long long)hi << 32) | lo);
}
struct Args { const float* in[23]; float* out; unsigned char* ws; int ph_lo, ph_hi; };
__global__ void __launch_bounds__(NTHREADS, 2) mega_fwd(Args args) {
    extern __shared__ __attribute__((aligned(16))) unsigned char lds_raw[];
    LAS unsigned char* lds = (LAS unsigned char*)lds_raw;
    const int G_ = gridDim.x, ngw = G_ * NWAVES;
#define PHASE_IDS() const int tid = fresh_tid(), lane = tid & 63, wave = __builtin_amdgcn_readfirstlane(tid >> 6), cb = fresh_bid(), gw = cb * NWAVES + wave; (void)lane; (void)gw; (void)tid; \
        GAS unsigned char* ws = (GAS unsigned char*)fresh_ptr(args.ws); GAS unsigned char* out_p = (GAS unsigned char*)fresh_ptr((unsigned char*)args.out); (void)ws; (void)out_p
    for (int u = threadIdx.x; u < (LDS_BYTES - LDSCTL_OFF) / 4; u += NTHREADS) ((LAS unsigned*)(lds + LDSCTL_OFF))[u] = 0u;
    __syncthreads();
    if (threadIdx.x == 0) {
#pragma unroll
        for (int k = 0; k < 23; ++k) ((volatile LAS unsigned long long*)(lds + PTR_OFF))[k] = (unsigned long long)args.in[k];
    }
    __syncthreads();
#define INP(k) ld_inptr(lds, k)
    XcdBarrier bar = xcd_barrier_post((unsigned*)args.ws + CW_BAR, (volatile LAS unsigned*)(lds + MISC_OFF) + 8);
#define xout ((float*)(unsigned char*)out_p)
#define rs ((float*)(unsigned char*)(ws + OFF_RS))
#define rs_mem ((float*)(unsigned char*)(ws + OFF_RSMEM))
#define lse ((float*)(unsigned char*)(ws + OFF_LSE))
#define XB ((bf16_t*)(unsigned char*)(ws + OFF_XB))
#define U ((bf16_t*)(unsigned char*)(ws + OFF_U))
#define ZM ((bf16_t*)(unsigned char*)(ws + OFF_ZM))
#define ZS ((bf16_t*)(unsigned char*)(ws + OFF_ZS))
#define Q ((bf16_t*)(unsigned char*)(ws + OFF_Q))
#define Kb ((bf16_t*)(unsigned char*)(ws + OFF_K))
#define V ((bf16_t*)(unsigned char*)(ws + OFF_V))
#define ZA ((bf16_t*)(unsigned char*)(ws + OFF_ZA))
#define QM ((bf16_t*)(unsigned char*)(ws + OFF_QM))
#define Y ((bf16_t*)(unsigned char*)(ws + OFF_Y))
#define MG ((bf16_t*)(unsigned char*)(ws + OFF_MERGED))
#define MEMB ((bf16_t*)(unsigned char*)(ws + OFF_MEMB))
#define tab ((unsigned char*)(ws + OFF_TAB))
#define x_in INP(0)
#define mem INP(1)
#define norm_g INP(2)
#define mem_norm_g INP(3)
#define w_in INP(4)
#define b_gate INP(5)
#define lam_re INP(6)
#define lam_im INP(7)
#define log_dt INP(8)
#define b_re INP(9)
#define b_im INP(10)
#define c_re INP(11)
#define c_im INP(12)
#define ssm_d INP(13)
#define w_glu INP(14)
#define b_glu INP(15)
#define w_mem_kv INP(16)
#define w_br_ssm INP(17)
#define w_br_attn INP(18)
#define w_br_mem INP(19)
#define w_out INP(20)
#define rel_bias INP(21)
#define final_g INP(22)
#define WL(l, o) ((bf16_t*)(unsigned char*)(ws + OFF_W + (size_t)(l) * W_STRIDE + (o)))
#define GRID_BAR() xcd_barrier(bar)
#define TABGEN(l) tabgen(tab, lam_re + (l) * NG * NP, lam_im + (l) * NG * NP, log_dt + (l) * NG, b_re + (size_t)(l) * NG * NP * HG, b_im + (size_t)(l) * NG * NP * HG, \
                         c_re + (size_t)(l) * NG * HG * NP, c_im + (size_t)(l) * NG * HG * NP, ssm_d + (l) * D_SSM, (LAS float*)(lds + wave * 16384), gw, ngw, lane)
    {
        PHASE_IDS();
        LAS float* scr = (LAS float*)(lds + wave * 16384);
        for (int l = 0; l < DEPTH; ++l) {
            constexpr int I_IN = (1024 / 64) * (D_IN / 32), I_GLU = (768 / 64) * (768 / 32), I_B12 = (768 / 64) * (1024 / 32), I_B3 = (512 / 64) * (1024 / 32), I_SQ = (1024 / 64) * (1024 / 32);
            constexpr int NIT = I_IN + I_GLU + 2 * I_B12 + I_B3 + 2 * I_SQ;
            for (int it = gw; it < NIT; it += ngw) {
                int r = it;
                if (r < I_IN) { transpose_item(w_in + (size_t)l * 1024 * D_IN, 1024, D_IN, WL(l, WO_IN), 1024, norm_g + l * 1024, scr, r, lane); continue; } r -= I_IN;
                if (r < I_GLU) { transpose_item(w_glu + (size_t)l * 768 * 768, 768, 768, WL(l, WO_GLU), 768, nullptr, scr, r, lane); continue; } r -= I_GLU;
                if (r < I_B12) { transpose_item(w_br_ssm + (size_t)l * 768 * 1024, 768, 1024, WL(l, WO_B1), 768, nullptr, scr, r, lane); continue; } r -= I_B12;
                if (r < I_B12) { transpose_item(w_br_attn + (size_t)l * 768 * 1024, 768, 1024, WL(l, WO_B2), 768, nullptr, scr, r, lane); continue; } r -= I_B12;
                if (r < I_B3) { transpose_item(w_br_mem + (size_t)l * 512 * 1024, 512, 1024, WL(l, WO_B3), 512, nullptr, scr, r, lane); continue; } r -= I_B3;
                if (r < I_SQ) { transpose_item(w_out + (size_t)l * 1024 * 1024, 1024, 1024, WL(l, WO_OUT), 1024, nullptr, scr, r, lane); continue; } r -= I_SQ;
                transpose_item(w_mem_kv + (size_t)l * 1024 * 1024, 1024, 1024, WL(l, WO_MKV), 1024, mem_norm_g + l * 1024, scr, r, lane);
            }
        }
        for (int m = gw; m < T; m += ngw) rownorm_row(x_in, XB, rs, m, lane, (float*)(unsigned char*)(ws + OFF_ROWSQ));
        for (int m = gw; m < BATCH * MEM_LEN; m += ngw) rownorm_row(mem, MEMB, rs_mem, m, lane);
        TABGEN(0);
    }
    GRID_BAR();
#pragma unroll 1
    for (int l = 0; l < DEPTH; ++l) {
#define KVM ((bf16_t*)(unsigned char*)(ws + OFF_KVM + (size_t)l * 2 * MiB))
        {
            PHASE_IDS();
            if (l > 0) { TABGEN(l); __syncthreads(); }
            ge::PA_Sched S{G_, cb, (unsigned char*)ws, (unsigned char*)ws + OFF_W + (size_t)l * W_STRIDE};
            ge::PA_Epi E{ws, l};
            ge::gemm_run(lds, S, E);
        }
        GRID_BAR();
        {
            PHASE_IDS();
            { ge::PS_Sched S{cb, (unsigned char*)ws}; ge::PS_Epi E{ws}; ge::gemm_run(lds, S, E); }
            asm volatile("s_waitcnt vmcnt(0)" ::: "memory"); __syncthreads();
            { ge::PY_Sched S{cb, (unsigned char*)ws}; ge::PY_Epi E{ws}; ge::gemm_run(lds, S, E); }
            __syncthreads();
        }
        {
            PHASE_IDS();
            const int nss = BATCH * NG, n_lo = 5, n_hi = (BATCH * NH * 32 - nss * n_lo + (G_ - nss) - 1) / (G_ - nss);
            const int u_beg = cb < nss ? cb * n_lo : nss * n_lo + (cb - nss) * n_hi, u_cnt = cb < nss ? n_lo : n_hi;
            for (int uj = 0; uj < u_cnt; ++uj) { const int ui = u_beg + uj; if (ui >= BATCH * NH * 32) break;
                const int u32i = ui & 31, bh = ui >> 5, head = bh % NH, b = bh / NH, grp = head >> 2, r = grp == 0 ? 1 : (grp == 1 ? 4 : 16), ppr = 32 / r;
                at::dil_unit(lds, ws, (const GAS float*)rel_bias, b, head, r, u32i / ppr, u32i % ppr, tid);
            }
        }
        {
            PHASE_IDS();
            for (int ui = cb; ui < BATCH * MH * 32; ui += G_) at::mem_unit(lds, ws, l, ui >> 7, (ui >> 5) & 3, ui & 31, tid);
        }
        GRID_BAR();
        { PHASE_IDS(); for (int tok = gw; tok < T; tok += ngw) attn_final_tok(Q, lse, ZA, tok, lane); }
        {
            PHASE_IDS();
            ge::PG_Sched S{G_, cb, (unsigned char*)ws, (unsigned char*)ws + OFF_W + (size_t)l * W_STRIDE};
            ge::PG_Epi E{ws, (const GAS float*)(b_glu + l * 768)};
            ge::gemm_run(lds, S, E);
        }
        GRID_BAR();
        {
            PHASE_IDS();
            ge::PM_Sched S{G_, cb, (unsigned char*)ws, (unsigned char*)ws + OFF_W + (size_t)l * W_STRIDE};
            ge::PM_Epi E{ws, (const GAS float*)(b_gate + l * 3072), cb, l};
            ge::gemm_run(lds, S, E);
        }
        GRID_BAR();
        {
            PHASE_IDS();
            ge::PO_Sched S{G_, cb, (unsigned char*)ws, (unsigned char*)ws + OFF_W + (size_t)l * W_STRIDE};
            ge::PO_Epi E{(const GAS float*)(l == 0 ? x_in : xout), (GAS float*)xout, ws, l};
            ge::gemm_run(lds, S, E);
        }
        GRID_BAR();
        if (l + 1 == DEPTH) { PHASE_IDS(); for (int m = gw; m < T; m += ngw) final_norm_row(xout, final_g, m, lane); }
    }
}

extern "C" void kernel_launch(void* const* d_in, const int* in_sizes, int n_in, void* d_out, int out_size, void* d_ws, size_t ws_size, hipStream_t stream) {
    static int grid = 0;
    if (grid == 0) {
        if (n_in != 23 || ws_size < WS_NEED || out_size != T * D_MODEL) { fprintf(stderr, "kernel_launch: unexpected shapes (n_in %d, ws %zu, out %d)\n", n_in, ws_size, out_size); grid = -1; return; }
        int dev = 0, cus = 0, per_cu = 0;
        if (hipGetDevice(&dev) != hipSuccess || hipDeviceGetAttribute(&cus, hipDeviceAttributeMultiprocessorCount, dev) != hipSuccess) { grid = -1; return; }
        if (hipFuncSetAttribute((const void*)mega_fwd, hipFuncAttributeMaxDynamicSharedMemorySize, LDS_BYTES) != hipSuccess) { fprintf(stderr, "kernel_launch: hipFuncSetAttribute failed\n"); grid = -1; return; }
        if (hipOccupancyMaxActiveBlocksPerMultiprocessor(&per_cu, (const void*)mega_fwd, NTHREADS, LDS_BYTES) != hipSuccess || per_cu < 1) { fprintf(stderr, "kernel_launch: occupancy query says %d blocks/CU\n", per_cu); per_cu = 1; }
        (void)hipGetLastError();
        grid = cus * 1;
    }
    if (grid < 0) return;
    (void)hipMemsetAsync(d_ws, 0, CTL_ZERO_BYTES, stream);
    Args a{};
    for (int i = 0; i < 23; ++i) a.in[i] = (const float*)d_in[i];
    a.out = (float*)d_out; a.ws = (unsigned char*)d_ws; a.ph_lo = 0; a.ph_hi = 0;
    hipLaunchKernelGGL(mega_fwd, dim3(grid), dim3(NTHREADS), LDS_BYTES, stream, a);
}
```

```cpp
#include <hip/hip_runtime.h>
#include <cstdint>
#include <cstdio>

typedef unsigned short bf16_t;
typedef short bf16x8 __attribute__((ext_vector_type(8)));
typedef float f32x4 __attribute__((ext_vector_type(4)));
typedef float f32x16 __attribute__((ext_vector_type(16)));
typedef unsigned u32x4 __attribute__((ext_vector_type(4)));
typedef unsigned u32x2 __attribute__((ext_vector_type(2)));

constexpr int D_MODEL = 1024, BATCH = 4, SEQ = 8192, DEPTH = 2, T = BATCH * SEQ;
constexpr int D_SSM = 768, NG = 48, HG = 16, NP = 64;
constexpr int NH = 12, HD = 64, D_ATTN = 768;
constexpr int MEM_LEN = 256, MH = 4, MHD = 128, D_MEM = 512;
constexpr int D_IN = 8704, N_A1 = 5632;
constexpr float EPS = 1e-6f;

constexpr size_t MiB = 1u << 20;
constexpr size_t OFF_RS = 1 * MiB, OFF_RSMEM = 1 * MiB + 256 * 1024, OFF_LSE = 2 * MiB;
constexpr size_t OFF_W = 4 * MiB, W_STRIDE = 27 * MiB;
constexpr size_t WO_IN = 0, WO_GLU = 17 * MiB, WO_B1 = WO_GLU + 1179648, WO_B2 = WO_B1 + 1572864, WO_B3 = WO_B2 + 1572864, WO_OUT = WO_B3 + 1048576, WO_MKV = WO_OUT + 2 * MiB;
static_assert(WO_MKV + 2 * MiB <= W_STRIDE, "weights");
constexpr size_t OFF_KVM = 58 * MiB, OFF_MEMB = 62 * MiB, OFF_XB = 64 * MiB, OFF_U = 128 * MiB, OFF_ZM = 188 * MiB, OFF_ZS = 220 * MiB, OFF_Q = 268 * MiB,
                 OFF_K = 316 * MiB, OFF_V = 364 * MiB, OFF_ZA = 412 * MiB, OFF_QM = 460 * MiB, OFF_TAB = 492 * MiB, WS_NEED = 512 * MiB;
constexpr size_t OFF_Y = OFF_K, OFF_MERGED = OFF_U;

__device__ __forceinline__ unsigned f2bf(float f) { unsigned u = __builtin_bit_cast(unsigned, f); return (u + 0x7fffu + ((u >> 16) & 1u)) >> 16; }
__device__ __forceinline__ unsigned pk2(float lo, float hi) { return f2bf(lo) | (f2bf(hi) << 16); }
__device__ __forceinline__ float bflo(unsigned u) { return __builtin_bit_cast(float, u << 16); }
__device__ __forceinline__ float bfhi(unsigned u) { return __builtin_bit_cast(float, u & 0xffff0000u); }
__device__ __forceinline__ float bf2f(bf16_t h) { return __builtin_bit_cast(float, (unsigned)h << 16); }
__device__ __forceinline__ float sigmoidf_(float x) { return 1.f / (1.f + __expf(-x)); }
__device__ __forceinline__ float siluf_(float x) { return x * sigmoidf_(x); }
__device__ __forceinline__ float gelu_tanh(float y) { return 0.5f * y * (1.f + tanhf(0.7978845608028654f * (y + 0.044715f * y * y * y))); }
__device__ __forceinline__ float wave_sum(float v) {
#pragma unroll
    for (int o = 1; o < 64; o <<= 1) v += __shfl_xor(v, o);
    return v;
}
__device__ __forceinline__ float wave_max(float v) {
#pragma unroll
    for (int o = 1; o < 64; o <<= 1) v = fmaxf(v, __shfl_xor(v, o));
    return v;
}

#define GAS __attribute__((address_space(1)))
#define LAS __attribute__((address_space(3)))
constexpr int NWAVES = 8, NTHREADS = 512;
constexpr int RING_BYTES = 131072, LDS_BYTES = 147456, LDSCTL_OFF = LDS_BYTES - 1024, MISC_OFF = LDSCTL_OFF + 320;
constexpr size_t CTL_ZERO_BYTES = 1 * MiB; constexpr int CW_BAR = 4096;

#define XB_TMO      128
#define XB_XCNT(j)  (256  + 64 * (j))
#define XB_XSUB(j)  (1280 + 64 * (j))
#define XB_XGEN(j)  (2304 + 64 * (j))
#define XB_TOP      3328
#define XB_TOPGEN   3392
#define XCD_BAR_WORDS 3456
#define XB_SPIN_CAP (1u << 18)
__device__ __forceinline__ unsigned xb_ld(unsigned* p)              { return __hip_atomic_load(p, __ATOMIC_RELAXED, __HIP_MEMORY_SCOPE_AGENT); }
__device__ __forceinline__ unsigned xb_add(unsigned* p, unsigned v) { return __hip_atomic_fetch_add(p, v, __ATOMIC_RELAXED, __HIP_MEMORY_SCOPE_AGENT); }
__device__ __forceinline__ unsigned xb_xcc_id() { return (unsigned)__builtin_amdgcn_s_getreg((3 << 11) | 20) & 0xFu; }
#define XB_SPIN(cond, bar) do { unsigned _sp = 0; while (cond) { __builtin_amdgcn_s_sleep(1); \
    if ((++_sp & 255u) == 0u) { if (xb_ld(&(bar)[XB_TMO])) break; if (_sp > XB_SPIN_CAP) { atomicAdd(&(bar)[XB_TMO], 1u); break; } } } } while (0)
struct XcdBarrier { unsigned* bar; unsigned x; volatile LAS unsigned* st; };
__device__ __forceinline__ XcdBarrier xcd_barrier_post(unsigned* bar, volatile LAS unsigned* st) {
    XcdBarrier b; b.bar = bar; b.x = xb_xcc_id(); b.st = st;
    if (threadIdx.x == 0) (void)xb_add(&bar[XB_XCNT(b.x)], 1u);
    return b;
}
__device__ __forceinline__ void xcd_barrier_complete(unsigned* bar, unsigned x, unsigned& nloc, unsigned& nx) {
    const unsigned G = gridDim.x * gridDim.y * gridDim.z;
    unsigned sum, cnt, mine, sp = 0u;
    for (;;) {
        sum = 0u; cnt = 0u; mine = 0u;
#pragma unroll
        for (unsigned j = 0; j < 16; ++j) { const unsigned c = xb_ld(&bar[XB_XCNT(j)]); sum += c; cnt += (c > 0u) ? 1u : 0u; mine = (j == x) ? c : mine; }
        if (sum == G) break;
        __builtin_amdgcn_s_sleep(1);
        if ((++sp & 255u) == 0u) { if (xb_ld(&bar[XB_TMO])) break; if (sp > XB_SPIN_CAP) { atomicAdd(&bar[XB_TMO], 1u); break; } }
    }
    nloc = mine > 0u ? mine : 1u; nx = cnt > 0u ? cnt : 1u;
}
__device__ __forceinline__ void xcd_barrier(const XcdBarrier& b) {
    asm volatile("s_waitcnt vmcnt(0)" ::: "memory");
    __syncthreads();
    if (threadIdx.x == 0) {
        unsigned* bar = b.bar;
        __builtin_amdgcn_s_waitcnt(0);
        unsigned nloc = b.st[0], nx = b.st[1];
        if (nloc == 0u) { xcd_barrier_complete(bar, b.x, nloc, nx); b.st[0] = nloc; b.st[1] = nx; }
        const unsigned old = xb_add(&bar[XB_XSUB(b.x)], 1u);
        const unsigned gen = old / nloc;
        if (old + 1u == (gen + 1u) * nloc) {
            __builtin_amdgcn_fence(__ATOMIC_RELEASE, "agent");
            asm volatile("s_waitcnt vmcnt(0)" ::: "memory");
            const unsigned og = xb_add(&bar[XB_TOP], 1u);
            const unsigned tg = og / nx;
            if (og + 1u == (tg + 1u) * nx) xb_add(&bar[XB_TOPGEN], 1u);
            else XB_SPIN(xb_ld(&bar[XB_TOPGEN]) == tg, bar);
            __builtin_amdgcn_fence(__ATOMIC_ACQUIRE, "agent");
            xb_add(&bar[XB_XGEN(b.x)], 1u);
            asm volatile("s_waitcnt vmcnt(0)" ::: "memory");
        } else {
            XB_SPIN(xb_ld(&bar[XB_XGEN(b.x)]) == gen, bar);
            __builtin_amdgcn_fence(__ATOMIC_ACQUIRE, "agent");
            asm volatile("s_waitcnt vmcnt(0)" ::: "memory");
        }
    }
    __syncthreads();
}

__device__ __forceinline__ void transpose_item(const float* __restrict__ W, int K, int N, bf16_t* __restrict__ WT, int ldt, const float* __restrict__ kscale, LAS float* scr, int item, int lane) {
    const int nblk = N / 32, kb = item / nblk, nb = item % nblk, k0 = 64 * kb, n0 = 32 * nb;
#pragma unroll
    for (int i = 0; i < 32; ++i) { const int kk = 2 * i + (lane >> 5); const float s = kscale ? kscale[k0 + kk] : 1.f; scr[kk * 33 + (lane & 31)] = W[(size_t)(k0 + kk) * N + n0 + (lane & 31)] * s; }
    asm volatile("s_waitcnt lgkmcnt(0)" ::: "memory");
    const int c = lane & 7;
#pragma unroll
    for (int j = 0; j < 4; ++j) { const int n = (lane >> 3) + 8 * j; const LAS float* s = scr + (8 * c) * 33 + n;
        u32x4 o; o.x = pk2(s[0 * 33], s[1 * 33]); o.y = pk2(s[2 * 33], s[3 * 33]); o.z = pk2(s[4 * 33], s[5 * 33]); o.w = pk2(s[6 * 33], s[7 * 33]);
        *(u32x4*)(WT + (size_t)(n0 + n) * ldt + k0 + 8 * c) = o; }
    asm volatile("s_waitcnt lgkmcnt(0)" ::: "memory");
}
__device__ __forceinline__ void rownorm_row(const float* __restrict__ x, bf16_t* __restrict__ xb, float* __restrict__ rs, int row, int lane, float* __restrict__ sq4 = nullptr) {
    const f32x4* xr = (const f32x4*)(x + (size_t)row * 1024) + lane;
    f32x4 v[4]; float s = 0.f;
#pragma unroll
    for (int j = 0; j < 4; ++j) { v[j] = xr[64 * j]; s += (v[j].x * v[j].x + v[j].y * v[j].y) + (v[j].z * v[j].z + v[j].w * v[j].w); }
    s = wave_sum(s);
    u32x2* o = (u32x2*)(xb + (size_t)row * 1024) + lane;
#pragma unroll
    for (int j = 0; j < 4; ++j) o[64 * j] = (u32x2){pk2(v[j].x, v[j].y), pk2(v[j].z, v[j].w)};
    if (lane == 0) { rs[row] = 1.0f / sqrtf(s * (1.f / 1024.f) + EPS); if (sq4) *(f32x4*)(sq4 + (size_t)row * 4) = (f32x4){s, 0.f, 0.f, 0.f}; }
}
__device__ __forceinline__ void rownorm_row2(const float* __restrict__ x, bf16_t* __restrict__ xb, float* __restrict__ rs, int row, int lane, float* __restrict__ sq4) {
    const f32x4* xr = (const f32x4*)(x + (size_t)row * 1024) + lane;
    f32x4 v[8]; float s0 = 0.f, s1 = 0.f;
#pragma unroll
    for (int j = 0; j < 8; ++j) v[j] = xr[64 * j];
#pragma unroll
    for (int j = 0; j < 4; ++j) { s0 += (v[j].x * v[j].x + v[j].y * v[j].y) + (v[j].z * v[j].z + v[j].w * v[j].w); s1 += (v[4 + j].x * v[4 + j].x + v[4 + j].y * v[4 + j].y) + (v[4 + j].z * v[4 + j].z + v[4 + j].w * v[4 + j].w); }
#pragma unroll
    for (int o = 1; o < 64; o <<= 1) { s0 += __shfl_xor(s0, o); s1 += __shfl_xor(s1, o); }
    u32x2* ob = (u32x2*)(xb + (size_t)row * 1024) + lane;
#pragma unroll
    for (int j = 0; j < 8; ++j) ob[64 * j] = (u32x2){pk2(v[j].x, v[j].y), pk2(v[j].z, v[j].w)};
    if (lane == 0) { rs[row] = 1.0f / sqrtf(s0 * (1.f / 1024.f) + EPS); rs[row + 1] = 1.0f / sqrtf(s1 * (1.f / 1024.f) + EPS);
        *(f32x4*)(sq4 + (size_t)row * 4) = (f32x4){s0, 0.f, 0.f, 0.f}; *(f32x4*)(sq4 + (size_t)row * 4 + 4) = (f32x4){s1, 0.f, 0.f, 0.f}; }
}
__device__ __forceinline__ void final_norm_row(float* __restrict__ x, const float* __restrict__ g, int row, int lane) {
    f32x4* xr = (f32x4*)(x + (size_t)row * 1024) + lane; const f32x4* gr = (const f32x4*)g + lane;
    f32x4 v[4]; float s = 0.f;
#pragma unroll
    for (int j = 0; j < 4; ++j) { v[j] = xr[64 * j]; s += (v[j].x * v[j].x + v[j].y * v[j].y) + (v[j].z * v[j].z + v[j].w * v[j].w); }
    s = wave_sum(s); const float r = 1.0f / sqrtf(s * (1.f / 1024.f) + EPS);
#pragma unroll
    for (int j = 0; j < 4; ++j) xr[64 * j] = v[j] * r * gr[64 * j];
}

struct EpiA1 {
    const float* rs; bf16_t *U, *ZS, *Q, *Kb, *V, *ZA, *QM, *ZM;
    __device__ __forceinline__ void operator()(int m, int n, f32x4 v) const {
        v = v * rs[m]; bf16_t* dst; bool silu = false; float sc = 1.f;
        if (n < 768) dst = U + (size_t)m * 768 + n;
        else if (n < 1536) { dst = ZS + (size_t)m * 768 + (n - 768); silu = true; }
        else if (n < 2304) { dst = Q + (size_t)m * 768 + (n - 1536); sc = 0.125f; }
        else if (n < 3072) dst = Kb + (size_t)m * 768 + (n - 2304);
        else if (n < 3840) dst = V + (size_t)m * 768 + (n - 3072);
        else if (n < 4608) { dst = ZA + (size_t)m * 768 + (n - 3840); silu = true; }
        else if (n < 5120) { dst = QM + (size_t)m * 512 + (n - 4608); sc = 0.08838834764831845f; }
        else { dst = ZM + (size_t)m * 512 + (n - 5120); silu = true; }
        if (silu) { v.x = siluf_(v.x); v.y = siluf_(v.y); v.z = siluf_(v.z); v.w = siluf_(v.w); }
        v = v * sc;
        *(u32x2*)dst = (u32x2){pk2(v.x, v.y), pk2(v.z, v.w)};
    }
};
struct EpiKvm {
    const float* rs; bf16_t* O;
    __device__ __forceinline__ void operator()(int m, int n, f32x4 v) const { v = v * rs[m]; *(u32x2*)(O + (size_t)m * 1024 + n) = (u32x2){pk2(v.x, v.y), pk2(v.z, v.w)}; }
};
struct EpiGlu {
    const bf16_t* Y; bf16_t* ZS; const float* b;
    __device__ __forceinline__ void operator()(int m, int n, f32x4 v) const {
        const u32x2 y = *(const u32x2*)(Y + (size_t)m * 768 + n); u32x2* zp = (u32x2*)(ZS + (size_t)m * 768 + n); const u32x2 z = *zp; const f32x4 bb = *(const f32x4*)(b + n);
        const float o0 = bflo(y.x) * sigmoidf_(v.x + bb.x) * bflo(z.x), o1 = bfhi(y.x) * sigmoidf_(v.y + bb.y) * bfhi(z.x);
        const float o2 = bflo(y.y) * sigmoidf_(v.z + bb.z) * bflo(z.y), o3 = bfhi(y.y) * sigmoidf_(v.w + bb.w) * bfhi(z.y);
        *zp = (u32x2){pk2(o0, o1), pk2(o2, o3)};
    }
};
struct EpiOut {
    const float* xold; float* xnew;
    __device__ __forceinline__ void operator()(int m, int n, f32x4 v) const { const size_t o = (size_t)m * 1024 + n; *(f32x4*)(xnew + o) = *(const f32x4*)(xold + o) + v; }
};
template <class Epi>
__device__ __forceinline__ void wgemm(const bf16_t* __restrict__ A, int lda, const bf16_t* __restrict__ Bt, int ldb, int M, int N, int K, const Epi& epi, int gw, int ngw, int lane) {
    const int r = lane & 31, hi = lane >> 5; const int ntn = N / 64, ntiles = (M / 64) * ntn;
    for (int tile = gw; tile < ntiles; tile += ngw) {
        const int m0 = (tile / ntn) * 64, n0 = (tile % ntn) * 64;
        f32x16 acc[2][2];
#pragma unroll
        for (int i = 0; i < 2; ++i)
#pragma unroll
            for (int j = 0; j < 2; ++j)
#pragma unroll
                for (int q = 0; q < 16; ++q) acc[i][j][q] = 0.f;
        const bf16_t* ap = A + (size_t)(m0 + r) * lda + 8 * hi;
        const bf16_t* bp = Bt + (size_t)(n0 + r) * ldb + 8 * hi;
        for (int k = 0; k < K; k += 16) {
            const bf16x8 a0 = *(const bf16x8*)(ap + k), a1 = *(const bf16x8*)(ap + (size_t)32 * lda + k);
            const bf16x8 b0 = *(const bf16x8*)(bp + k), b1 = *(const bf16x8*)(bp + (size_t)32 * ldb + k);
            acc[0][0] = __builtin_amdgcn_mfma_f32_32x32x16_bf16(b0, a0, acc[0][0], 0, 0, 0);
            acc[0][1] = __builtin_amdgcn_mfma_f32_32x32x16_bf16(b1, a0, acc[0][1], 0, 0, 0);
            acc[1][0] = __builtin_amdgcn_mfma_f32_32x32x16_bf16(b0, a1, acc[1][0], 0, 0, 0);
            acc[1][1] = __builtin_amdgcn_mfma_f32_32x32x16_bf16(b1, a1, acc[1][1], 0, 0, 0);
        }
#pragma unroll
        for (int mi = 0; mi < 2; ++mi)
#pragma unroll
            for (int ni = 0; ni < 2; ++ni)
#pragma unroll
                for (int q = 0; q < 4; ++q)
                    epi(m0 + 32 * mi + r, n0 + 32 * ni + 8 * q + 4 * hi, (f32x4){acc[mi][ni][4 * q], acc[mi][ni][4 * q + 1], acc[mi][ni][4 * q + 2], acc[mi][ni][4 * q + 3]});
    }
}
__device__ __forceinline__ void merge_ref(const bf16_t* __restrict__ XB, const float* __restrict__ rs, const bf16_t* __restrict__ WinT, const float* __restrict__ bg,
                                          const bf16_t* __restrict__ OS, const bf16_t* __restrict__ OA, const bf16_t* __restrict__ OM,
                                          const bf16_t* __restrict__ W1, const bf16_t* __restrict__ W2, const bf16_t* __restrict__ W3, bf16_t* __restrict__ MG, int gw, int ngw, int lane) {
    const int r = lane & 31, hi = lane >> 5;
    for (int tile = gw; tile < (T / 32) * 32; tile += ngw) {
        const int m0 = (tile >> 5) * 32, n0 = (tile & 31) * 32;
        f32x16 L0, L1, L2, P0, P1, P2;
#pragma unroll
        for (int q = 0; q < 16; ++q) { L0[q] = 0.f; L1[q] = 0.f; L2[q] = 0.f; P0[q] = 0.f; P1[q] = 0.f; P2[q] = 0.f; }
        {
            const bf16_t* ap = XB + (size_t)(m0 + r) * 1024 + 8 * hi; const bf16_t* bp = WinT + (size_t)(N_A1 + n0 + r) * 1024 + 8 * hi;
            for (int k = 0; k < 1024; k += 16) {
                const bf16x8 a = *(const bf16x8*)(ap + k);
                L0 = __builtin_amdgcn_mfma_f32_32x32x16_bf16(*(const bf16x8*)(bp + k), a, L0, 0, 0, 0);
                L1 = __builtin_amdgcn_mfma_f32_32x32x16_bf16(*(const bf16x8*)(bp + (size_t)1024 * 1024 + k), a, L1, 0, 0, 0);
                L2 = __builtin_amdgcn_mfma_f32_32x32x16_bf16(*(const bf16x8*)(bp + (size_t)2048 * 1024 + k), a, L2, 0, 0, 0);
            }
        }
        {
            const bf16_t* ap = OS + (size_t)(m0 + r) * 768 + 8 * hi; const bf16_t* bp = W1 + (size_t)(n0 + r) * 768 + 8 * hi;
            for (int k = 0; k < 768; k += 16) P0 = __builtin_amdgcn_mfma_f32_32x32x16_bf16(*(const bf16x8*)(bp + k), *(const bf16x8*)(ap + k), P0, 0, 0, 0);
        }
        {
            const bf16_t* ap = OA + (size_t)(m0 + r) * 768 + 8 * hi; const bf16_t* bp = W2 + (size_t)(n0 + r) * 768 + 8 * hi;
            for (int k = 0; k < 768; k += 16) P1 = __builtin_amdgcn_mfma_f32_32x32x16_bf16(*(const bf16x8*)(bp + k), *(const bf16x8*)(ap + k), P1, 0, 0, 0);
        }
        {
            const bf16_t* ap = OM + (size_t)(m0 + r) * 512 + 8 * hi; const bf16_t* bp = W3 + (size_t)(n0 + r) * 512 + 8 * hi;
            for (int k = 0; k < 512; k += 16) P2 = __builtin_amdgcn_mfma_f32_32x32x16_bf16(*(const bf16x8*)(bp + k), *(const bf16x8*)(ap + k), P2, 0, 0, 0);
        }
        const int m = m0 + r; const float rsm = rs[m];
#pragma unroll
        for (int q = 0; q < 4; ++q) {
            const int n = n0 + 8 * q + 4 * hi; float o[4];
#pragma unroll
            for (int e = 0; e < 4; ++e) {
                const int rg = 4 * q + e;
                const float g0 = sigmoidf_(rsm * L0[rg] + bg[n + e]), g1 = sigmoidf_(rsm * L1[rg] + bg[1024 + n + e]), g2 = sigmoidf_(rsm * L2[rg] + bg[2048 + n + e]);
                o[e] = g0 * P0[rg] + g1 * P1[rg] + g2 * P2[rg];
            }
            *(u32x2*)(MG + (size_t)m * 1024 + n) = (u32x2){pk2(o[0], o[1]), pk2(o[2], o[3])};
        }
    }
}

__device__ __forceinline__ void ssm_ref(int b, int g, int lane, LAS float* xs, const bf16_t* __restrict__ U, bf16_t* __restrict__ Y, const float* __restrict__ lam_re, const float* __restrict__ lam_im,
                                        const float* __restrict__ log_dt, const float* __restrict__ b_re, const float* __restrict__ b_im,
                                        const float* __restrict__ c_re, const float* __restrict__ c_im, const float* __restrict__ dvec) {
    const float dt = expf(log_dt[g]); const float lre = lam_re[g * 64 + lane], lim = lam_im[g * 64 + lane];
    const float mag = expf(lre * dt); const float ar = mag * cosf(lim * dt), ai = mag * sinf(lim * dt);
    const float den = lre * lre + lim * lim, nr = ar - 1.0f, ni = ai;
    const float fr = (nr * lre + ni * lim) / den, fi = (ni * lre - nr * lim) / den;
    float bbr[16], bbi[16];
#pragma unroll
    for (int h = 0; h < 16; ++h) { const float br = b_re[(g * 64 + lane) * 16 + h], bi = b_im[(g * 64 + lane) * 16 + h]; bbr[h] = fr * br - fi * bi; bbi[h] = fr * bi + fi * br; }
    const int hq = lane & 15, part = lane >> 4;
    float cr[16], ci[16];
#pragma unroll
    for (int i = 0; i < 16; ++i) { cr[i] = c_re[(g * 16 + hq) * 64 + part * 16 + i]; ci[i] = c_im[(g * 16 + hq) * 64 + part * 16 + i]; }
    const float dd = dvec[g * 16 + hq];
    float xr = 0.f, xi = 0.f;
    const bf16_t* up = U + (size_t)b * SEQ * 768 + g * 16; bf16_t* yp = Y + (size_t)b * SEQ * 768 + g * 16;
    for (int t = 0; t < SEQ; ++t) {
        const u32x4 ua = *(const u32x4*)(up + (size_t)t * 768), ub = *(const u32x4*)(up + (size_t)t * 768 + 8);
        const float uh = bf2f(up[(size_t)t * 768 + hq]);
        float u[16];
        u[0] = bflo(ua.x); u[1] = bfhi(ua.x); u[2] = bflo(ua.y); u[3] = bfhi(ua.y); u[4] = bflo(ua.z); u[5] = bfhi(ua.z); u[6] = bflo(ua.w); u[7] = bfhi(ua.w);
        u[8] = bflo(ub.x); u[9] = bfhi(ub.x); u[10] = bflo(ub.y); u[11] = bfhi(ub.y); u[12] = bflo(ub.z); u[13] = bfhi(ub.z); u[14] = bflo(ub.w); u[15] = bfhi(ub.w);
        float bur = 0.f, bui = 0.f;
#pragma unroll
        for (int h = 0; h < 16; ++h) { bur += bbr[h] * u[h]; bui += bbi[h] * u[h]; }
        const float nxr = ar * xr - ai * xi + bur, nxi = ar * xi + ai * xr + bui; xr = nxr; xi = nxi;
        xs[lane] = xr; xs[64 + lane] = xi;
        asm volatile("s_waitcnt lgkmcnt(0)" ::: "memory");
        float acc = 0.f;
#pragma unroll
        for (int i = 0; i < 16; ++i) acc += cr[i] * xs[part * 16 + i] - ci[i] * xs[64 + part * 16 + i];
        acc += __shfl_xor(acc, 16); acc += __shfl_xor(acc, 32);
        asm volatile("s_waitcnt lgkmcnt(0)" ::: "memory");
        if (lane < 16) yp[(size_t)t * 768 + lane] = (bf16_t)f2bf(gelu_tanh(acc + dd * uh));
    }
}

__device__ __forceinline__ int rel_bucket(int n) {
    if (n < 16) return n;
    const float v = logf((float)n / 16.0f) / 4.852030263919617f * 16.0f;
    const int lg = 16 + (int)v; return lg < 31 ? lg : 31;
}
__device__ __forceinline__ float dot8(const u32x4 a, const u32x4 b) {
    return bflo(a.x) * bflo(b.x) + bfhi(a.x) * bfhi(b.x) + bflo(a.y) * bflo(b.y) + bfhi(a.y) * bfhi(b.y) + bflo(a.z) * bflo(b.z) + bfhi(a.z) * bfhi(b.z) + bflo(a.w) * bflo(b.w) + bfhi(a.w) * bfhi(b.w);
}
__device__ __forceinline__ void attn_ref(bf16_t* Q, const bf16_t* __restrict__ Kb, const bf16_t* __restrict__ V, const float* __restrict__ rel_bias, float* __restrict__ lse, int gw, int ngw, int lane) {
    for (int item = gw; item < T * NH; item += ngw) {
        const int head = item % NH, tok = item / NH, t = tok % SEQ, row0 = tok - t;
        const int grp = head >> 2, r = grp == 0 ? 1 : (grp == 1 ? 4 : 16);
        bf16_t* qp = Q + (size_t)tok * 768 + head * 64;
        u32x4 qv[8];
#pragma unroll
        for (int i = 0; i < 8; ++i) qv[i] = ((const u32x4*)qp)[i];
        float s[3]; bool ok[3];
#pragma unroll
        for (int sl = 0; sl < 3; ++sl) {
            const int j = sl * 64 + lane, p = t - j * r; ok[sl] = (j <= 128) && (p >= 0); s[sl] = -1e30f;
            if (ok[sl]) {
                const u32x4* kp = (const u32x4*)(Kb + (size_t)(row0 + p) * 768 + head * 64); float d = 0.f;
#pragma unroll
                for (int i = 0; i < 8; ++i) d += dot8(qv[i], kp[i]);
                s[sl] = d + rel_bias[rel_bucket(j * r) * NH + head];
            }
        }
        const float m = wave_max(fmaxf(fmaxf(s[0], s[1]), s[2]));
        float e[3];
#pragma unroll
        for (int sl = 0; sl < 3; ++sl) e[sl] = ok[sl] ? __expf(s[sl] - m) : 0.f;
        const float l = wave_sum(e[0] + e[1] + e[2]);
        float o = 0.f;
#pragma unroll
        for (int sl = 0; sl < 3; ++sl) {
            for (int jj = 0; jj < 64; ++jj) {
                const int j = sl * 64 + jj, p = t - j * r; if (j > 128 || p < 0) break;
                const float pj = __shfl(e[sl], jj);
                o += pj * bf2f(V[(size_t)(row0 + p) * 768 + head * 64 + lane]);
            }
        }
        qp[lane] = (bf16_t)f2bf(o / l);
        if (lane == 0) lse[(size_t)tok * NH + head] = m + logf(l);
    }
}
__device__ __forceinline__ void attn_final_pair(bf16_t* __restrict__ Q, const float* __restrict__ lse, const bf16_t* __restrict__ ZA, int tok0, int lane) {
    u32x4 o[3], z[3]; float l0[3], l1[3], l2[3]; int off[3], hd[3];
#pragma unroll
    for (int j = 0; j < 3; ++j) { const int ci = lane + 64 * j, tl = ci >= 96 ? 1 : 0, c8 = (ci - 96 * tl) * 8; hd[j] = c8 >> 6; off[j] = (tok0 + tl) * 768 + c8;
        o[j] = *(const u32x4*)(Q + off[j]); z[j] = *(const u32x4*)(ZA + off[j]); const float* lp = lse + (size_t)(tok0 + tl) * NH + (hd[j] & 3); l0[j] = lp[0]; l1[j] = lp[4]; l2[j] = lp[8]; }
#pragma unroll
    for (int j = 0; j < 3; ++j) {
        const float mx = fmaxf(fmaxf(l0[j], l1[j]), l2[j]); const float e0 = __expf(l0[j] - mx), e1 = __expf(l1[j] - mx), e2 = __expf(l2[j] - mx);
        const float mine = hd[j] < 4 ? e0 : (hd[j] < 8 ? e1 : e2); const float al = mine / (e0 + e1 + e2);
        *(u32x4*)(Q + off[j]) = (u32x4){pk2(bflo(o[j].x) * al * bflo(z[j].x), bfhi(o[j].x) * al * bfhi(z[j].x)), pk2(bflo(o[j].y) * al * bflo(z[j].y), bfhi(o[j].y) * al * bfhi(z[j].y)),
                                        pk2(bflo(o[j].z) * al * bflo(z[j].z), bfhi(o[j].z) * al * bfhi(z[j].z)), pk2(bflo(o[j].w) * al * bflo(z[j].w), bfhi(o[j].w) * al * bfhi(z[j].w))};
    }
}
__device__ __forceinline__ void memattn_ref(bf16_t* QM, const bf16_t* __restrict__ KVM, const bf16_t* __restrict__ ZM, int gw, int ngw, int lane) {
    for (int item = gw; item < T * MH; item += ngw) {
        const int head = item & 3, tok = item >> 2, b = tok / SEQ;
        bf16_t* qp = QM + (size_t)tok * 512 + head * 128;
        u32x4 qv[16];
#pragma unroll
        for (int i = 0; i < 16; ++i) qv[i] = ((const u32x4*)qp)[i];
        float s[4];
#pragma unroll
        for (int sl = 0; sl < 4; ++sl) {
            const int j = sl * 64 + lane; const u32x4* kp = (const u32x4*)(KVM + (size_t)(b * 256 + j) * 1024 + head * 128); float d = 0.f;
#pragma unroll
            for (int i = 0; i < 16; ++i) d += dot8(qv[i], kp[i]);
            s[sl] = d;
        }
        const float m = wave_max(fmaxf(fmaxf(s[0], s[1]), fmaxf(s[2], s[3])));
        float e[4];
#pragma unroll
        for (int sl = 0; sl < 4; ++sl) e[sl] = __expf(s[sl] - m);
        const float l = wave_sum((e[0] + e[1]) + (e[2] + e[3]));
        float o0 = 0.f, o1 = 0.f;
#pragma unroll
        for (int sl = 0; sl < 4; ++sl)
            for (int jj = 0; jj < 64; ++jj) {
                const int j = sl * 64 + jj; const float pj = __shfl(e[sl], jj);
                const bf16_t* vp = KVM + (size_t)(b * 256 + j) * 1024 + 512 + head * 128;
                o0 += pj * bf2f(vp[lane]); o1 += pj * bf2f(vp[64 + lane]);
            }
        const bf16_t* zp = ZM + (size_t)tok * 512 + head * 128;
        qp[lane] = (bf16_t)f2bf(o0 / l * bf2f(zp[lane])); qp[64 + lane] = (bf16_t)f2bf(o1 / l * bf2f(zp[64 + lane]));
    }
}

constexpr size_t OFF_ROWSQ = 3 * MiB + 512 * 1024;
constexpr size_t TAB_TOEP = 0, TAB_CST = 2 * MiB, TAB_WST = 8 * MiB, TAB_AQ = 15 * MiB;
__device__ __forceinline__ int fresh_tid() { int t = threadIdx.x; asm volatile("" : "+v"(t)); return t; }
__device__ __forceinline__ unsigned char* fresh_ptr(unsigned char* p) { asm volatile("" : "+s"(p)); return (unsigned char*)(GAS unsigned char*)p; }
__device__ __forceinline__ int fresh_bid() { int b = blockIdx.x; asm volatile("" : "+s"(b)); return b; }
__device__ __forceinline__ float load_rs(GAS unsigned char* ws, int, int tr) {
    const f32x4 p = ((const GAS f32x4*)(ws + OFF_ROWSQ))[tr]; return __builtin_amdgcn_rsqf(((p.x + p.y) + (p.z + p.w)) * (1.f / 1024.f) + EPS);
}
__device__ __forceinline__ void load_rs8(GAS unsigned char* ws, int row0, int wr, int fr, float (&r8)[8]) {
    f32x4 p[8];
#pragma unroll
    for (int i = 0; i < 8; ++i) p[i] = ((const GAS f32x4*)(ws + OFF_ROWSQ))[row0 + (i >> 2) * 128 + wr * 64 + (i & 3) * 16 + fr];
#pragma unroll
    for (int i = 0; i < 8; ++i) r8[i] = __builtin_amdgcn_rsqf(((p[i].x + p[i].y) + (p[i].z + p[i].w)) * (1.f / 1024.f) + EPS);
}
namespace ge {
constexpr int BM = 256, BK = 64, HALF = 128, HTB = HALF * BK * 2, STAGE_BYTES = 8 * HTB;
__device__ __forceinline__ int lds_byte(int r, int c) { const int st = (r >> 4) * 2 + (c >> 5), rr = r & 15, cc = c & 31, ob = rr * 64 + cc * 2; return st * 1024 + (ob ^ (((ob >> 9) & 1) << 5)); }
__device__ __forceinline__ void stage_rc(int b, int& R, int& C) { const int st = b / 1024, sb = b % 1024, swz = sb ^ (((sb >> 9) & 1) << 5); R = (st >> 1) * 16 + swz / 64; C = (st & 1) * 32 + (swz % 64) / 2; }
__device__ __forceinline__ int perm32(int rho) { const int n = rho >> 4, i = rho & 15; return 8 * (i >> 2) + 4 * n + (i & 3); }
enum { A_STD = 0, A_GM = 1 };
enum { B_STD = 0, B_PERM = 1, B_TOEP = 2 };
struct Seg { const char* A; const char* B; int a_h, b_h, a_k, b_k, npairs, amode, bmode; unsigned lda2, ldb2; };
struct Unit { int type, pm, pn, g; };
typedef f32x4 Acc[2][2][4][2];

template <class Sched, class Epi>
__device__ __forceinline__ void gemm_run(LAS unsigned char* lds, const Sched& S, const Epi& E) {
    const int tid = fresh_tid(), wid = __builtin_amdgcn_readfirstlane(tid >> 6), lane = tid & 63, wr = wid >> 2, wc = wid & 3, fr = lane & 15, fq = lane >> 4;
    const unsigned ldsw = (unsigned)wid * 1024u;
    const int aoff = lds_byte(wr * 64 + fr, fq * 8), boff = lds_byte(wc * 32 + fr, fq * 8);
#define GE_SA(b, h) (((b) * 2 + (h)) * HTB)
#define GE_SB(b, h) ((4 + (b) * 2 + (h)) * HTB)
#define GE_STAGE(bufoff, gbase, voff) do { _Pragma("unroll") for (int _i = 0; _i < 2; ++_i) \
        __builtin_amdgcn_global_load_lds((const unsigned*)((const char*)(gbase) + (voff)[_i]), (LAS unsigned*)(lds + (bufoff) + ldsw + _i * 8192), 16, 0, 0); } while (0)
#define GE_LDA(dst, b, h) do { _Pragma("unroll") for (int m = 0; m < 4; ++m) _Pragma("unroll") for (int k = 0; k < 2; ++k) dst[m][k] = *(const LAS bf16x8*)(lds + GE_SA(b, h) + aoff + m * 2048 + k * 1024); } while (0)
#define GE_LDB(dst, b, h) do { _Pragma("unroll") for (int n = 0; n < 2; ++n) _Pragma("unroll") for (int k = 0; k < 2; ++k) dst[n][k] = *(const LAS bf16x8*)(lds + GE_SB(b, h) + boff + n * 2048 + k * 1024); } while (0)
#define GE_MMA(ai, bj, At, Bt) do { __builtin_amdgcn_s_setprio(1); _Pragma("unroll") for (int m = 0; m < 4; ++m) _Pragma("unroll") for (int n = 0; n < 2; ++n) _Pragma("unroll") for (int k = 0; k < 2; ++k) \
        acc[ai][bj][m][n] = __builtin_amdgcn_mfma_f32_16x16x32_bf16(Bt[n][k], At[m][k], acc[ai][bj][m][n], 0, 0, 0); __builtin_amdgcn_s_setprio(0); } while (0)
#define GE_WAIT_V(n) asm volatile("s_waitcnt vmcnt(" #n ")" ::: "memory")
#define GE_WAIT_L(n) asm volatile("s_waitcnt lgkmcnt(" #n ")" ::: "memory")
#define GE_BAR __builtin_amdgcn_s_barrier()
#define GE_SCHED __builtin_amdgcn_sched_barrier(0)
#define GE_VOFFS(sg, va, vb) do { _Pragma("unroll") for (int _i = 0; _i < 2; ++_i) { int R_, C_; stage_rc(tid * 16 + _i * 8192, R_, C_); const int Rp_ = (R_ & ~31) + perm32(R_ & 31); \
        va[_i] = (sg).amode == A_GM ? (unsigned)((R_ >> 5) * 1280 + (R_ & 31) * 32 + (C_ >> 4) * (1024 * 1280) + (C_ & 15) * 2) : (unsigned)R_ * (sg).lda2 + (unsigned)(C_ * 2); \
        vb[_i] = (sg).bmode == B_TOEP ? (unsigned)((((Rp_ >> 4) - (C_ >> 4) + 3) * 256 + (Rp_ & 15) * 16 + (C_ & 15)) * 2) : (unsigned)((sg).bmode == B_PERM ? Rp_ : R_) * (sg).ldb2 + (unsigned)(C_ * 2); } } while (0)
    Unit nu; int nui = 0;
    if (!S.unit(0, nu)) return;
    Seg ns; int nsi = 0, npi = 0; S.seg(nu, 0, ns);
    const char* npa = ns.A; const char* npb = ns.B; unsigned nva[2], nvb[2]; GE_VOFFS(ns, nva, nvb);
    bool nreal = true;
    Unit cu; int csi; bool c_lastseg, c_lastunit; const char* c_a1h; unsigned cva[2];
#define GE_ADVANCE() do { ++npi; if (npi < ns.npairs) { npa += 2 * ns.a_k; npb += 2 * ns.b_k; } else { npi = 0; ++nsi; \
        if (nsi >= S.nseg(nu)) { nsi = 0; Unit tu; if (S.unit(nui + 1, tu)) { ++nui; nu = tu; } else nreal = false; } \
        S.seg(nu, nsi, ns); npa = ns.A; npb = ns.B; GE_VOFFS(ns, nva, nvb); } } while (0)
#define GE_SHIFT() do { cu = nu; csi = nsi; c_lastseg = (npi == ns.npairs - 1); c_lastunit = c_lastseg && (nsi == S.nseg(nu) - 1); \
        c_a1h = npa + ns.a_k + ns.a_h; cva[0] = nva[0]; cva[1] = nva[1]; GE_ADVANCE(); } while (0)
    Acc acc;
#pragma unroll
    for (int a = 0; a < 2; ++a)
#pragma unroll
        for (int b = 0; b < 2; ++b)
#pragma unroll
            for (int m = 0; m < 4; ++m)
#pragma unroll
                for (int n = 0; n < 2; ++n) acc[a][b][m][n] = (f32x4){0.f, 0.f, 0.f, 0.f};
    bf16x8 At[4][2], B0[2][2], B1[2][2];
    GE_STAGE(GE_SB(0, 0), npb, nvb); GE_STAGE(GE_SB(0, 1), npb + ns.b_h, nvb); GE_STAGE(GE_SA(0, 0), npa, nva); GE_STAGE(GE_SA(0, 1), npa + ns.a_h, nva);
    if (wr == 1) GE_BAR;
    GE_WAIT_V(2); GE_BAR;
    GE_STAGE(GE_SB(1, 0), npb + ns.b_k, nvb); GE_STAGE(GE_SA(1, 0), npa + ns.a_k, nva); GE_STAGE(GE_SB(1, 1), npb + ns.b_k + ns.b_h, nvb);
    GE_WAIT_V(6); GE_BAR;
    GE_SHIFT();
    for (;;) {
        GE_LDB(B0, 0, 0); GE_LDB(B1, 0, 1); GE_SCHED; GE_LDA(At, 0, 0); GE_STAGE(GE_SA(1, 1), c_a1h, cva);
        GE_WAIT_V(8); GE_WAIT_L(0); GE_BAR; GE_MMA(0, 0, At, B0); GE_MMA(0, 1, At, B1); GE_BAR; GE_SCHED;
        GE_LDA(At, 0, 1); GE_STAGE(GE_SB(0, 0), npb, nvb); GE_STAGE(GE_SB(0, 1), npb + ns.b_h, nvb); GE_STAGE(GE_SA(0, 0), npa, nva);
        GE_WAIT_V(8); GE_WAIT_L(0); GE_BAR; GE_MMA(1, 0, At, B0); GE_MMA(1, 1, At, B1); GE_BAR; GE_SCHED;
        GE_LDB(B0, 1, 0); GE_LDB(B1, 1, 1); GE_SCHED; GE_LDA(At, 1, 0); GE_STAGE(GE_SA(0, 1), npa + ns.a_h, nva);
        GE_WAIT_V(8); GE_WAIT_L(0); GE_BAR; GE_MMA(0, 0, At, B0); GE_MMA(0, 1, At, B1); GE_BAR; GE_SCHED;
        GE_LDA(At, 1, 1); GE_STAGE(GE_SB(1, 0), npb + ns.b_k, nvb); GE_STAGE(GE_SB(1, 1), npb + ns.b_k + ns.b_h, nvb); GE_STAGE(GE_SA(1, 0), npa + ns.a_k, nva);
        GE_WAIT_V(8); GE_WAIT_L(0); GE_BAR; GE_MMA(1, 0, At, B0); GE_MMA(1, 1, At, B1); GE_BAR; GE_SCHED;
        if (c_lastunit) {
            if (wr == 0) GE_BAR;
            { int fr_ = fr, fq_ = fq; asm volatile("" : "+v"(fr_), "+v"(fq_)); E.finish(acc, cu, wr, wc, fr_, fq_); }
            if (!nreal) break;
#pragma unroll
            for (int a = 0; a < 2; ++a)
#pragma unroll
                for (int b = 0; b < 2; ++b)
#pragma unroll
                    for (int m = 0; m < 4; ++m)
#pragma unroll
                        for (int n = 0; n < 2; ++n) acc[a][b][m][n] = (f32x4){0.f, 0.f, 0.f, 0.f};
            if (wr == 1) GE_BAR;
        } else if (c_lastseg) {
            { int fr_ = fr, fq_ = fq; asm volatile("" : "+v"(fr_), "+v"(fq_)); E.seg_end(acc, cu, csi, wr, wc, fr_, fq_); }
        }
        GE_SHIFT();
    }
    GE_WAIT_V(0);
    GE_BAR;
    { int fr_ = fr, fq_ = fq; asm volatile("" : "+v"(fr_), "+v"(fq_)); E.after_drain(acc, cu, lds, wr, wc, fr_, fq_); }
#undef GE_SA
#undef GE_SB
#undef GE_STAGE
#undef GE_LDA
#undef GE_LDB
#undef GE_MMA
#undef GE_WAIT_V
#undef GE_WAIT_L
#undef GE_BAR
#undef GE_SCHED
#undef GE_VOFFS
#undef GE_ADVANCE
#undef GE_SHIFT
}
__device__ __forceinline__ bool static_tile(int i, int G, int c, int nM, int nN, int& pm, int& pn) {
    const int nwg = nM * nN; const long L = (long)i * G + c; if (L >= nwg) return false;
    int wgid = (int)L; { const int q = nwg / 8, r = nwg % 8, xcd = wgid % 8, off = wgid / 8; wgid = (xcd < r ? xcd * (q + 1) : r * (q + 1) + (xcd - r) * q) + off; }
    const int nig = 8 * nN, gid = wgid / nig, fm = gid * 8, gsz = (nM - fm) < 8 ? (nM - fm) : 8;
    pm = fm + ((wgid % nig) % gsz); pn = (wgid % nig) / gsz; return true;
}
__device__ __forceinline__ unsigned cvt_pk_bf16(float lo, float hi) { unsigned r; asm volatile("v_cvt_pk_bf16_f32 %0, %1, %2" : "=v"(r) : "v"(lo), "v"(hi)); return r; }
__device__ __forceinline__ u32x4 pack8(const f32x4 a, const f32x4 b) { u32x4 w; w.x = cvt_pk_bf16(a[0], a[1]); w.y = cvt_pk_bf16(a[2], a[3]); w.z = cvt_pk_bf16(b[0], b[1]); w.w = cvt_pk_bf16(b[2], b[3]); return w; }
__device__ __forceinline__ void unpack8(const u32x4 w, f32x4& a, f32x4& b) { a = (f32x4){bflo(w.x), bfhi(w.x), bflo(w.y), bfhi(w.y)}; b = (f32x4){bflo(w.z), bfhi(w.z), bflo(w.w), bfhi(w.w)}; }
__device__ __forceinline__ float fsigm(float x) { return __builtin_amdgcn_rcpf(1.f + __builtin_amdgcn_exp2f(-1.4426950408889634f * x)); }
__device__ __forceinline__ float fgelu(float y) { return y * fsigm(1.5957691216057308f * (y + 0.044715f * y * y * y)); }
__device__ __forceinline__ f32x4 silu4(f32x4 v) { return (f32x4){v[0] * fsigm(v[0]), v[1] * fsigm(v[1]), v[2] * fsigm(v[2]), v[3] * fsigm(v[3])}; }
__device__ __forceinline__ f32x4 sigm4(f32x4 v) { return (f32x4){fsigm(v[0]), fsigm(v[1]), fsigm(v[2]), fsigm(v[3])}; }
__device__ __forceinline__ f32x4 gelu4(f32x4 v) { return (f32x4){fgelu(v[0]), fgelu(v[1]), fgelu(v[2]), fgelu(v[3])}; }
#define GE_FOR_PERM(...) _Pragma("unroll") for (int ai = 0; ai < 2; ++ai) _Pragma("unroll") for (int m = 0; m < 4; ++m) _Pragma("unroll") for (int bj = 0; bj < 2; ++bj) { \
        const int row = ai * HALF + wr * 64 + m * 16 + fr, col8 = bj * HALF + wc * 32 + 8 * fq; __VA_ARGS__ }

struct PA_Sched {
    int G, c; const unsigned char *ws, *wl;
    __device__ __forceinline__ bool unit(int i, Unit& u) const {
        constexpr int nwg = (T / 256) * (N_A1 / 256); const int nA = c < nwg ? (nwg - c + G - 1) / G : 0;
        if (i < nA) { u.type = 0; u.g = 0; return static_tile(i, G, c, T / 256, N_A1 / 256, u.pm, u.pn); }
        if (i == nA && c < 16) { u.type = 1; u.pm = c >> 2; u.pn = c & 3; u.g = 0; return true; }
        return false;
    }
    __device__ __forceinline__ int nseg(const Unit&) const { return 1; }
    __device__ __forceinline__ void seg(const Unit& u, int, Seg& s) const {
        s.A = (const char*)(ws + (u.type == 0 ? OFF_XB : OFF_MEMB)) + (size_t)u.pm * 256 * 2048; s.B = (const char*)(wl + (u.type == 0 ? WO_IN : WO_MKV)) + (size_t)u.pn * 256 * 2048;
        s.a_h = 128 * 2048; s.b_h = 128 * 2048; s.a_k = 128; s.b_k = 128; s.npairs = 8; s.amode = A_STD; s.bmode = B_PERM; s.lda2 = 2048; s.ldb2 = 2048;
    }
};
struct PA_Epi {
    GAS unsigned char* ws; int l;
    __device__ __forceinline__ void seg_end(Acc&, const Unit&, int, int, int, int, int) const {}
    __device__ __forceinline__ void after_drain(Acc&, const Unit&, LAS unsigned char*, int, int, int, int) const {}
    __device__ __forceinline__ void finish(Acc& acc, const Unit& u, int wr, int wc, int fr, int fq) const {
        const int pn = u.pn;
        float r8[8];
        if (u.type == 1) {
#pragma unroll
            for (int i = 0; i < 8; ++i) r8[i] = ((const GAS float*)(ws + OFF_RSMEM))[u.pm * 256 + (i >> 2) * HALF + wr * 64 + (i & 3) * 16 + fr];
        } else {
            load_rs8(ws, u.pm * 256, wr, fr, r8);
        }
        if (u.type == 1) {
            auto KVM = (GAS bf16_t*)(ws + OFF_KVM + (size_t)l * 2 * MiB);
            GE_FOR_PERM({ const int tr = u.pm * 256 + row; const float r = r8[ai * 4 + m]; *(GAS u32x4*)(KVM + (size_t)tr * 1024 + pn * 256 + col8) = pack8(acc[ai][bj][m][0] * r, acc[ai][bj][m][1] * r); })
            return;
        }
        if (pn < 3) {
            auto U = (GAS bf16_t*)(ws + OFF_U);
            GE_FOR_PERM({ const int tr = u.pm * 256 + row; const float r = r8[ai * 4 + m]; const int c = pn * 256 + col8;
                *(GAS u32x4*)(U + ((size_t)(c >> 4) * 1024 + (tr >> 5)) * 640 + (tr & 31) * 16 + (c & 15)) = pack8(acc[ai][bj][m][0] * r, acc[ai][bj][m][1] * r); })
        } else if (pn < 18) {
            const int k = (pn - 3) / 3; const size_t off = k == 0 ? OFF_ZS : (k == 1 ? OFF_Q : (k == 2 ? OFF_K : (k == 3 ? OFF_V : OFF_ZA)));
            auto D = (GAS bf16_t*)(ws + off); const bool silu = (k == 0 || k == 4); const float sc = k == 1 ? 0.125f * 1.4426950408889634f : 1.0f;
            const int cb = (pn - 3 - 3 * k) * 256;
            if (silu) { GE_FOR_PERM({ const int tr = u.pm * 256 + row; const float r = r8[ai * 4 + m]; *(GAS u32x4*)(D + (size_t)tr * 768 + cb + col8) = pack8(silu4(acc[ai][bj][m][0] * r), silu4(acc[ai][bj][m][1] * r)); }) }
            else { GE_FOR_PERM({ const int tr = u.pm * 256 + row; const float r = r8[ai * 4 + m] * sc; *(GAS u32x4*)(D + (size_t)tr * 768 + cb + col8) = pack8(acc[ai][bj][m][0] * r, acc[ai][bj][m][1] * r); }) }
        } else {
            const bool isz = pn >= 20; auto D = (GAS bf16_t*)(ws + (isz ? OFF_ZM : OFF_QM)); const int cb = (pn - (isz ? 20 : 18)) * 256; const float sc = isz ? 1.0f : 0.08838834764831845f * 1.4426950408889634f;
            if (isz) { GE_FOR_PERM({ const int tr = u.pm * 256 + row; const float r = r8[ai * 4 + m]; *(GAS u32x4*)(D + (size_t)tr * 512 + cb + col8) = pack8(silu4(acc[ai][bj][m][0] * r), silu4(acc[ai][bj][m][1] * r)); }) }
            else { GE_FOR_PERM({ const int tr = u.pm * 256 + row; const float r = r8[ai * 4 + m] * sc; *(GAS u32x4*)(D + (size_t)tr * 512 + cb + col8) = pack8(acc[ai][bj][m][0] * r, acc[ai][bj][m][1] * r); }) }
        }
    }
};
struct PS_Sched {
    int c; const unsigned char* ws;
    __device__ __forceinline__ bool unit(int i, Unit& u) const { if (i != 0 || c >= BATCH * NG) return false; u.type = 0; u.g = c % NG; u.pm = c / NG; u.pn = 0; return true; }
    __device__ __forceinline__ int nseg(const Unit&) const { return 1; }
    __device__ __forceinline__ void seg(const Unit& u, int, Seg& s) const {
        s.A = (const char*)((const bf16_t*)(ws + OFF_U) + ((size_t)u.g * 1024 + u.pm * 256) * 640); s.B = (const char*)((const bf16_t*)(ws + OFF_TAB + TAB_WST) + (size_t)u.g * 128 * 512);
        s.a_h = 128 * 1280; s.b_h = 128 * 1024; s.a_k = 128; s.b_k = 128; s.npairs = 4; s.amode = A_STD; s.bmode = B_STD; s.lda2 = 1280; s.ldb2 = 1024;
    }
};
struct PS_Epi {
    GAS unsigned char* ws;
    __device__ __forceinline__ void seg_end(Acc&, const Unit&, int, int, int, int, int) const {}
    __device__ __forceinline__ void finish(Acc&, const Unit&, int, int, int, int) const {}
    __device__ __forceinline__ void after_drain(Acc& acc, const Unit& u, LAS unsigned char* lds, int wr, int wc, int fr, int fq) const {
        LAS float* Sl = (LAS float*)lds;
#pragma unroll
        for (int ai = 0; ai < 2; ++ai)
#pragma unroll
            for (int m = 0; m < 4; ++m)
#pragma unroll
                for (int n = 0; n < 2; ++n) *(LAS f32x4*)(Sl + (ai * HALF + wr * 64 + m * 16 + fr) * 128 + wc * 32 + 16 * n + 4 * fq) = acc[ai][0][m][n];
        asm volatile("s_waitcnt lgkmcnt(0)" ::: "memory"); __builtin_amdgcn_s_barrier(); asm volatile("" ::: "memory");
        if (wr * 4 + wc == 0) {
            auto AQ = (const GAS float*)(ws + OFF_TAB + TAB_AQ); const int p = fq * 16 + fr; const float ar = AQ[(u.g * 64 + p) * 2], ai_ = AQ[(u.g * 64 + p) * 2 + 1];
            float xr = 0.f, xi = 0.f; auto up = (GAS bf16_t*)(ws + OFF_U) + ((size_t)u.g * 1024 + u.pm * 256) * 640 + 512 + p;
            for (int c = 0; c < 256; ++c) {
                up[(size_t)c * 640] = (bf16_t)f2bf(xr); up[(size_t)c * 640 + 64] = (bf16_t)f2bf(xi);
                const float sr = Sl[c * 128 + p], si = Sl[c * 128 + 64 + p];
                const float nxr = ar * xr - ai_ * xi + sr, nxi = ar * xi + ai_ * xr + si; xr = nxr; xi = nxi;
            }
        }
    }
};
struct PY_Sched {
    int c; const unsigned char* ws;
    __device__ __forceinline__ bool unit(int i, Unit& u) const { if (i > 1 || c >= BATCH * NG) return false; u.type = 0; u.pn = 1 - i; u.g = c % NG; u.pm = c / NG; return true; }
    __device__ __forceinline__ int nseg(const Unit&) const { return 2; }
    __device__ __forceinline__ void seg(const Unit& u, int si, Seg& s) const {
        const char* Arow = (const char*)((const bf16_t*)(ws + OFF_U) + ((size_t)u.g * 1024 + u.pm * 256) * 640);
        s.a_h = 128 * 1280; s.a_k = 128; s.amode = A_STD; s.lda2 = 1280;
        if (si == 0) { s.A = Arow; s.B = (const char*)((const bf16_t*)(ws + OFF_TAB + TAB_TOEP) + (size_t)u.g * 48 * 256) + (16 * u.pn + 13) * 512; s.b_h = 8 * 512; s.b_k = -2048; s.npairs = 2 * (u.pn + 1); s.bmode = B_TOEP; s.ldb2 = 0; }
        else { s.A = Arow + 1024; s.B = (const char*)((const bf16_t*)(ws + OFF_TAB + TAB_CST) + ((size_t)u.g * 512 + u.pn * 256) * 128); s.b_h = 128 * 256; s.b_k = 128; s.npairs = 1; s.bmode = B_PERM; s.ldb2 = 256; }
    }
};
struct PY_Epi {
    GAS unsigned char* ws;
    __device__ __forceinline__ void seg_end(Acc&, const Unit&, int, int, int, int, int) const {}
    __device__ __forceinline__ void after_drain(Acc&, const Unit&, LAS unsigned char*, int, int, int, int) const {}
    __device__ __forceinline__ void finish(Acc& acc, const Unit& u, int wr, int wc, int fr, int fq) const {
        auto base = (GAS bf16_t*)(ws + OFF_U) + ((size_t)u.g * 1024 + u.pm * 256) * 640 + u.pn * 256;
        GE_FOR_PERM({ *(GAS u32x4*)(base + (size_t)row * 640 + col8) = pack8(gelu4(acc[ai][bj][m][0]), gelu4(acc[ai][bj][m][1])); })
    }
};
struct PG_Sched {
    int G, c; const unsigned char *ws, *wl;
    __device__ __forceinline__ bool unit(int i, Unit& u) const { u.type = 0; u.g = 0; return static_tile(i, G, c, T / 256, 3, u.pm, u.pn); }
    __device__ __forceinline__ int nseg(const Unit&) const { return 1; }
    __device__ __forceinline__ void seg(const Unit& u, int, Seg& s) const {
        s.A = (const char*)(ws + OFF_U) + (size_t)u.pm * 8 * 1280; s.B = (const char*)(wl + WO_GLU) + (size_t)u.pn * 256 * 1536;
        s.a_h = 4 * 1280; s.a_k = 4 * 1024 * 1280; s.amode = A_GM; s.lda2 = 0; s.b_h = 128 * 1536; s.b_k = 128; s.bmode = B_PERM; s.ldb2 = 1536; s.npairs = 6;
    }
};
struct PG_Epi {
    GAS unsigned char* ws; const GAS float* b;
    __device__ __forceinline__ void seg_end(Acc&, const Unit&, int, int, int, int, int) const {}
    __device__ __forceinline__ void after_drain(Acc&, const Unit&, LAS unsigned char*, int, int, int, int) const {}
    __device__ __forceinline__ void finish(Acc& acc, const Unit& u, int wr, int wc, int fr, int fq) const {
        auto Y = (const GAS bf16_t*)(ws + OFF_U); auto ZS = (GAS bf16_t*)(ws + OFF_ZS);
        f32x4 bb[2][2];
#pragma unroll
        for (int j = 0; j < 2; ++j) { const int c = u.pn * 256 + j * HALF + wc * 32 + 8 * fq; bb[j][0] = *(const GAS f32x4*)(b + c); bb[j][1] = *(const GAS f32x4*)(b + c + 4); }
#pragma unroll
        for (int ai = 0; ai < 2; ++ai)
#pragma unroll
            for (int bj = 0; bj < 2; ++bj) {
                u32x4 yv[4], zv[4]; const int c = u.pn * 256 + bj * HALF + wc * 32 + 8 * fq;
#pragma unroll
                for (int m = 0; m < 4; ++m) { const int tr = u.pm * 256 + ai * HALF + wr * 64 + m * 16 + fr;
                    yv[m] = *(const GAS u32x4*)(Y + ((size_t)(c >> 4) * 1024 + (tr >> 5)) * 640 + (tr & 31) * 16 + (c & 15)); zv[m] = *(const GAS u32x4*)(ZS + (size_t)tr * 768 + c); }
#pragma unroll
                for (int m = 0; m < 4; ++m) { const int tr = u.pm * 256 + ai * HALF + wr * 64 + m * 16 + fr; f32x4 y0, y1, z0, z1; unpack8(yv[m], y0, y1); unpack8(zv[m], z0, z1);
                    *(GAS u32x4*)(ZS + (size_t)tr * 768 + c) = pack8(y0 * sigm4(acc[ai][bj][m][0] + bb[bj][0]) * z0, y1 * sigm4(acc[ai][bj][m][1] + bb[bj][1]) * z1); }
            }
    }
};
struct PM_Sched {
    int G, c; const unsigned char *ws, *wl;
    __device__ __forceinline__ bool unit(int i, Unit& u) const { const int t = i / 6; u.type = i - 6 * t; u.g = 0; return static_tile(t, G, c, T / 256, 4, u.pm, u.pn); }
    __device__ __forceinline__ int nseg(const Unit&) const { return 1; }
    __device__ __forceinline__ void seg(const Unit& u, int, Seg& s) const {
        s.a_k = 128; s.b_k = 128; s.amode = A_STD; s.bmode = B_PERM;
        if ((u.type & 1) == 0) { s.A = (const char*)(ws + OFF_XB) + (size_t)u.pm * 256 * 2048; s.B = (const char*)(wl + WO_IN) + (size_t)(N_A1 + (u.type >> 1) * 1024 + u.pn * 256) * 2048; s.lda2 = 2048; s.ldb2 = 2048; s.npairs = 8; }
        else if (u.type == 1) { s.A = (const char*)(ws + OFF_ZS) + (size_t)u.pm * 256 * 1536; s.B = (const char*)(wl + WO_B1) + (size_t)u.pn * 256 * 1536; s.lda2 = 1536; s.ldb2 = 1536; s.npairs = 6; }
        else if (u.type == 3) { s.A = (const char*)(ws + OFF_Q) + (size_t)u.pm * 256 * 1536; s.B = (const char*)(wl + WO_B2) + (size_t)u.pn * 256 * 1536; s.lda2 = 1536; s.ldb2 = 1536; s.npairs = 6; }
        else { s.A = (const char*)(ws + OFF_QM) + (size_t)u.pm * 256 * 1024; s.B = (const char*)(wl + WO_B3) + (size_t)u.pn * 256 * 1024; s.lda2 = 1024; s.ldb2 = 1024; s.npairs = 4; }
        s.a_h = 128 * (int)s.lda2; s.b_h = 128 * (int)s.ldb2;
    }
};
typedef _Float16 f16x8 __attribute__((ext_vector_type(8)));
struct PM_Epi {
    GAS unsigned char* ws; const GAS float* bg; int c, l;
    __device__ __forceinline__ void seg_end(Acc&, const Unit&, int, int, int, int, int) const {}
    __device__ __forceinline__ void after_drain(Acc&, const Unit&, LAS unsigned char*, int, int, int, int) const {}
    __device__ __forceinline__ void finish(Acc& acc, const Unit& u, int wr, int wc, int fr, int fq) const {
        const int t_ = (wr * 4 + wc) * 64 + fq * 16 + fr;
        GAS unsigned char* st = (ws + OFF_V + (size_t)c * 262144);
        if ((u.type & 1) == 0) {
            auto bgs = bg + (u.type >> 1) * 1024 + u.pn * 256;
            float r8[8]; f32x4 bb[2][2];
            load_rs8(ws, u.pm * 256, wr, fr, r8);
#pragma unroll
            for (int j = 0; j < 2; ++j) { bb[j][0] = *(const GAS f32x4*)(bgs + j * HALF + wc * 32 + 8 * fq); bb[j][1] = *(const GAS f32x4*)(bgs + j * HALF + wc * 32 + 8 * fq + 4); }
            GE_FOR_PERM({ (void)row; (void)col8; const float r = r8[ai * 4 + m]; const f32x4 b0 = bb[bj][0], b1 = bb[bj][1];
                const f32x4 g0 = sigm4(acc[ai][bj][m][0] * r + b0), g1 = sigm4(acc[ai][bj][m][1] * r + b1); f16x8 h;
                h[0] = (_Float16)g0[0]; h[1] = (_Float16)g0[1]; h[2] = (_Float16)g0[2]; h[3] = (_Float16)g0[3]; h[4] = (_Float16)g1[0]; h[5] = (_Float16)g1[1]; h[6] = (_Float16)g1[2]; h[7] = (_Float16)g1[3];
                *(GAS f16x8*)(st + ((ai * 2 + bj) * 4 + m) * 8192 + t_ * 16) = h; })
        } else if (u.type == 1) branch_fin<false, false>(acc, u, st, t_, wr, wc, fr, fq);
        else if (u.type == 3) branch_fin<true, false>(acc, u, st, t_, wr, wc, fr, fq);
        else branch_fin<true, true>(acc, u, st, t_, wr, wc, fr, fq);
    }
    template <bool ADD, bool LAST>
    __device__ __forceinline__ void branch_fin(Acc& acc, const Unit& u, GAS unsigned char* st, int t_, int wr, int wc, int fr, int fq) const {
#pragma unroll
        for (int ai = 0; ai < 2; ++ai)
#pragma unroll
            for (int bj = 0; bj < 2; ++bj) {
                f16x8 h[4], pp[4];
#pragma unroll
                for (int m = 0; m < 4; ++m) { const int idx = (ai * 2 + bj) * 4 + m; h[m] = *(const GAS f16x8*)(st + idx * 8192 + t_ * 16);
                    if (ADD) pp[m] = *(const GAS f16x8*)(st + 131072 + idx * 8192 + t_ * 16); }
#pragma unroll
                for (int m = 0; m < 4; ++m) { const int idx = (ai * 2 + bj) * 4 + m; f32x4 v0 = acc[ai][bj][m][0], v1 = acc[ai][bj][m][1];
#pragma unroll
                    for (int e2 = 0; e2 < 4; ++e2) { v0[e2] *= (float)h[m][e2]; v1[e2] *= (float)h[m][4 + e2]; }
                    if (ADD) {
#pragma unroll
                        for (int e2 = 0; e2 < 4; ++e2) { v0[e2] += (float)pp[m][e2]; v1[e2] += (float)pp[m][4 + e2]; } }
                    if (!LAST) { f16x8 o; o[0] = (_Float16)v0[0]; o[1] = (_Float16)v0[1]; o[2] = (_Float16)v0[2]; o[3] = (_Float16)v0[3]; o[4] = (_Float16)v1[0]; o[5] = (_Float16)v1[1]; o[6] = (_Float16)v1[2]; o[7] = (_Float16)v1[3];
                        *(GAS f16x8*)(st + 131072 + idx * 8192 + t_ * 16) = o; }
                    else { const int row = ai * HALF + wr * 64 + m * 16 + fr, col8 = bj * HALF + wc * 32 + 8 * fq;
                        *(GAS u32x4*)((GAS bf16_t*)(ws + OFF_MERGED) + (size_t)(u.pm * 256 + row) * 1024 + u.pn * 256 + col8) = pack8(v0, v1); } }
            }
    }
};
struct PO_Sched {
    int G, c; const unsigned char *ws, *wl;
    __device__ __forceinline__ bool unit(int i, Unit& u) const { u.type = 0; u.g = 0; return static_tile(i, G, c, T / 256, 4, u.pm, u.pn); }
    __device__ __forceinline__ int nseg(const Unit&) const { return 1; }
    __device__ __forceinline__ void seg(const Unit& u, int, Seg& s) const {
        s.A = (const char*)(ws + OFF_MERGED) + (size_t)u.pm * 256 * 2048; s.B = (const char*)(wl + WO_OUT) + (size_t)u.pn * 256 * 2048;
        s.a_h = 128 * 2048; s.b_h = 128 * 2048; s.a_k = 128; s.b_k = 128; s.npairs = 8; s.amode = A_STD; s.bmode = B_STD; s.lda2 = 2048; s.ldb2 = 2048;
    }
};
struct PO_Epi {
    const GAS float* xold; GAS float* xnew; GAS unsigned char* ws; int l;
    __device__ __forceinline__ void seg_end(Acc&, const Unit&, int, int, int, int, int) const {}
    __device__ __forceinline__ void after_drain(Acc&, const Unit&, LAS unsigned char*, int, int, int, int) const {}
    template <bool NEXT>
    __device__ __forceinline__ void fin(Acc& acc, const Unit& u, int wr, int wc, int fr, int fq) const {
        LAS float* part = (LAS float*)(size_t)RING_BYTES;
        auto XBo = (GAS bf16_t*)(ws + OFF_XB);
#pragma unroll
        for (int ai = 0; ai < 2; ++ai)
#pragma unroll
            for (int mh = 0; mh < 2; ++mh) {
                f32x4 xo[2][2][2];
#pragma unroll
                for (int mm = 0; mm < 2; ++mm) { const int m = mh * 2 + mm; const size_t ro = (size_t)(u.pm * 256 + ai * HALF + wr * 64 + m * 16 + fr) * 1024 + u.pn * 256 + wc * 32 + 4 * fq;
#pragma unroll
                    for (int bj = 0; bj < 2; ++bj)
#pragma unroll
                        for (int n = 0; n < 2; ++n) xo[mm][bj][n] = *(const GAS f32x4*)(xold + ro + bj * HALF + n * 16); }
#pragma unroll
                for (int mm = 0; mm < 2; ++mm) { const int m = mh * 2 + mm, row = ai * HALF + wr * 64 + m * 16 + fr; const size_t ro = (size_t)(u.pm * 256 + row) * 1024 + u.pn * 256 + wc * 32 + 4 * fq; float sq = 0.f;
#pragma unroll
                    for (int bj = 0; bj < 2; ++bj)
#pragma unroll
                        for (int n = 0; n < 2; ++n) { const size_t o = ro + bj * HALF + n * 16; const f32x4 v = xo[mm][bj][n] + acc[ai][bj][m][n]; *(GAS f32x4*)(xnew + o) = v;
                            if (NEXT) { *(GAS u32x2*)(XBo + o) = (u32x2){cvt_pk_bf16(v[0], v[1]), cvt_pk_bf16(v[2], v[3])}; sq += (v[0] * v[0] + v[1] * v[1]) + (v[2] * v[2] + v[3] * v[3]); } }
                    if (NEXT) { sq += __shfl_xor(sq, 16); sq += __shfl_xor(sq, 32); if (fq == 0) part[row * 4 + wc] = sq; } }
            }
        if (NEXT) {
            asm volatile("s_waitcnt lgkmcnt(0)" ::: "memory"); __builtin_amdgcn_s_barrier(); asm volatile("" ::: "memory");
            const int t = (wr * 4 + wc) * 64 + fq * 16 + fr;
            if (t < 256) { const f32x4 p = *(const LAS f32x4*)(part + t * 4); ((GAS float*)(ws + OFF_ROWSQ))[(size_t)(u.pm * 256 + t) * 4 + u.pn] = (p.x + p.y) + (p.z + p.w); }
            asm volatile("s_waitcnt lgkmcnt(0)" ::: "memory"); __builtin_amdgcn_s_barrier(); asm volatile("" ::: "memory");
        }
    }
    __device__ __forceinline__ void finish(Acc& acc, const Unit& u, int wr, int wc, int fr, int fq) const { if (l == 0) fin<true>(acc, u, wr, wc, fr, fq); else fin<false>(acc, u, wr, wc, fr, fq); }
};
}

__device__ __forceinline__ void cpow(float lmag, double rev1, int k, float& re, float& im) {
    const float m = expf((float)k * lmag); double r = (double)k * rev1; r -= rint(r);
    const float a = (float)(r * 6.283185307179586476925286766559); re = m * cosf(a); im = m * sinf(a);
}
__device__ __forceinline__ void tabgen(unsigned char* tab, const float* __restrict__ lam_re, const float* __restrict__ lam_im, const float* __restrict__ log_dt, const float* __restrict__ b_re, const float* __restrict__ b_im,
                                       const float* __restrict__ c_re, const float* __restrict__ c_im, const float* __restrict__ dvec, LAS float* scr, int gw, int ngw, int lane) {
    bf16_t* TOEP = (bf16_t*)(tab + TAB_TOEP); bf16_t* CST = (bf16_t*)(tab + TAB_CST); bf16_t* WST = (bf16_t*)(tab + TAB_WST); float* AQ = (float*)(tab + TAB_AQ);
    for (int item = gw; item < NG * 32; item += ngw) {
        const int g = item >> 5, d = item & 31, p = lane;
        const float dt = expf(log_dt[g]); const float lre = lam_re[g * 64 + p], lim = lam_im[g * 64 + p];
        const float lmag = lre * dt; const double rev1 = (double)lim * (double)dt * 0.15915494309189533576888376337251;
        float fr, fi;
        {
            double r = rev1; r -= rint(r); const float bq = (float)(r * 6.283185307179586476925286766559);
            const float em1 = expm1f(lmag), sb2 = sinf(0.5f * bq); const float nr = em1 * cosf(bq) - 2.f * sb2 * sb2, ni = (em1 + 1.f) * sinf(bq);
            const float den = lre * lre + lim * lim; fr = (nr * lre + ni * lim) / den; fi = (ni * lre - nr * lim) / den;
        }
        float bbr[16], bbi[16];
#pragma unroll
        for (int h = 0; h < 16; ++h) { const float br = b_re[(g * 64 + p) * 16 + h], bi = b_im[(g * 64 + p) * 16 + h]; bbr[h] = fr * br - fi * bi; bbi[h] = fr * bi + fi * br; }
        float pr, pi;
        cpow(lmag, rev1, 31 - d, pr, pi);
        {
            unsigned wre[8], wim[8];
#pragma unroll
            for (int h = 0; h < 16; h += 2) { wre[h >> 1] = pk2(pr * bbr[h] - pi * bbi[h], pr * bbr[h + 1] - pi * bbi[h + 1]); wim[h >> 1] = pk2(pr * bbi[h] + pi * bbr[h], pr * bbi[h + 1] + pi * bbr[h + 1]); }
            u32x4* o0 = (u32x4*)(WST + ((size_t)g * 128 + p) * 512 + d * 16); u32x4* o1 = (u32x4*)(WST + ((size_t)g * 128 + 64 + p) * 512 + d * 16);
            o0[0] = (u32x4){wre[0], wre[1], wre[2], wre[3]}; o0[1] = (u32x4){wre[4], wre[5], wre[6], wre[7]};
            o1[0] = (u32x4){wim[0], wim[1], wim[2], wim[3]}; o1[1] = (u32x4){wim[4], wim[5], wim[6], wim[7]};
        }
        cpow(lmag, rev1, d + 1, pr, pi);
#pragma unroll 2
        for (int hq = 0; hq < 16; ++hq) { const float cr = c_re[(g * 16 + hq) * 64 + p], ci = c_im[(g * 16 + hq) * 64 + p];
            bf16_t* o = CST + ((size_t)g * 512 + d * 16 + hq) * 128; o[p] = (bf16_t)f2bf(cr * pr - ci * pi); o[64 + p] = (bf16_t)f2bf(-(cr * pi + ci * pr)); }
        cpow(lmag, rev1, d, pr, pi);
#pragma unroll
        for (int h = 0; h < 16; ++h) { scr[(p * 16 + h) * 2] = pr * bbr[h] - pi * bbi[h]; scr[(p * 16 + h) * 2 + 1] = pr * bbi[h] + pi * bbr[h]; }
        asm volatile("s_waitcnt lgkmcnt(0)" ::: "memory");
        {
            const int hq = lane >> 2, h0 = (lane & 3) * 4; float a0 = 0.f, a1 = 0.f, a2 = 0.f, a3 = 0.f;
            for (int q = 0; q < 64; ++q) { const float cr = c_re[(g * 16 + hq) * 64 + q], ci = c_im[(g * 16 + hq) * 64 + q]; const LAS float* s = scr + (q * 16 + h0) * 2;
                a0 += cr * s[0] - ci * s[1]; a1 += cr * s[2] - ci * s[3]; a2 += cr * s[4] - ci * s[5]; a3 += cr * s[6] - ci * s[7]; }
            if (d == 0) { const float dd = dvec[g * 16 + hq]; if (hq == h0) a0 += dd; if (hq == h0 + 1) a1 += dd; if (hq == h0 + 2) a2 += dd; if (hq == h0 + 3) a3 += dd; }
            *(u32x2*)(TOEP + ((size_t)g * 48 + 16 + d) * 256 + hq * 16 + h0) = (u32x2){pk2(a0, a1), pk2(a2, a3)};
            if (d < 16) *(u32x2*)(TOEP + ((size_t)g * 48 + d) * 256 + hq * 16 + h0) = (u32x2){0u, 0u};
        }
        asm volatile("s_waitcnt lgkmcnt(0)" ::: "memory");
        if (d == 0) { cpow(lmag, rev1, 32, pr, pi); AQ[(g * 64 + p) * 2] = pr; AQ[(g * 64 + p) * 2 + 1] = pi; }
    }
}

namespace at {
__device__ __forceinline__ int crow(int r, int hi) { return (r & 3) + 8 * (r >> 2) + 4 * hi; }
__device__ __forceinline__ unsigned cvtpk(float lo, float hi) { unsigned r; asm volatile("v_cvt_pk_bf16_f32 %0, %1, %2" : "=v"(r) : "v"(lo), "v"(hi)); return r; }
constexpr float LOG2E = 1.4426950408889634f, LN2 = 0.6931471805599453f;
constexpr int D_VTS = 388;
constexpr int D_LK = 0, D_LVT = 49152, D_LBIAS = D_LVT + 64 * D_VTS * 2, D_LSCR = D_LBIAS + 1024, D_LEND = D_LSCR + 8 * 128;
static_assert(D_LEND <= 146432, "dilated attention LDS");
__device__ __forceinline__ void dil_unit(LAS unsigned char* lds, GAS unsigned char* ws, const GAS float* __restrict__ rel_bias, int b, int head, int r, int s, int np, int tid) {
    const int lane = tid & 63, wave = __builtin_amdgcn_readfirstlane(tid >> 6), r32 = lane & 31, hi = lane >> 5;
    GAS bf16_t* Q = (GAS bf16_t*)(ws + OFF_Q); const GAS bf16_t* Kb = (const GAS bf16_t*)(ws + OFF_K); const GAS bf16_t* V = (const GAS bf16_t*)(ws + OFF_V); GAS float* lse = (GAS float*)(ws + OFF_LSE);
    const size_t rowbase = (size_t)b * SEQ; const int M0 = np * 256, mk0 = M0 - 128;
#pragma unroll
    for (int i = 0; i < 6; ++i) {
        const int idx = tid + 512 * i, key = idx >> 3, ch = idx & 7, mk = mk0 + key; u32x4 kv = (u32x4){0u, 0u, 0u, 0u};
        if (mk >= 0) kv = *(const GAS u32x4*)(Kb + (rowbase + (size_t)mk * r + s) * 768 + head * 64 + ch * 8);
        *(LAS u32x4*)(lds + D_LK + key * 128 + ((ch ^ ((key >> 1) & 7)) << 4)) = kv;
    }
#pragma unroll
    for (int i = 0; i < 3; ++i) {
        const int idx = tid + 512 * i, key = (idx >> 3) * 2, ch = idx & 7, mk = mk0 + key; u32x4 v0 = (u32x4){0u, 0u, 0u, 0u}, v1 = v0;
        if (mk >= 0) { const GAS bf16_t* vp = V + (rowbase + (size_t)mk * r + s) * 768 + head * 64 + ch * 8; v0 = *(const GAS u32x4*)vp; v1 = *(const GAS u32x4*)(vp + (size_t)r * 768); }
        LAS unsigned* vt = (LAS unsigned*)(lds + D_LVT + ((ch * 8) * D_VTS + key) * 2);
        vt[0 * (D_VTS / 2)] = (v0.x & 0xffffu) | (v1.x << 16); vt[1 * (D_VTS / 2)] = (v0.x >> 16) | (v1.x & 0xffff0000u);
        vt[2 * (D_VTS / 2)] = (v0.y & 0xffffu) | (v1.y << 16); vt[3 * (D_VTS / 2)] = (v0.y >> 16) | (v1.y & 0xffff0000u);
        vt[4 * (D_VTS / 2)] = (v0.z & 0xffffu) | (v1.z << 16); vt[5 * (D_VTS / 2)] = (v0.z >> 16) | (v1.z & 0xffff0000u);
        vt[6 * (D_VTS / 2)] = (v0.w & 0xffffu) | (v1.w << 16); vt[7 * (D_VTS / 2)] = (v0.w >> 16) | (v1.w & 0xffff0000u);
    }
    if (tid < 129) ((LAS float*)(lds + D_LBIAS))[tid] = rel_bias[rel_bucket(tid * r) * NH + head] * LOG2E;
    const size_t qtok = rowbase + (size_t)(M0 + 32 * wave + r32) * r + s;
    bf16x8 qf[4];
#pragma unroll
    for (int ks = 0; ks < 4; ++ks) qf[ks] = *(const GAS bf16x8*)(Q + qtok * 768 + head * 64 + 16 * ks + 8 * hi);
    __syncthreads();
    f32x16 S[5];
#pragma unroll
    for (int t = 0; t < 5; ++t) {
#pragma unroll
        for (int q = 0; q < 16; ++q) S[t][q] = 0.f;
        const int key = 32 * (wave + t) + r32; const LAS unsigned char* kp = lds + D_LK + key * 128; const int sw = (key >> 1) & 7;
#pragma unroll
        for (int ks = 0; ks < 4; ++ks) S[t] = __builtin_amdgcn_mfma_f32_32x32x16_bf16(*(const LAS bf16x8*)(kp + (((2 * ks + hi) ^ sw) << 4)), qf[ks], S[t], 0, 0, 0);
    }
    const LAS float* biasl = (const LAS float*)(lds + D_LBIAS);
    float mx = -1e30f;
#pragma unroll
    for (int t = 0; t < 5; ++t)
#pragma unroll
        for (int q = 0; q < 16; ++q) {
            const int kk = crow(q, hi), delta = 128 + r32 - 32 * t - kk; const bool ok = (delta >= 0) && (delta <= 128) && (mk0 + 32 * (wave + t) + kk >= 0);
            const int di = delta < 0 ? 0 : (delta > 128 ? 128 : delta);
            const float v = ok ? S[t][q] + biasl[di] : -1e30f; S[t][q] = v; mx = fmaxf(mx, v);
        }
    mx = fmaxf(mx, __shfl_xor(mx, 32));
    float lsum = 0.f; unsigned pk[5][8];
#pragma unroll
    for (int t = 0; t < 5; ++t) {
#pragma unroll
        for (int q = 0; q < 16; ++q) { const float p = __builtin_amdgcn_exp2f(S[t][q] - mx); S[t][q] = p; lsum += p; }
#pragma unroll
        for (int q = 0; q < 8; ++q) pk[t][q] = cvtpk(S[t][2 * q], S[t][2 * q + 1]);
    }
    lsum += __shfl_xor(lsum, 32);
    f32x16 O[2];
#pragma unroll
    for (int d0 = 0; d0 < 2; ++d0)
#pragma unroll
        for (int q = 0; q < 16; ++q) O[d0][q] = 0.f;
#pragma unroll
    for (int t = 0; t < 5; ++t)
#pragma unroll
        for (int s2 = 0; s2 < 2; ++s2) {
            const bf16x8 A = __builtin_bit_cast(bf16x8, (u32x4){pk[t][4 * s2], pk[t][4 * s2 + 1], pk[t][4 * s2 + 2], pk[t][4 * s2 + 3]});
#pragma unroll
            for (int d0 = 0; d0 < 2; ++d0) {
                const LAS unsigned char* vp = lds + D_LVT + ((32 * d0 + r32) * D_VTS + 32 * (wave + t) + 16 * s2 + 4 * hi) * 2;
                const u32x2 lo = *(const LAS u32x2*)vp, hi2 = *(const LAS u32x2*)(vp + 16);
                O[d0] = __builtin_amdgcn_mfma_f32_32x32x16_bf16(A, __builtin_bit_cast(bf16x8, (u32x4){lo.x, lo.y, hi2.x, hi2.y}), O[d0], 0, 0, 0);
            }
        }
    LAS float* scr = (LAS float*)(lds + D_LSCR + wave * 128);
    if (hi == 0) { scr[r32] = __builtin_amdgcn_rcpf(lsum); lse[qtok * NH + head] = (mx + __builtin_amdgcn_logf(lsum)) * LN2; }
    __syncthreads();
    LAS bf16_t* stg = (LAS bf16_t*)(lds + D_LK + wave * 4096);
#pragma unroll
    for (int q = 0; q < 16; ++q) { const int orow = crow(q, hi); const float ri = scr[orow];
        stg[orow * 64 + r32] = (bf16_t)f2bf(O[0][q] * ri); stg[orow * 64 + 32 + r32] = (bf16_t)f2bf(O[1][q] * ri); }
    asm volatile("s_waitcnt lgkmcnt(0)" ::: "memory");
#pragma unroll
    for (int i = 0; i < 4; ++i) { const int row = i * 8 + (lane >> 3), ch = lane & 7;
        *(GAS u32x4*)(Q + (rowbase + (size_t)(M0 + 32 * wave + row) * r + s) * 768 + head * 64 + ch * 8) = *(const LAS u32x4*)(stg + row * 64 + ch * 8); }
    __syncthreads();
}
constexpr int M_VTS = 260;
constexpr int M_LK = 0, M_LVT = 65536, M_LSCR = M_LVT + 128 * M_VTS * 2, M_LEND = M_LSCR + 8 * 128;
static_assert(M_LEND <= 146432, "memory attention LDS");
__device__ __forceinline__ void mem_unit(LAS unsigned char* lds, GAS unsigned char* ws, int l, int b, int head, int qb, int tid) {
    const int lane = tid & 63, wave = __builtin_amdgcn_readfirstlane(tid >> 6), r32 = lane & 31, hi = lane >> 5;
    GAS bf16_t* QM = (GAS bf16_t*)(ws + OFF_QM); const GAS bf16_t* ZM = (const GAS bf16_t*)(ws + OFF_ZM); const GAS bf16_t* KVM = (const GAS bf16_t*)(ws + OFF_KVM + (size_t)l * 2 * MiB) + (size_t)b * 256 * 1024 + head * 128;
#pragma unroll
    for (int i = 0; i < 8; ++i) {
        const int idx = tid + 512 * i, key = idx >> 4, ch = idx & 15;
        *(LAS u32x4*)(lds + M_LK + key * 256 + ((ch ^ (key & 15)) << 4)) = *(const GAS u32x4*)(KVM + (size_t)key * 1024 + ch * 8);
    }
#pragma unroll
    for (int i = 0; i < 4; ++i) {
        const int idx = tid + 512 * i, key = (idx >> 4) * 2, ch = idx & 15; const GAS bf16_t* vp = KVM + (size_t)key * 1024 + 512 + ch * 8;
        const u32x4 v0 = *(const GAS u32x4*)vp, v1 = *(const GAS u32x4*)(vp + 1024);
        LAS unsigned* vt = (LAS unsigned*)(lds + M_LVT + ((ch * 8) * M_VTS + key) * 2);
        vt[0 * (M_VTS / 2)] = (v0.x & 0xffffu) | (v1.x << 16); vt[1 * (M_VTS / 2)] = (v0.x >> 16) | (v1.x & 0xffff0000u);
        vt[2 * (M_VTS / 2)] = (v0.y & 0xffffu) | (v1.y << 16); vt[3 * (M_VTS / 2)] = (v0.y >> 16) | (v1.y & 0xffff0000u);
        vt[4 * (M_VTS / 2)] = (v0.z & 0xffffu) | (v1.z << 16); vt[5 * (M_VTS / 2)] = (v0.z >> 16) | (v1.z & 0xffff0000u);
        vt[6 * (M_VTS / 2)] = (v0.w & 0xffffu) | (v1.w << 16); vt[7 * (M_VTS / 2)] = (v0.w >> 16) | (v1.w & 0xffff0000u);
    }
    const size_t qrow0 = (size_t)b * SEQ + qb * 256 + 32 * wave;
    __syncthreads();
    f32x16 S[8];
#pragma unroll
    for (int t = 0; t < 8; ++t)
#pragma unroll
        for (int q = 0; q < 16; ++q) S[t][q] = 0.f;
#pragma unroll
    for (int ks = 0; ks < 8; ++ks) {
        const bf16x8 qf = *(const GAS bf16x8*)(QM + (qrow0 + r32) * 512 + head * 128 + 16 * ks + 8 * hi);
#pragma unroll
        for (int t = 0; t < 8; ++t) { const int key = 32 * t + r32;
            S[t] = __builtin_amdgcn_mfma_f32_32x32x16_bf16(*(const LAS bf16x8*)(lds + M_LK + key * 256 + (((2 * ks + hi) ^ (key & 15)) << 4)), qf, S[t], 0, 0, 0); }
    }
    float mx = -1e30f;
#pragma unroll
    for (int t = 0; t < 8; ++t)
#pragma unroll
        for (int q = 0; q < 16; ++q) mx = fmaxf(mx, S[t][q]);
    mx = fmaxf(mx, __shfl_xor(mx, 32));
    float lsum = 0.f; unsigned pk[8][8];
#pragma unroll
    for (int t = 0; t < 8; ++t) {
#pragma unroll
        for (int q = 0; q < 16; ++q) { const float p = __builtin_amdgcn_exp2f(S[t][q] - mx); S[t][q] = p; lsum += p; }
#pragma unroll
        for (int q = 0; q < 8; ++q) pk[t][q] = cvtpk(S[t][2 * q], S[t][2 * q + 1]);
    }
    lsum += __shfl_xor(lsum, 32);
    f32x16 O[4];
#pragma unroll
    for (int d0 = 0; d0 < 4; ++d0)
#pragma unroll
        for (int q = 0; q < 16; ++q) O[d0][q] = 0.f;
#pragma unroll
    for (int t = 0; t < 8; ++t)
#pragma unroll
        for (int s2 = 0; s2 < 2; ++s2) {
            const bf16x8 A = __builtin_bit_cast(bf16x8, (u32x4){pk[t][4 * s2], pk[t][4 * s2 + 1], pk[t][4 * s2 + 2], pk[t][4 * s2 + 3]});
#pragma unroll
            for (int d0 = 0; d0 < 4; ++d0) {
                const LAS unsigned char* vp = lds + M_LVT + ((32 * d0 + r32) * M_VTS + 32 * t + 16 * s2 + 4 * hi) * 2;
                const u32x2 lo = *(const LAS u32x2*)vp, hi2 = *(const LAS u32x2*)(vp + 16);
                O[d0] = __builtin_amdgcn_mfma_f32_32x32x16_bf16(A, __builtin_bit_cast(bf16x8, (u32x4){lo.x, lo.y, hi2.x, hi2.y}), O[d0], 0, 0, 0);
            }
        }
    LAS float* scr = (LAS float*)(lds + M_LSCR + wave * 128);
    if (hi == 0) scr[r32] = __builtin_amdgcn_rcpf(lsum);
    __syncthreads();
    LAS bf16_t* stg = (LAS bf16_t*)(lds + M_LK + wave * 8192);
#pragma unroll
    for (int q = 0; q < 16; ++q) { const int orow = crow(q, hi); const float ri = scr[orow];
#pragma unroll
        for (int d0 = 0; d0 < 4; ++d0) stg[orow * 128 + 32 * d0 + r32] = (bf16_t)f2bf(O[d0][q] * ri); }
    asm volatile("s_waitcnt lgkmcnt(0)" ::: "memory");
#pragma unroll
    for (int i = 0; i < 8; ++i) { const int row = i * 4 + (lane >> 4), ch = lane & 15; const size_t go = (qrow0 + row) * 512 + head * 128 + ch * 8;
        const u32x4 o = *(const LAS u32x4*)(stg + row * 128 + ch * 8), z = *(const GAS u32x4*)(ZM + go);
        *(GAS u32x4*)(QM + go) = (u32x4){pk2(bflo(o.x) * bflo(z.x), bfhi(o.x) * bfhi(z.x)), pk2(bflo(o.y) * bflo(z.y), bfhi(o.y) * bfhi(z.y)),
                                     pk2(bflo(o.z) * bflo(z.z), bfhi(o.z) * bfhi(z.z)), pk2(bflo(o.w) * bflo(z.w), bfhi(o.w) * bfhi(z.w))}; }
    __syncthreads();
}
}

constexpr int PTR_OFF = MISC_OFF + 256;
__device__ __forceinline__ const float* ld_inptr(LAS unsigned char* lds, int k) {
    const unsigned long long v = ((volatile LAS unsigned long long*)(lds + PTR_OFF))[k];
    const unsigned lo = __builtin_amdgcn_readfirstlane((unsigned)v), hi = __builtin_amdgcn_readfirstlane((unsigned)(v >> 32));
    return (const float*)(GAS const float*)(((unsigned long long)hi << 32) | lo);
}
struct Args { const float* in[23]; float* out; unsigned char* ws; int ph_lo, ph_hi; };
__global__ void __launch_bounds__(NTHREADS, 2) mega_fwd(Args args) {
    extern __shared__ __attribute__((aligned(16))) unsigned char lds_raw[];
    LAS unsigned char* lds = (LAS unsigned char*)lds_raw;
    const int G_ = gridDim.x, ngw = G_ * NWAVES;
#define PHASE_IDS() const int tid = fresh_tid(), lane = tid & 63, wave = __builtin_amdgcn_readfirstlane(tid >> 6), cb = fresh_bid(), gw = cb * NWAVES + wave; (void)lane; (void)gw; (void)tid; \
        GAS unsigned char* ws = (GAS unsigned char*)fresh_ptr(args.ws); GAS unsigned char* out_p = (GAS unsigned char*)fresh_ptr((unsigned char*)args.out); (void)ws; (void)out_p
    for (int u = threadIdx.x; u < (LDS_BYTES - LDSCTL_OFF) / 4; u += NTHREADS) ((LAS unsigned*)(lds + LDSCTL_OFF))[u] = 0u;
    __syncthreads();
    if (threadIdx.x == 0) {
#pragma unroll
        for (int k = 0; k < 23; ++k) ((volatile LAS unsigned long long*)(lds + PTR_OFF))[k] = (unsigned long long)args.in[k];
    }
    __syncthreads();
#define INP(k) ld_inptr(lds, k)
    XcdBarrier bar = xcd_barrier_post((unsigned*)args.ws + CW_BAR, (volatile LAS unsigned*)(lds + MISC_OFF) + 8);
#define xout ((float*)(unsigned char*)out_p)
#define rs ((float*)(unsigned char*)(ws + OFF_RS))
#define rs_mem ((float*)(unsigned char*)(ws + OFF_RSMEM))
#define lse ((float*)(unsigned char*)(ws + OFF_LSE))
#define XB ((bf16_t*)(unsigned char*)(ws + OFF_XB))
#define U ((bf16_t*)(unsigned char*)(ws + OFF_U))
#define ZM ((bf16_t*)(unsigned char*)(ws + OFF_ZM))
#define ZS ((bf16_t*)(unsigned char*)(ws + OFF_ZS))
#define Q ((bf16_t*)(unsigned char*)(ws + OFF_Q))
#define Kb ((bf16_t*)(unsigned char*)(ws + OFF_K))
#define V ((bf16_t*)(unsigned char*)(ws + OFF_V))
#define ZA ((bf16_t*)(unsigned char*)(ws + OFF_ZA))
#define QM ((bf16_t*)(unsigned char*)(ws + OFF_QM))
#define Y ((bf16_t*)(unsigned char*)(ws + OFF_Y))
#define MG ((bf16_t*)(unsigned char*)(ws + OFF_MERGED))
#define MEMB ((bf16_t*)(unsigned char*)(ws + OFF_MEMB))
#define tab ((unsigned char*)(ws + OFF_TAB))
#define x_in INP(0)
#define mem INP(1)
#define norm_g INP(2)
#define mem_norm_g INP(3)
#define w_in INP(4)
#define b_gate INP(5)
#define lam_re INP(6)
#define lam_im INP(7)
#define log_dt INP(8)
#define b_re INP(9)
#define b_im INP(10)
#define c_re INP(11)
#define c_im INP(12)
#define ssm_d INP(13)
#define w_glu INP(14)
#define b_glu INP(15)
#define w_mem_kv INP(16)
#define w_br_ssm INP(17)
#define w_br_attn INP(18)
#define w_br_mem INP(19)
#define w_out INP(20)
#define rel_bias INP(21)
#define final_g INP(22)
#define WL(l, o) ((bf16_t*)(unsigned char*)(ws + OFF_W + (size_t)(l) * W_STRIDE + (o)))
#define GRID_BAR() xcd_barrier(bar)
#define TABGEN(l) tabgen(tab, lam_re + (l) * NG * NP, lam_im + (l) * NG * NP, log_dt + (l) * NG, b_re + (size_t)(l) * NG * NP * HG, b_im + (size_t)(l) * NG * NP * HG, \
                         c_re + (size_t)(l) * NG * HG * NP, c_im + (size_t)(l) * NG * HG * NP, ssm_d + (l) * D_SSM, (LAS float*)(lds + wave * 16384), gw, ngw, lane)
    {
        PHASE_IDS();
        LAS float* scr = (LAS float*)(lds + wave * 16384);
        for (int l = 0; l < DEPTH; ++l) {
            constexpr int I_IN = (1024 / 64) * (D_IN / 32), I_GLU = (768 / 64) * (768 / 32), I_B12 = (768 / 64) * (1024 / 32), I_B3 = (512 / 64) * (1024 / 32), I_SQ = (1024 / 64) * (1024 / 32);
            constexpr int NIT = I_IN + I_GLU + 2 * I_B12 + I_B3 + 2 * I_SQ;
            for (int it = gw; it < NIT; it += ngw) {
                int r = it;
                if (r < I_IN) { transpose_item(w_in + (size_t)l * 1024 * D_IN, 1024, D_IN, WL(l, WO_IN), 1024, norm_g + l * 1024, scr, r, lane); continue; } r -= I_IN;
                if (r < I_GLU) { transpose_item(w_glu + (size_t)l * 768 * 768, 768, 768, WL(l, WO_GLU), 768, nullptr, scr, r, lane); continue; } r -= I_GLU;
                if (r < I_B12) { transpose_item(w_br_ssm + (size_t)l * 768 * 1024, 768, 1024, WL(l, WO_B1), 768, nullptr, scr, r, lane); continue; } r -= I_B12;
                if (r < I_B12) { transpose_item(w_br_attn + (size_t)l * 768 * 1024, 768, 1024, WL(l, WO_B2), 768, nullptr, scr, r, lane); continue; } r -= I_B12;
                if (r < I_B3) { transpose_item(w_br_mem + (size_t)l * 512 * 1024, 512, 1024, WL(l, WO_B3), 512, nullptr, scr, r, lane); continue; } r -= I_B3;
                if (r < I_SQ) { transpose_item(w_out + (size_t)l * 1024 * 1024, 1024, 1024, WL(l, WO_OUT), 1024, nullptr, scr, r, lane); continue; } r -= I_SQ;
                transpose_item(w_mem_kv + (size_t)l * 1024 * 1024, 1024, 1024, WL(l, WO_MKV), 1024, mem_norm_g + l * 1024, scr, r, lane);
            }
        }
        for (int m = 2 * gw; m < T; m += 2 * ngw) rownorm_row2(x_in, XB, rs, m, lane, (float*)(unsigned char*)(ws + OFF_ROWSQ));
        for (int m = gw; m < BATCH * MEM_LEN; m += ngw) rownorm_row(mem, MEMB, rs_mem, m, lane);
        TABGEN(0);
    }
    GRID_BAR();
#pragma unroll 1
    for (int l = 0; l < DEPTH; ++l) {
#define KVM ((bf16_t*)(unsigned char*)(ws + OFF_KVM + (size_t)l * 2 * MiB))
        {
            PHASE_IDS();
            if (l > 0) { TABGEN(l); __syncthreads(); }
            ge::PA_Sched S{G_, cb, (unsigned char*)ws, (unsigned char*)ws + OFF_W + (size_t)l * W_STRIDE};
            ge::PA_Epi E{ws, l};
            ge::gemm_run(lds, S, E);
        }
        GRID_BAR();
        {
            PHASE_IDS();
            { ge::PS_Sched S{cb, (unsigned char*)ws}; ge::PS_Epi E{ws}; ge::gemm_run(lds, S, E); }
            asm volatile("s_waitcnt vmcnt(0)" ::: "memory"); __syncthreads();
            { ge::PY_Sched S{cb, (unsigned char*)ws}; ge::PY_Epi E{ws}; ge::gemm_run(lds, S, E); }
            __syncthreads();
        }
        {
            PHASE_IDS();
            const int nss = BATCH * NG, n_lo = 5, n_hi = (BATCH * NH * 32 - nss * n_lo + (G_ - nss) - 1) / (G_ - nss);
            const int u_beg = cb < nss ? cb * n_lo : nss * n_lo + (cb - nss) * n_hi, u_cnt = cb < nss ? n_lo : n_hi;
            for (int uj = 0; uj < u_cnt; ++uj) { const int ui = u_beg + uj; if (ui >= BATCH * NH * 32) break;
                const int u32i = ui & 31, bh = ui >> 5, head = bh % NH, b = bh / NH, grp = head >> 2, r = grp == 0 ? 1 : (grp == 1 ? 4 : 16), ppr = 32 / r;
                at::dil_unit(lds, ws, (const GAS float*)rel_bias, b, head, r, u32i / ppr, u32i % ppr, tid);
            }
        }
        {
            PHASE_IDS();
            for (int ui = cb; ui < BATCH * MH * 32; ui += G_) at::mem_unit(lds, ws, l, ui >> 7, (ui >> 5) & 3, ui & 31, tid);
        }
        GRID_BAR();
        {
            PHASE_IDS();
            ge::PG_Sched S{G_, cb, (unsigned char*)ws, (unsigned char*)ws + OFF_W + (size_t)l * W_STRIDE};
            ge::PG_Epi E{ws, (const GAS float*)(b_glu + l * 768)};
            ge::gemm_run(lds, S, E);
        }
        {
            PHASE_IDS();
            const int nfree = G_ - 128;
            if (nfree > 0) { if (cb >= 128) for (int tp = (cb - 128) * NWAVES + wave; tp < T / 2; tp += nfree * NWAVES) attn_final_pair(Q, lse, ZA, 2 * tp, lane); }
            else for (int tp = gw; tp < T / 2; tp += ngw) attn_final_pair(Q, lse, ZA, 2 * tp, lane);
        }
        GRID_BAR();
        {
            PHASE_IDS();
            ge::PM_Sched S{G_, cb, (unsigned char*)ws, (unsigned char*)ws + OFF_W + (size_t)l * W_STRIDE};
            ge::PM_Epi E{ws, (const GAS float*)(b_gate + l * 3072), cb, l};
            ge::gemm_run(lds, S, E);
        }
        GRID_BAR();
        {
            PHASE_IDS();
            ge::PO_Sched S{G_, cb, (unsigned char*)ws, (unsigned char*)ws + OFF_W + (size_t)l * W_STRIDE};
            ge::PO_Epi E{(const GAS float*)(l == 0 ? x_in : xout), (GAS float*)xout, ws, l};
            ge::gemm_run(lds, S, E);
        }
        GRID_BAR();
        if (l + 1 == DEPTH) { PHASE_IDS(); for (int m = gw; m < T; m += ngw) final_norm_row(xout, final_g, m, lane); }
    }
}

extern "C" void kernel_launch(void* const* d_in, const int* in_sizes, int n_in, void* d_out, int out_size, void* d_ws, size_t ws_size, hipStream_t stream) {
    static int grid = 0;
    if (grid == 0) {
        if (n_in != 23 || ws_size < WS_NEED || out_size != T * D_MODEL) { fprintf(stderr, "kernel_launch: unexpected shapes (n_in %d, ws %zu, out %d)\n", n_in, ws_size, out_size); grid = -1; return; }
        int dev = 0, cus = 0, per_cu = 0;
        if (hipGetDevice(&dev) != hipSuccess || hipDeviceGetAttribute(&cus, hipDeviceAttributeMultiprocessorCount, dev) != hipSuccess) { grid = -1; return; }
        if (hipFuncSetAttribute((const void*)mega_fwd, hipFuncAttributeMaxDynamicSharedMemorySize, LDS_BYTES) != hipSuccess) { fprintf(stderr, "kernel_launch: hipFuncSetAttribute failed\n"); grid = -1; return; }
        if (hipOccupancyMaxActiveBlocksPerMultiprocessor(&per_cu, (const void*)mega_fwd, NTHREADS, LDS_BYTES) != hipSuccess || per_cu < 1) { fprintf(stderr, "kernel_launch: occupancy query says %d blocks/CU\n", per_cu); per_cu = 1; }
        (void)hipGetLastError();
        grid = cus * 1;
    }
    if (grid < 0) return;
    (void)hipMemsetAsync(d_ws, 0, CTL_ZERO_BYTES, stream);
    Args a{};
    for (int i = 0; i < 23; ++i) a.in[i] = (const float*)d_in[i];
    a.out = (float*)d_out; a.ws = (unsigned char*)d_ws; a.ph_lo = 0; a.ph_hi = 0;
    hipLaunchKernelGGL(mega_fwd, dim3(grid), dim3(NTHREADS), LDS_BYTES, stream, a);
}
```

```cpp
#include <hip/hip_runtime.h>
#include <cstdint>
#include <cstdio>

typedef unsigned short bf16_t;
typedef short bf16x8 __attribute__((ext_vector_type(8)));
typedef float f32x4 __attribute__((ext_vector_type(4)));
typedef float f32x16 __attribute__((ext_vector_type(16)));
typedef unsigned u32x4 __attribute__((ext_vector_type(4)));
typedef unsigned u32x2 __attribute__((ext_vector_type(2)));

constexpr int D_MODEL = 1024, BATCH = 4, SEQ = 8192, DEPTH = 2, T = BATCH * SEQ;
constexpr int D_SSM = 768, NG = 48, HG = 16, NP = 64;
constexpr int NH = 12, HD = 64, D_ATTN = 768;
constexpr int MEM_LEN = 256, MH = 4, MHD = 128, D_MEM = 512;
constexpr int D_IN = 8704, N_A1 = 5632;
constexpr float EPS = 1e-6f;

constexpr size_t MiB = 1u << 20;
constexpr size_t OFF_RS = 1 * MiB, OFF_RSMEM = 1 * MiB + 256 * 1024, OFF_LSE = 2 * MiB;
constexpr size_t OFF_W = 4 * MiB, W_STRIDE = 27 * MiB;
constexpr size_t WO_IN = 0, WO_GLU = 17 * MiB, WO_B1 = WO_GLU + 1179648, WO_B2 = WO_B1 + 1572864, WO_B3 = WO_B2 + 1572864, WO_OUT = WO_B3 + 1048576, WO_MKV = WO_OUT + 2 * MiB;
static_assert(WO_MKV + 2 * MiB <= W_STRIDE, "weights");
constexpr size_t OFF_KVM = 58 * MiB, OFF_MEMB = 62 * MiB, OFF_XB = 64 * MiB, OFF_U = 128 * MiB, OFF_ZM = 188 * MiB, OFF_ZS = 220 * MiB, OFF_Q = 268 * MiB,
                 OFF_K = 316 * MiB, OFF_V = 364 * MiB, OFF_ZA = 412 * MiB, OFF_QM = 460 * MiB, OFF_TAB = 492 * MiB, WS_NEED = 512 * MiB;
constexpr size_t OFF_Y = OFF_K, OFF_MERGED = OFF_U;

__device__ __forceinline__ unsigned f2bf(float f) { unsigned u = __builtin_bit_cast(unsigned, f); return (u + 0x7fffu + ((u >> 16) & 1u)) >> 16; }
__device__ __forceinline__ unsigned pk2(float lo, float hi) { return f2bf(lo) | (f2bf(hi) << 16); }
__device__ __forceinline__ float bflo(unsigned u) { return __builtin_bit_cast(float, u << 16); }
__device__ __forceinline__ float bfhi(unsigned u) { return __builtin_bit_cast(float, u & 0xffff0000u); }
__device__ __forceinline__ float bf2f(bf16_t h) { return __builtin_bit_cast(float, (unsigned)h << 16); }
__device__ __forceinline__ float sigmoidf_(float x) { return 1.f / (1.f + __expf(-x)); }
__device__ __forceinline__ float siluf_(float x) { return x * sigmoidf_(x); }
__device__ __forceinline__ float gelu_tanh(float y) { return 0.5f * y * (1.f + tanhf(0.7978845608028654f * (y + 0.044715f * y * y * y))); }
__device__ __forceinline__ float wave_sum(float v) {
#pragma unroll
    for (int o = 1; o < 64; o <<= 1) v += __shfl_xor(v, o);
    return v;
}
__device__ __forceinline__ float wave_max(float v) {
#pragma unroll
    for (int o = 1; o < 64; o <<= 1) v = fmaxf(v, __shfl_xor(v, o));
    return v;
}

#define GAS __attribute__((address_space(1)))
#define LAS __attribute__((address_space(3)))
constexpr int NWAVES = 8, NTHREADS = 512;
constexpr int RING_BYTES = 131072, LDS_BYTES = 147456, LDSCTL_OFF = LDS_BYTES - 1024, MISC_OFF = LDSCTL_OFF + 320;
constexpr size_t CTL_ZERO_BYTES = 1 * MiB; constexpr int CW_BAR = 4096;

#define XB_TMO      128
#define XB_XCNT(j)  (256  + 64 * (j))
#define XB_XSUB(j)  (1280 + 64 * (j))
#define XB_XGEN(j)  (2304 + 64 * (j))
#define XB_TOP      3328
#define XB_TOPGEN   3392
#define XCD_BAR_WORDS 3456
#define XB_SPIN_CAP (1u << 18)
__device__ __forceinline__ unsigned xb_ld(unsigned* p)              { return __hip_atomic_load(p, __ATOMIC_RELAXED, __HIP_MEMORY_SCOPE_AGENT); }
__device__ __forceinline__ unsigned xb_add(unsigned* p, unsigned v) { return __hip_atomic_fetch_add(p, v, __ATOMIC_RELAXED, __HIP_MEMORY_SCOPE_AGENT); }
__device__ __forceinline__ unsigned xb_xcc_id() { return (unsigned)__builtin_amdgcn_s_getreg((3 << 11) | 20) & 0xFu; }
#define XB_SPIN(cond, bar) do { unsigned _sp = 0; while (cond) { __builtin_amdgcn_s_sleep(1); \
    if ((++_sp & 255u) == 0u) { if (xb_ld(&(bar)[XB_TMO])) break; if (_sp > XB_SPIN_CAP) { atomicAdd(&(bar)[XB_TMO], 1u); break; } } } } while (0)
struct XcdBarrier { unsigned* bar; unsigned x; volatile LAS unsigned* st; };
__device__ __forceinline__ XcdBarrier xcd_barrier_post(unsigned* bar, volatile LAS unsigned* st) {
    XcdBarrier b; b.bar = bar; b.x = (unsigned)__builtin_amdgcn_readfirstlane((int)xb_xcc_id()); b.st = st;
    if (threadIdx.x == 0) (void)xb_add(&bar[XB_XCNT(b.x)], 1u);
    return b;
}
__device__ __forceinline__ void xcd_barrier_complete(unsigned* bar, unsigned x, unsigned& nloc, unsigned& nx) {
    const unsigned G = gridDim.x * gridDim.y * gridDim.z;
    unsigned sum, cnt, mine, sp = 0u;
    for (;;) {
        sum = 0u; cnt = 0u; mine = 0u;
#pragma unroll
        for (unsigned j = 0; j < 16; ++j) { const unsigned c = xb_ld(&bar[XB_XCNT(j)]); sum += c; cnt += (c > 0u) ? 1u : 0u; mine = (j == x) ? c : mine; }
        if (sum == G) break;
        __builtin_amdgcn_s_sleep(1);
        if ((++sp & 255u) == 0u) { if (xb_ld(&bar[XB_TMO])) break; if (sp > XB_SPIN_CAP) { atomicAdd(&bar[XB_TMO], 1u); break; } }
    }
    nloc = mine > 0u ? mine : 1u; nx = cnt > 0u ? cnt : 1u;
}
__device__ __forceinline__ void xcd_barrier(const XcdBarrier& b) {
    asm volatile("s_waitcnt vmcnt(0)" ::: "memory");
    __syncthreads();
    if (threadIdx.x == 0) {
        unsigned* bar = b.bar; unsigned bx = b.x; asm volatile("" : "+s"(bar), "+s"(bx));
        __builtin_amdgcn_s_waitcnt(0);
        unsigned nloc = b.st[0], nx = b.st[1];
        if (nloc == 0u) { xcd_barrier_complete(bar, bx, nloc, nx); b.st[0] = nloc; b.st[1] = nx; }
        const unsigned old = xb_add(&bar[XB_XSUB(bx)], 1u);
        const unsigned gen = old / nloc;
        if (old + 1u == (gen + 1u) * nloc) {
            __builtin_amdgcn_fence(__ATOMIC_RELEASE, "agent");
            asm volatile("s_waitcnt vmcnt(0)" ::: "memory");
            const unsigned og = xb_add(&bar[XB_TOP], 1u);
            const unsigned tg = og / nx;
            if (og + 1u == (tg + 1u) * nx) xb_add(&bar[XB_TOPGEN], 1u);
            else XB_SPIN(xb_ld(&bar[XB_TOPGEN]) == tg, bar);
            __builtin_amdgcn_fence(__ATOMIC_ACQUIRE, "agent");
            xb_add(&bar[XB_XGEN(bx)], 1u);
            asm volatile("s_waitcnt vmcnt(0)" ::: "memory");
        } else {
            XB_SPIN(xb_ld(&bar[XB_XGEN(bx)]) == gen, bar);
            __builtin_amdgcn_fence(__ATOMIC_ACQUIRE, "agent");
            asm volatile("s_waitcnt vmcnt(0)" ::: "memory");
        }
    }
    __syncthreads();
}

__device__ __forceinline__ void transpose_item(const float* __restrict__ W, int K, int N, bf16_t* __restrict__ WT, int ldt, const float* __restrict__ kscale, LAS float* scr, int item, int lane) {
    const int nblk = N / 32, kb = item / nblk, nb = item % nblk, k0 = 64 * kb, n0 = 32 * nb;
#pragma unroll
    for (int i = 0; i < 32; ++i) { const int kk = 2 * i + (lane >> 5); const float s = kscale ? kscale[k0 + kk] : 1.f; scr[kk * 33 + (lane & 31)] = W[(size_t)(k0 + kk) * N + n0 + (lane & 31)] * s; }
    asm volatile("s_waitcnt lgkmcnt(0)" ::: "memory");
    const int c = lane & 7;
#pragma unroll
    for (int j = 0; j < 4; ++j) { const int n = (lane >> 3) + 8 * j; const LAS float* s = scr + (8 * c) * 33 + n;
        u32x4 o; o.x = pk2(s[0 * 33], s[1 * 33]); o.y = pk2(s[2 * 33], s[3 * 33]); o.z = pk2(s[4 * 33], s[5 * 33]); o.w = pk2(s[6 * 33], s[7 * 33]);
        *(u32x4*)(WT + (size_t)(n0 + n) * ldt + k0 + 8 * c) = o; }
    asm volatile("s_waitcnt lgkmcnt(0)" ::: "memory");
}
__device__ __forceinline__ void rownorm_row(const float* __restrict__ x, bf16_t* __restrict__ xb, float* __restrict__ rs, int row, int lane, float* __restrict__ sq4 = nullptr) {
    const f32x4* xr = (const f32x4*)(x + (size_t)row * 1024) + lane;
    f32x4 v[4]; float s = 0.f;
#pragma unroll
    for (int j = 0; j < 4; ++j) { v[j] = xr[64 * j]; s += (v[j].x * v[j].x + v[j].y * v[j].y) + (v[j].z * v[j].z + v[j].w * v[j].w); }
    s = wave_sum(s);
    u32x2* o = (u32x2*)(xb + (size_t)row * 1024) + lane;
#pragma unroll
    for (int j = 0; j < 4; ++j) o[64 * j] = (u32x2){pk2(v[j].x, v[j].y), pk2(v[j].z, v[j].w)};
    if (lane == 0) { rs[row] = 1.0f / sqrtf(s * (1.f / 1024.f) + EPS); if (sq4) *(f32x4*)(sq4 + (size_t)row * 4) = (f32x4){s, 0.f, 0.f, 0.f}; }
}
__device__ __forceinline__ void rownorm_row2(const float* __restrict__ x, bf16_t* __restrict__ xb, float* __restrict__ rs, int row, int lane, float* __restrict__ sq4) {
    const f32x4* xr = (const f32x4*)(x + (size_t)row * 1024) + lane;
    f32x4 v[8]; float s0 = 0.f, s1 = 0.f;
#pragma unroll
    for (int j = 0; j < 8; ++j) v[j] = xr[64 * j];
#pragma unroll
    for (int j = 0; j < 4; ++j) { s0 += (v[j].x * v[j].x + v[j].y * v[j].y) + (v[j].z * v[j].z + v[j].w * v[j].w); s1 += (v[4 + j].x * v[4 + j].x + v[4 + j].y * v[4 + j].y) + (v[4 + j].z * v[4 + j].z + v[4 + j].w * v[4 + j].w); }
#pragma unroll
    for (int o = 1; o < 64; o <<= 1) { s0 += __shfl_xor(s0, o); s1 += __shfl_xor(s1, o); }
    u32x2* ob = (u32x2*)(xb + (size_t)row * 1024) + lane;
#pragma unroll
    for (int j = 0; j < 8; ++j) ob[64 * j] = (u32x2){pk2(v[j].x, v[j].y), pk2(v[j].z, v[j].w)};
    if (lane == 0) { rs[row] = 1.0f / sqrtf(s0 * (1.f / 1024.f) + EPS); rs[row + 1] = 1.0f / sqrtf(s1 * (1.f / 1024.f) + EPS);
        *(f32x4*)(sq4 + (size_t)row * 4) = (f32x4){s0, 0.f, 0.f, 0.f}; *(f32x4*)(sq4 + (size_t)row * 4 + 4) = (f32x4){s1, 0.f, 0.f, 0.f}; }
}
__device__ __forceinline__ void final_norm_row(float* __restrict__ x, const float* __restrict__ g, int row, int lane) {
    f32x4* xr = (f32x4*)(x + (size_t)row * 1024) + lane; const f32x4* gr = (const f32x4*)g + lane;
    f32x4 v[4]; float s = 0.f;
#pragma unroll
    for (int j = 0; j < 4; ++j) { v[j] = xr[64 * j]; s += (v[j].x * v[j].x + v[j].y * v[j].y) + (v[j].z * v[j].z + v[j].w * v[j].w); }
    s = wave_sum(s); const float r = 1.0f / sqrtf(s * (1.f / 1024.f) + EPS);
#pragma unroll
    for (int j = 0; j < 4; ++j) xr[64 * j] = v[j] * r * gr[64 * j];
}

struct EpiA1 {
    const float* rs; bf16_t *U, *ZS, *Q, *Kb, *V, *ZA, *QM, *ZM;
    __device__ __forceinline__ void operator()(int m, int n, f32x4 v) const {
        v = v * rs[m]; bf16_t* dst; bool silu = false; float sc = 1.f;
        if (n < 768) dst = U + (size_t)m * 768 + n;
        else if (n < 1536) { dst = ZS + (size_t)m * 768 + (n - 768); silu = true; }
        else if (n < 2304) { dst = Q + (size_t)m * 768 + (n - 1536); sc = 0.125f; }
        else if (n < 3072) dst = Kb + (size_t)m * 768 + (n - 2304);
        else if (n < 3840) dst = V + (size_t)m * 768 + (n - 3072);
        else if (n < 4608) { dst = ZA + (size_t)m * 768 + (n - 3840); silu = true; }
        else if (n < 5120) { dst = QM + (size_t)m * 512 + (n - 4608); sc = 0.08838834764831845f; }
        else { dst = ZM + (size_t)m * 512 + (n - 5120); silu = true; }
        if (silu) { v.x = siluf_(v.x); v.y = siluf_(v.y); v.z = siluf_(v.z); v.w = siluf_(v.w); }
        v = v * sc;
        *(u32x2*)dst = (u32x2){pk2(v.x, v.y), pk2(v.z, v.w)};
    }
};
struct EpiKvm {
    const float* rs; bf16_t* O;
    __device__ __forceinline__ void operator()(int m, int n, f32x4 v) const { v = v * rs[m]; *(u32x2*)(O + (size_t)m * 1024 + n) = (u32x2){pk2(v.x, v.y), pk2(v.z, v.w)}; }
};
struct EpiGlu {
    const bf16_t* Y; bf16_t* ZS; const float* b;
    __device__ __forceinline__ void operator()(int m, int n, f32x4 v) const {
        const u32x2 y = *(const u32x2*)(Y + (size_t)m * 768 + n); u32x2* zp = (u32x2*)(ZS + (size_t)m * 768 + n); const u32x2 z = *zp; const f32x4 bb = *(const f32x4*)(b + n);
        const float o0 = bflo(y.x) * sigmoidf_(v.x + bb.x) * bflo(z.x), o1 = bfhi(y.x) * sigmoidf_(v.y + bb.y) * bfhi(z.x);
        const float o2 = bflo(y.y) * sigmoidf_(v.z + bb.z) * bflo(z.y), o3 = bfhi(y.y) * sigmoidf_(v.w + bb.w) * bfhi(z.y);
        *zp = (u32x2){pk2(o0, o1), pk2(o2, o3)};
    }
};
struct EpiOut {
    const float* xold; float* xnew;
    __device__ __forceinline__ void operator()(int m, int n, f32x4 v) const { const size_t o = (size_t)m * 1024 + n; *(f32x4*)(xnew + o) = *(const f32x4*)(xold + o) + v; }
};
template <class Epi>
__device__ __forceinline__ void wgemm(const bf16_t* __restrict__ A, int lda, const bf16_t* __restrict__ Bt, int ldb, int M, int N, int K, const Epi& epi, int gw, int ngw, int lane) {
    const int r = lane & 31, hi = lane >> 5; const int ntn = N / 64, ntiles = (M / 64) * ntn;
    for (int tile = gw; tile < ntiles; tile += ngw) {
        const int m0 = (tile / ntn) * 64, n0 = (tile % ntn) * 64;
        f32x16 acc[2][2];
#pragma unroll
        for (int i = 0; i < 2; ++i)
#pragma unroll
            for (int j = 0; j < 2; ++j)
#pragma unroll
                for (int q = 0; q < 16; ++q) acc[i][j][q] = 0.f;
        const bf16_t* ap = A + (size_t)(m0 + r) * lda + 8 * hi;
        const bf16_t* bp = Bt + (size_t)(n0 + r) * ldb + 8 * hi;
        for (int k = 0; k < K; k += 16) {
            const bf16x8 a0 = *(const bf16x8*)(ap + k), a1 = *(const bf16x8*)(ap + (size_t)32 * lda + k);
            const bf16x8 b0 = *(const bf16x8*)(bp + k), b1 = *(const bf16x8*)(bp + (size_t)32 * ldb + k);
            acc[0][0] = __builtin_amdgcn_mfma_f32_32x32x16_bf16(b0, a0, acc[0][0], 0, 0, 0);
            acc[0][1] = __builtin_amdgcn_mfma_f32_32x32x16_bf16(b1, a0, acc[0][1], 0, 0, 0);
            acc[1][0] = __builtin_amdgcn_mfma_f32_32x32x16_bf16(b0, a1, acc[1][0], 0, 0, 0);
            acc[1][1] = __builtin_amdgcn_mfma_f32_32x32x16_bf16(b1, a1, acc[1][1], 0, 0, 0);
        }
#pragma unroll
        for (int mi = 0; mi < 2; ++mi)
#pragma unroll
            for (int ni = 0; ni < 2; ++ni)
#pragma unroll
                for (int q = 0; q < 4; ++q)
                    epi(m0 + 32 * mi + r, n0 + 32 * ni + 8 * q + 4 * hi, (f32x4){acc[mi][ni][4 * q], acc[mi][ni][4 * q + 1], acc[mi][ni][4 * q + 2], acc[mi][ni][4 * q + 3]});
    }
}
__device__ __forceinline__ void merge_ref(const bf16_t* __restrict__ XB, const float* __restrict__ rs, const bf16_t* __restrict__ WinT, const float* __restrict__ bg,
                                          const bf16_t* __restrict__ OS, const bf16_t* __restrict__ OA, const bf16_t* __restrict__ OM,
                                          const bf16_t* __restrict__ W1, const bf16_t* __restrict__ W2, const bf16_t* __restrict__ W3, bf16_t* __restrict__ MG, int gw, int ngw, int lane) {
    const int r = lane & 31, hi = lane >> 5;
    for (int tile = gw; tile < (T / 32) * 32; tile += ngw) {
        const int m0 = (tile >> 5) * 32, n0 = (tile & 31) * 32;
        f32x16 L0, L1, L2, P0, P1, P2;
#pragma unroll
        for (int q = 0; q < 16; ++q) { L0[q] = 0.f; L1[q] = 0.f; L2[q] = 0.f; P0[q] = 0.f; P1[q] = 0.f; P2[q] = 0.f; }
        {
            const bf16_t* ap = XB + (size_t)(m0 + r) * 1024 + 8 * hi; const bf16_t* bp = WinT + (size_t)(N_A1 + n0 + r) * 1024 + 8 * hi;
            for (int k = 0; k < 1024; k += 16) {
                const bf16x8 a = *(const bf16x8*)(ap + k);
                L0 = __builtin_amdgcn_mfma_f32_32x32x16_bf16(*(const bf16x8*)(bp + k), a, L0, 0, 0, 0);
                L1 = __builtin_amdgcn_mfma_f32_32x32x16_bf16(*(const bf16x8*)(bp + (size_t)1024 * 1024 + k), a, L1, 0, 0, 0);
                L2 = __builtin_amdgcn_mfma_f32_32x32x16_bf16(*(const bf16x8*)(bp + (size_t)2048 * 1024 + k), a, L2, 0, 0, 0);
            }
        }
        {
            const bf16_t* ap = OS + (size_t)(m0 + r) * 768 + 8 * hi; const bf16_t* bp = W1 + (size_t)(n0 + r) * 768 + 8 * hi;
            for (int k = 0; k < 768; k += 16) P0 = __builtin_amdgcn_mfma_f32_32x32x16_bf16(*(const bf16x8*)(bp + k), *(const bf16x8*)(ap + k), P0, 0, 0, 0);
        }
        {
            const bf16_t* ap = OA + (size_t)(m0 + r) * 768 + 8 * hi; const bf16_t* bp = W2 + (size_t)(n0 + r) * 768 + 8 * hi;
            for (int k = 0; k < 768; k += 16) P1 = __builtin_amdgcn_mfma_f32_32x32x16_bf16(*(const bf16x8*)(bp + k), *(const bf16x8*)(ap + k), P1, 0, 0, 0);
        }
        {
            const bf16_t* ap = OM + (size_t)(m0 + r) * 512 + 8 * hi; const bf16_t* bp = W3 + (size_t)(n0 + r) * 512 + 8 * hi;
            for (int k = 0; k < 512; k += 16) P2 = __builtin_amdgcn_mfma_f32_32x32x16_bf16(*(const bf16x8*)(bp + k), *(const bf16x8*)(ap + k), P2, 0, 0, 0);
        }
        const int m = m0 + r; const float rsm = rs[m];
#pragma unroll
        for (int q = 0; q < 4; ++q) {
            const int n = n0 + 8 * q + 4 * hi; float o[4];
#pragma unroll
            for (int e = 0; e < 4; ++e) {
                const int rg = 4 * q + e;
                const float g0 = sigmoidf_(rsm * L0[rg] + bg[n + e]), g1 = sigmoidf_(rsm * L1[rg] + bg[1024 + n + e]), g2 = sigmoidf_(rsm * L2[rg] + bg[2048 + n + e]);
                o[e] = g0 * P0[rg] + g1 * P1[rg] + g2 * P2[rg];
            }
            *(u32x2*)(MG + (size_t)m * 1024 + n) = (u32x2){pk2(o[0], o[1]), pk2(o[2], o[3])};
        }
    }
}

__device__ __forceinline__ void ssm_ref(int b, int g, int lane, LAS float* xs, const bf16_t* __restrict__ U, bf16_t* __restrict__ Y, const float* __restrict__ lam_re, const float* __restrict__ lam_im,
                                        const float* __restrict__ log_dt, const float* __restrict__ b_re, const float* __restrict__ b_im,
                                        const float* __restrict__ c_re, const float* __restrict__ c_im, const float* __restrict__ dvec) {
    const float dt = expf(log_dt[g]); const float lre = lam_re[g * 64 + lane], lim = lam_im[g * 64 + lane];
    const float mag = expf(lre * dt); const float ar = mag * cosf(lim * dt), ai = mag * sinf(lim * dt);
    const float den = lre * lre + lim * lim, nr = ar - 1.0f, ni = ai;
    const float fr = (nr * lre + ni * lim) / den, fi = (ni * lre - nr * lim) / den;
    float bbr[16], bbi[16];
#pragma unroll
    for (int h = 0; h < 16; ++h) { const float br = b_re[(g * 64 + lane) * 16 + h], bi = b_im[(g * 64 + lane) * 16 + h]; bbr[h] = fr * br - fi * bi; bbi[h] = fr * bi + fi * br; }
    const int hq = lane & 15, part = lane >> 4;
    float cr[16], ci[16];
#pragma unroll
    for (int i = 0; i < 16; ++i) { cr[i] = c_re[(g * 16 + hq) * 64 + part * 16 + i]; ci[i] = c_im[(g * 16 + hq) * 64 + part * 16 + i]; }
    const float dd = dvec[g * 16 + hq];
    float xr = 0.f, xi = 0.f;
    const bf16_t* up = U + (size_t)b * SEQ * 768 + g * 16; bf16_t* yp = Y + (size_t)b * SEQ * 768 + g * 16;
    for (int t = 0; t < SEQ; ++t) {
        const u32x4 ua = *(const u32x4*)(up + (size_t)t * 768), ub = *(const u32x4*)(up + (size_t)t * 768 + 8);
        const float uh = bf2f(up[(size_t)t * 768 + hq]);
        float u[16];
        u[0] = bflo(ua.x); u[1] = bfhi(ua.x); u[2] = bflo(ua.y); u[3] = bfhi(ua.y); u[4] = bflo(ua.z); u[5] = bfhi(ua.z); u[6] = bflo(ua.w); u[7] = bfhi(ua.w);
        u[8] = bflo(ub.x); u[9] = bfhi(ub.x); u[10] = bflo(ub.y); u[11] = bfhi(ub.y); u[12] = bflo(ub.z); u[13] = bfhi(ub.z); u[14] = bflo(ub.w); u[15] = bfhi(ub.w);
        float bur = 0.f, bui = 0.f;
#pragma unroll
        for (int h = 0; h < 16; ++h) { bur += bbr[h] * u[h]; bui += bbi[h] * u[h]; }
        const float nxr = ar * xr - ai * xi + bur, nxi = ar * xi + ai * xr + bui; xr = nxr; xi = nxi;
        xs[lane] = xr; xs[64 + lane] = xi;
        asm volatile("s_waitcnt lgkmcnt(0)" ::: "memory");
        float acc = 0.f;
#pragma unroll
        for (int i = 0; i < 16; ++i) acc += cr[i] * xs[part * 16 + i] - ci[i] * xs[64 + part * 16 + i];
        acc += __shfl_xor(acc, 16); acc += __shfl_xor(acc, 32);
        asm volatile("s_waitcnt lgkmcnt(0)" ::: "memory");
        if (lane < 16) yp[(size_t)t * 768 + lane] = (bf16_t)f2bf(gelu_tanh(acc + dd * uh));
    }
}

__device__ __forceinline__ int rel_bucket(int n) {
    if (n < 16) return n;
    const float v = logf((float)n / 16.0f) / 4.852030263919617f * 16.0f;
    const int lg = 16 + (int)v; return lg < 31 ? lg : 31;
}
__device__ __forceinline__ float dot8(const u32x4 a, const u32x4 b) {
    return bflo(a.x) * bflo(b.x) + bfhi(a.x) * bfhi(b.x) + bflo(a.y) * bflo(b.y) + bfhi(a.y) * bfhi(b.y) + bflo(a.z) * bflo(b.z) + bfhi(a.z) * bfhi(b.z) + bflo(a.w) * bflo(b.w) + bfhi(a.w) * bfhi(b.w);
}
__device__ __forceinline__ void attn_ref(bf16_t* Q, const bf16_t* __restrict__ Kb, const bf16_t* __restrict__ V, const float* __restrict__ rel_bias, float* __restrict__ lse, int gw, int ngw, int lane) {
    for (int item = gw; item < T * NH; item += ngw) {
        const int head = item % NH, tok = item / NH, t = tok % SEQ, row0 = tok - t;
        const int grp = head >> 2, r = grp == 0 ? 1 : (grp == 1 ? 4 : 16);
        bf16_t* qp = Q + (size_t)tok * 768 + head * 64;
        u32x4 qv[8];
#pragma unroll
        for (int i = 0; i < 8; ++i) qv[i] = ((const u32x4*)qp)[i];
        float s[3]; bool ok[3];
#pragma unroll
        for (int sl = 0; sl < 3; ++sl) {
            const int j = sl * 64 + lane, p = t - j * r; ok[sl] = (j <= 128) && (p >= 0); s[sl] = -1e30f;
            if (ok[sl]) {
                const u32x4* kp = (const u32x4*)(Kb + (size_t)(row0 + p) * 768 + head * 64); float d = 0.f;
#pragma unroll
                for (int i = 0; i < 8; ++i) d += dot8(qv[i], kp[i]);
                s[sl] = d + rel_bias[rel_bucket(j * r) * NH + head];
            }
        }
        const float m = wave_max(fmaxf(fmaxf(s[0], s[1]), s[2]));
        float e[3];
#pragma unroll
        for (int sl = 0; sl < 3; ++sl) e[sl] = ok[sl] ? __expf(s[sl] - m) : 0.f;
        const float l = wave_sum(e[0] + e[1] + e[2]);
        float o = 0.f;
#pragma unroll
        for (int sl = 0; sl < 3; ++sl) {
            for (int jj = 0; jj < 64; ++jj) {
                const int j = sl * 64 + jj, p = t - j * r; if (j > 128 || p < 0) break;
                const float pj = __shfl(e[sl], jj);
                o += pj * bf2f(V[(size_t)(row0 + p) * 768 + head * 64 + lane]);
            }
        }
        qp[lane] = (bf16_t)f2bf(o / l);
        if (lane == 0) lse[(size_t)tok * NH + head] = m + logf(l);
    }
}
__device__ __forceinline__ void attn_final_pair(bf16_t* __restrict__ Q, const float* __restrict__ lse, const bf16_t* __restrict__ ZA, int tok0, int lane) {
    u32x4 o[3], z[3]; float l0[3], l1[3], l2[3]; int off[3], hd[3];
#pragma unroll
    for (int j = 0; j < 3; ++j) { const int ci = lane + 64 * j, tl = ci >= 96 ? 1 : 0, c8 = (ci - 96 * tl) * 8; hd[j] = c8 >> 6; off[j] = (tok0 + tl) * 768 + c8;
        o[j] = *(const u32x4*)(Q + off[j]); z[j] = *(const u32x4*)(ZA + off[j]); const float* lp = lse + (size_t)(tok0 + tl) * NH + (hd[j] & 3); l0[j] = lp[0]; l1[j] = lp[4]; l2[j] = lp[8]; }
#pragma unroll
    for (int j = 0; j < 3; ++j) {
        const float mx = fmaxf(fmaxf(l0[j], l1[j]), l2[j]); const float e0 = __expf(l0[j] - mx), e1 = __expf(l1[j] - mx), e2 = __expf(l2[j] - mx);
        const float mine = hd[j] < 4 ? e0 : (hd[j] < 8 ? e1 : e2); const float al = mine / (e0 + e1 + e2);
        *(u32x4*)(Q + off[j]) = (u32x4){pk2(bflo(o[j].x) * al * bflo(z[j].x), bfhi(o[j].x) * al * bfhi(z[j].x)), pk2(bflo(o[j].y) * al * bflo(z[j].y), bfhi(o[j].y) * al * bfhi(z[j].y)),
                                        pk2(bflo(o[j].z) * al * bflo(z[j].z), bfhi(o[j].z) * al * bfhi(z[j].z)), pk2(bflo(o[j].w) * al * bflo(z[j].w), bfhi(o[j].w) * al * bfhi(z[j].w))};
    }
}
__device__ __forceinline__ void memattn_ref(bf16_t* QM, const bf16_t* __restrict__ KVM, const bf16_t* __restrict__ ZM, int gw, int ngw, int lane) {
    for (int item = gw; item < T * MH; item += ngw) {
        const int head = item & 3, tok = item >> 2, b = tok / SEQ;
        bf16_t* qp = QM + (size_t)tok * 512 + head * 128;
        u32x4 qv[16];
#pragma unroll
        for (int i = 0; i < 16; ++i) qv[i] = ((const u32x4*)qp)[i];
        float s[4];
#pragma unroll
        for (int sl = 0; sl < 4; ++sl) {
            const int j = sl * 64 + lane; const u32x4* kp = (const u32x4*)(KVM + (size_t)(b * 256 + j) * 1024 + head * 128); float d = 0.f;
#pragma unroll
            for (int i = 0; i < 16; ++i) d += dot8(qv[i], kp[i]);
            s[sl] = d;
        }
        const float m = wave_max(fmaxf(fmaxf(s[0], s[1]), fmaxf(s[2], s[3])));
        float e[4];
#pragma unroll
        for (int sl = 0; sl < 4; ++sl) e[sl] = __expf(s[sl] - m);
        const float l = wave_sum((e[0] + e[1]) + (e[2] + e[3]));
        float o0 = 0.f, o1 = 0.f;
#pragma unroll
        for (int sl = 0; sl < 4; ++sl)
            for (int jj = 0; jj < 64; ++jj) {
                const int j = sl * 64 + jj; const float pj = __shfl(e[sl], jj);
                const bf16_t* vp = KVM + (size_t)(b * 256 + j) * 1024 + 512 + head * 128;
                o0 += pj * bf2f(vp[lane]); o1 += pj * bf2f(vp[64 + lane]);
            }
        const bf16_t* zp = ZM + (size_t)tok * 512 + head * 128;
        qp[lane] = (bf16_t)f2bf(o0 / l * bf2f(zp[lane])); qp[64 + lane] = (bf16_t)f2bf(o1 / l * bf2f(zp[64 + lane]));
    }
}

constexpr size_t OFF_ROWSQ = 3 * MiB + 512 * 1024;
constexpr size_t TAB_TOEP = 0, TAB_CST = 2 * MiB, TAB_WST = 8 * MiB, TAB_AQ = 15 * MiB;
__device__ __forceinline__ int fresh_tid() { int t = threadIdx.x; asm volatile("" : "+v"(t)); return t; }
__device__ __forceinline__ unsigned char* fresh_ptr(unsigned char* p) { asm volatile("" : "+s"(p)); return (unsigned char*)(GAS unsigned char*)p; }
__device__ __forceinline__ int fresh_bid() { int b = blockIdx.x; asm volatile("" : "+s"(b)); return b; }
__device__ __forceinline__ float load_rs(GAS unsigned char* ws, int, int tr) {
    const f32x4 p = ((const GAS f32x4*)(ws + OFF_ROWSQ))[tr]; return __builtin_amdgcn_rsqf(((p.x + p.y) + (p.z + p.w)) * (1.f / 1024.f) + EPS);
}
__device__ __forceinline__ void load_rs8(GAS unsigned char* ws, int row0, int wr, int fr, float (&r8)[8]) {
    f32x4 p[8];
#pragma unroll
    for (int i = 0; i < 8; ++i) p[i] = ((const GAS f32x4*)(ws + OFF_ROWSQ))[row0 + (i >> 2) * 128 + wr * 64 + (i & 3) * 16 + fr];
#pragma unroll
    for (int i = 0; i < 8; ++i) r8[i] = __builtin_amdgcn_rsqf(((p[i].x + p[i].y) + (p[i].z + p[i].w)) * (1.f / 1024.f) + EPS);
}
namespace ge {
constexpr int BM = 256, BK = 64, HALF = 128, HTB = HALF * BK * 2, STAGE_BYTES = 8 * HTB;
__device__ __forceinline__ int lds_byte(int r, int c) { const int st = (r >> 4) * 2 + (c >> 5), rr = r & 15, cc = c & 31, ob = rr * 64 + cc * 2; return st * 1024 + (ob ^ (((ob >> 9) & 1) << 5)); }
__device__ __forceinline__ void stage_rc(int b, int& R, int& C) { const int st = b / 1024, sb = b % 1024, swz = sb ^ (((sb >> 9) & 1) << 5); R = (st >> 1) * 16 + swz / 64; C = (st & 1) * 32 + (swz % 64) / 2; }
__device__ __forceinline__ int perm32(int rho) { const int n = rho >> 4, i = rho & 15; return 8 * (i >> 2) + 4 * n + (i & 3); }
enum { A_STD = 0, A_GM = 1 };
enum { B_STD = 0, B_PERM = 1, B_TOEP = 2 };
struct Seg { const char* A; const char* B; int a_h, b_h, a_k, b_k, npairs, amode, bmode; unsigned lda2, ldb2; };
struct Unit { int type, pm, pn, g; };
typedef f32x4 Acc[2][2][4][2];

template <class Sched, class Epi>
__device__ __forceinline__ void gemm_run(LAS unsigned char* lds, const Sched& S, const Epi& E) {
    const int tid = fresh_tid(), wid = __builtin_amdgcn_readfirstlane(tid >> 6), lane = tid & 63, wr = wid >> 2, wc = wid & 3, fr = lane & 15, fq = lane >> 4;
    const unsigned ldsw = (unsigned)wid * 1024u;
    const int aoff = lds_byte(wr * 64 + fr, fq * 8), boff = lds_byte(wc * 32 + fr, fq * 8);
#define GE_SA(b, h) (((b) * 2 + (h)) * HTB)
#define GE_SB(b, h) ((4 + (b) * 2 + (h)) * HTB)
#define GE_STAGE(bufoff, gbase, voff) do { _Pragma("unroll") for (int _i = 0; _i < 2; ++_i) \
        __builtin_amdgcn_global_load_lds((const unsigned*)((const char*)(gbase) + (voff)[_i]), (LAS unsigned*)(lds + (bufoff) + ldsw + _i * 8192), 16, 0, 0); } while (0)
#define GE_LDA(dst, b, h) do { _Pragma("unroll") for (int m = 0; m < 4; ++m) _Pragma("unroll") for (int k = 0; k < 2; ++k) dst[m][k] = *(const LAS bf16x8*)(lds + GE_SA(b, h) + aoff + m * 2048 + k * 1024); } while (0)
#define GE_LDB(dst, b, h) do { _Pragma("unroll") for (int n = 0; n < 2; ++n) _Pragma("unroll") for (int k = 0; k < 2; ++k) dst[n][k] = *(const LAS bf16x8*)(lds + GE_SB(b, h) + boff + n * 2048 + k * 1024); } while (0)
#define GE_MMA(ai, bj, At, Bt) do { __builtin_amdgcn_s_setprio(1); _Pragma("unroll") for (int m = 0; m < 4; ++m) _Pragma("unroll") for (int n = 0; n < 2; ++n) _Pragma("unroll") for (int k = 0; k < 2; ++k) \
        acc[ai][bj][m][n] = __builtin_amdgcn_mfma_f32_16x16x32_bf16(Bt[n][k], At[m][k], acc[ai][bj][m][n], 0, 0, 0); __builtin_amdgcn_s_setprio(0); } while (0)
#define GE_WAIT_V(n) asm volatile("s_waitcnt vmcnt(" #n ")" ::: "memory")
#define GE_WAIT_L(n) asm volatile("s_waitcnt lgkmcnt(" #n ")" ::: "memory")
#define GE_BAR __builtin_amdgcn_s_barrier()
#define GE_SCHED __builtin_amdgcn_sched_barrier(0)
#define GE_VOFFS(sg, va, vb) do { _Pragma("unroll") for (int _i = 0; _i < 2; ++_i) { int R_, C_; stage_rc(tid * 16 + _i * 8192, R_, C_); const int Rp_ = (R_ & ~31) + perm32(R_ & 31); \
        va[_i] = (sg).amode == A_GM ? (unsigned)((R_ >> 5) * 1280 + (R_ & 31) * 32 + (C_ >> 4) * (1024 * 1280) + (C_ & 15) * 2) : (unsigned)R_ * (sg).lda2 + (unsigned)(C_ * 2); \
        vb[_i] = (sg).bmode == B_TOEP ? (unsigned)((((Rp_ >> 4) - (C_ >> 4) + 3) * 256 + (Rp_ & 15) * 16 + (C_ & 15)) * 2) : (unsigned)((sg).bmode == B_PERM ? Rp_ : R_) * (sg).ldb2 + (unsigned)(C_ * 2); } } while (0)
    Unit nu; int nui = 0;
    if (!S.unit(0, nu)) return;
    Seg ns; int nsi = 0, npi = 0; S.seg(nu, 0, ns);
    const char* npa = ns.A; const char* npb = ns.B; unsigned nva[2], nvb[2]; GE_VOFFS(ns, nva, nvb);
    bool nreal = true;
    Unit cu; int csi; bool c_lastseg, c_lastunit; const char* c_a1h; unsigned cva[2];
#define GE_ADVANCE() do { ++npi; if (npi < ns.npairs) { npa += 2 * ns.a_k; npb += 2 * ns.b_k; } else { npi = 0; ++nsi; \
        if (nsi >= S.nseg(nu)) { nsi = 0; Unit tu; if (S.unit(nui + 1, tu)) { ++nui; nu = tu; } else nreal = false; } \
        S.seg(nu, nsi, ns); npa = ns.A; npb = ns.B; GE_VOFFS(ns, nva, nvb); } } while (0)
#define GE_SHIFT() do { cu = nu; csi = nsi; c_lastseg = (npi == ns.npairs - 1); c_lastunit = c_lastseg && (nsi == S.nseg(nu) - 1); \
        c_a1h = npa + ns.a_k + ns.a_h; cva[0] = nva[0]; cva[1] = nva[1]; GE_ADVANCE(); } while (0)
    Acc acc;
#pragma unroll
    for (int a = 0; a < 2; ++a)
#pragma unroll
        for (int b = 0; b < 2; ++b)
#pragma unroll
            for (int m = 0; m < 4; ++m)
#pragma unroll
                for (int n = 0; n < 2; ++n) acc[a][b][m][n] = (f32x4){0.f, 0.f, 0.f, 0.f};
    bf16x8 At[4][2], B0[2][2], B1[2][2];
    GE_STAGE(GE_SB(0, 0), npb, nvb); GE_STAGE(GE_SB(0, 1), npb + ns.b_h, nvb); GE_STAGE(GE_SA(0, 0), npa, nva); GE_STAGE(GE_SA(0, 1), npa + ns.a_h, nva);
    if (wr == 1) GE_BAR;
    GE_WAIT_V(2); GE_BAR;
    GE_STAGE(GE_SB(1, 0), npb + ns.b_k, nvb); GE_STAGE(GE_SA(1, 0), npa + ns.a_k, nva); GE_STAGE(GE_SB(1, 1), npb + ns.b_k + ns.b_h, nvb);
    GE_WAIT_V(6); GE_BAR;
    GE_SHIFT();
    for (;;) {
        GE_LDB(B0, 0, 0); GE_LDB(B1, 0, 1); GE_SCHED; GE_LDA(At, 0, 0); GE_STAGE(GE_SA(1, 1), c_a1h, cva);
        GE_WAIT_V(8); GE_WAIT_L(0); GE_BAR; GE_MMA(0, 0, At, B0); GE_MMA(0, 1, At, B1); GE_BAR; GE_SCHED;
        GE_LDA(At, 0, 1); GE_STAGE(GE_SB(0, 0), npb, nvb); GE_STAGE(GE_SB(0, 1), npb + ns.b_h, nvb); GE_STAGE(GE_SA(0, 0), npa, nva);
        GE_WAIT_V(8); GE_WAIT_L(0); GE_BAR; GE_MMA(1, 0, At, B0); GE_MMA(1, 1, At, B1); GE_BAR; GE_SCHED;
        GE_LDB(B0, 1, 0); GE_LDB(B1, 1, 1); GE_SCHED; GE_LDA(At, 1, 0); GE_STAGE(GE_SA(0, 1), npa + ns.a_h, nva);
        GE_WAIT_V(8); GE_WAIT_L(0); GE_BAR; GE_MMA(0, 0, At, B0); GE_MMA(0, 1, At, B1); GE_BAR; GE_SCHED;
        GE_LDA(At, 1, 1); GE_STAGE(GE_SB(1, 0), npb + ns.b_k, nvb); GE_STAGE(GE_SB(1, 1), npb + ns.b_k + ns.b_h, nvb); GE_STAGE(GE_SA(1, 0), npa + ns.a_k, nva);
        GE_WAIT_V(8); GE_WAIT_L(0); GE_BAR; GE_MMA(1, 0, At, B0); GE_MMA(1, 1, At, B1); GE_BAR; GE_SCHED;
        if (c_lastunit) {
            if (wr == 0) GE_BAR;
            { int fr_ = fr, fq_ = fq; asm volatile("" : "+v"(fr_), "+v"(fq_)); E.finish(acc, cu, wr, wc, fr_, fq_); }
            if (!nreal) break;
#pragma unroll
            for (int a = 0; a < 2; ++a)
#pragma unroll
                for (int b = 0; b < 2; ++b)
#pragma unroll
                    for (int m = 0; m < 4; ++m)
#pragma unroll
                        for (int n = 0; n < 2; ++n) acc[a][b][m][n] = (f32x4){0.f, 0.f, 0.f, 0.f};
            if (wr == 1) GE_BAR;
        } else if (c_lastseg) {
            { int fr_ = fr, fq_ = fq; asm volatile("" : "+v"(fr_), "+v"(fq_)); E.seg_end(acc, cu, csi, wr, wc, fr_, fq_); }
        }
        GE_SHIFT();
    }
    GE_WAIT_V(0);
    GE_BAR;
    { int fr_ = fr, fq_ = fq; asm volatile("" : "+v"(fr_), "+v"(fq_)); E.after_drain(acc, cu, lds, wr, wc, fr_, fq_); }
#undef GE_SA
#undef GE_SB
#undef GE_STAGE
#undef GE_LDA
#undef GE_LDB
#undef GE_MMA
#undef GE_WAIT_V
#undef GE_WAIT_L
#undef GE_BAR
#undef GE_SCHED
#undef GE_VOFFS
#undef GE_ADVANCE
#undef GE_SHIFT
}
__device__ __forceinline__ bool static_tile(int i, int G, int c, int nM, int nN, int& pm, int& pn) {
    const int nwg = nM * nN; const long L = (long)i * G + c; if (L >= nwg) return false;
    int wgid = (int)L; { const int q = nwg / 8, r = nwg % 8, xcd = wgid % 8, off = wgid / 8; wgid = (xcd < r ? xcd * (q + 1) : r * (q + 1) + (xcd - r) * q) + off; }
    const int nig = 8 * nN, gid = wgid / nig, fm = gid * 8, gsz = (nM - fm) < 8 ? (nM - fm) : 8;
    pm = fm + ((wgid % nig) % gsz); pn = (wgid % nig) / gsz; return true;
}
__device__ __forceinline__ unsigned cvt_pk_bf16(float lo, float hi) { unsigned r; asm volatile("v_cvt_pk_bf16_f32 %0, %1, %2" : "=v"(r) : "v"(lo), "v"(hi)); return r; }
__device__ __forceinline__ u32x4 pack8(const f32x4 a, const f32x4 b) { u32x4 w; w.x = cvt_pk_bf16(a[0], a[1]); w.y = cvt_pk_bf16(a[2], a[3]); w.z = cvt_pk_bf16(b[0], b[1]); w.w = cvt_pk_bf16(b[2], b[3]); return w; }
__device__ __forceinline__ void unpack8(const u32x4 w, f32x4& a, f32x4& b) { a = (f32x4){bflo(w.x), bfhi(w.x), bflo(w.y), bfhi(w.y)}; b = (f32x4){bflo(w.z), bfhi(w.z), bflo(w.w), bfhi(w.w)}; }
__device__ __forceinline__ float fsigm(float x) { return __builtin_amdgcn_rcpf(1.f + __builtin_amdgcn_exp2f(-1.4426950408889634f * x)); }
__device__ __forceinline__ float fgelu(float y) { return y * fsigm(1.5957691216057308f * (y + 0.044715f * y * y * y)); }
__device__ __forceinline__ f32x4 silu4(f32x4 v) { return (f32x4){v[0] * fsigm(v[0]), v[1] * fsigm(v[1]), v[2] * fsigm(v[2]), v[3] * fsigm(v[3])}; }
__device__ __forceinline__ f32x4 sigm4(f32x4 v) { return (f32x4){fsigm(v[0]), fsigm(v[1]), fsigm(v[2]), fsigm(v[3])}; }
__device__ __forceinline__ f32x4 gelu4(f32x4 v) { return (f32x4){fgelu(v[0]), fgelu(v[1]), fgelu(v[2]), fgelu(v[3])}; }
#define GE_FOR_PERM(...) _Pragma("unroll") for (int ai = 0; ai < 2; ++ai) _Pragma("unroll") for (int m = 0; m < 4; ++m) _Pragma("unroll") for (int bj = 0; bj < 2; ++bj) { \
        const int row = ai * HALF + wr * 64 + m * 16 + fr, col8 = bj * HALF + wc * 32 + 8 * fq; __VA_ARGS__ }

struct PA_Sched {
    int G, c; const unsigned char *ws, *wl;
    __device__ __forceinline__ bool unit(int i, Unit& u) const {
        constexpr int nwg = (T / 256) * (N_A1 / 256); const int nA = c < nwg ? (nwg - c + G - 1) / G : 0;
        if (i < nA) { u.type = 0; u.g = 0; return static_tile(i, G, c, T / 256, N_A1 / 256, u.pm, u.pn); }
        if (i == nA && c < 16) { u.type = 1; u.pm = c >> 2; u.pn = c & 3; u.g = 0; return true; }
        return false;
    }
    __device__ __forceinline__ int nseg(const Unit&) const { return 1; }
    __device__ __forceinline__ void seg(const Unit& u, int, Seg& s) const {
        s.A = (const char*)(ws + (u.type == 0 ? OFF_XB : OFF_MEMB)) + (size_t)u.pm * 256 * 2048; s.B = (const char*)(wl + (u.type == 0 ? WO_IN : WO_MKV)) + (size_t)u.pn * 256 * 2048;
        s.a_h = 128 * 2048; s.b_h = 128 * 2048; s.a_k = 128; s.b_k = 128; s.npairs = 8; s.amode = A_STD; s.bmode = B_PERM; s.lda2 = 2048; s.ldb2 = 2048;
    }
};
struct PA_Epi {
    GAS unsigned char* ws; int l;
    __device__ __forceinline__ void seg_end(Acc&, const Unit&, int, int, int, int, int) const {}
    __device__ __forceinline__ void after_drain(Acc&, const Unit&, LAS unsigned char*, int, int, int, int) const {}
    __device__ __forceinline__ void finish(Acc& acc, const Unit& u, int wr, int wc, int fr, int fq) const {
        const int pn = u.pn;
        float r8[8];
        if (u.type == 1) {
#pragma unroll
            for (int i = 0; i < 8; ++i) r8[i] = ((const GAS float*)(ws + OFF_RSMEM))[u.pm * 256 + (i >> 2) * HALF + wr * 64 + (i & 3) * 16 + fr];
        } else {
            load_rs8(ws, u.pm * 256, wr, fr, r8);
        }
        if (u.type == 1) {
            auto KVM = (GAS bf16_t*)(ws + OFF_KVM + (size_t)l * 2 * MiB);
            GE_FOR_PERM({ const int tr = u.pm * 256 + row; const float r = r8[ai * 4 + m]; *(GAS u32x4*)(KVM + (size_t)tr * 1024 + pn * 256 + col8) = pack8(acc[ai][bj][m][0] * r, acc[ai][bj][m][1] * r); })
            return;
        }
        if (pn < 3) {
            auto U = (GAS bf16_t*)(ws + OFF_U);
            GE_FOR_PERM({ const int tr = u.pm * 256 + row; const float r = r8[ai * 4 + m]; const int c = pn * 256 + col8;
                *(GAS u32x4*)(U + ((size_t)(c >> 4) * 1024 + (tr >> 5)) * 640 + (tr & 31) * 16 + (c & 15)) = pack8(acc[ai][bj][m][0] * r, acc[ai][bj][m][1] * r); })
        } else if (pn < 18) {
            const int k = (pn - 3) / 3; const size_t off = k == 0 ? OFF_ZS : (k == 1 ? OFF_Q : (k == 2 ? OFF_K : (k == 3 ? OFF_V : OFF_ZA)));
            auto D = (GAS bf16_t*)(ws + off); const bool silu = (k == 0 || k == 4); const float sc = k == 1 ? 0.125f * 1.4426950408889634f : 1.0f;
            const int cb = (pn - 3 - 3 * k) * 256;
            if (silu) { GE_FOR_PERM({ const int tr = u.pm * 256 + row; const float r = r8[ai * 4 + m]; *(GAS u32x4*)(D + (size_t)tr * 768 + cb + col8) = pack8(silu4(acc[ai][bj][m][0] * r), silu4(acc[ai][bj][m][1] * r)); }) }
            else { GE_FOR_PERM({ const int tr = u.pm * 256 + row; const float r = r8[ai * 4 + m] * sc; *(GAS u32x4*)(D + (size_t)tr * 768 + cb + col8) = pack8(acc[ai][bj][m][0] * r, acc[ai][bj][m][1] * r); }) }
        } else {
            const bool isz = pn >= 20; auto D = (GAS bf16_t*)(ws + (isz ? OFF_ZM : OFF_QM)); const int cb = (pn - (isz ? 20 : 18)) * 256; const float sc = isz ? 1.0f : 0.08838834764831845f * 1.4426950408889634f;
            if (isz) { GE_FOR_PERM({ const int tr = u.pm * 256 + row; const float r = r8[ai * 4 + m]; *(GAS u32x4*)(D + (size_t)tr * 512 + cb + col8) = pack8(silu4(acc[ai][bj][m][0] * r), silu4(acc[ai][bj][m][1] * r)); }) }
            else { GE_FOR_PERM({ const int tr = u.pm * 256 + row; const float r = r8[ai * 4 + m] * sc; *(GAS u32x4*)(D + (size_t)tr * 512 + cb + col8) = pack8(acc[ai][bj][m][0] * r, acc[ai][bj][m][1] * r); }) }
        }
    }
};
struct PS_Sched {
    int c; const unsigned char* ws;
    __device__ __forceinline__ bool unit(int i, Unit& u) const { if (i != 0 || c >= BATCH * NG) return false; u.type = 0; u.g = c % NG; u.pm = c / NG; u.pn = 0; return true; }
    __device__ __forceinline__ int nseg(const Unit&) const { return 1; }
    __device__ __forceinline__ void seg(const Unit& u, int, Seg& s) const {
        s.A = (const char*)((const bf16_t*)(ws + OFF_U) + ((size_t)u.g * 1024 + u.pm * 256) * 640); s.B = (const char*)((const bf16_t*)(ws + OFF_TAB + TAB_WST) + (size_t)u.g * 128 * 512);
        s.a_h = 128 * 1280; s.b_h = 128 * 1024; s.a_k = 128; s.b_k = 128; s.npairs = 4; s.amode = A_STD; s.bmode = B_STD; s.lda2 = 1280; s.ldb2 = 1024;
    }
};
struct PS_Epi {
    GAS unsigned char* ws;
    __device__ __forceinline__ void seg_end(Acc&, const Unit&, int, int, int, int, int) const {}
    __device__ __forceinline__ void finish(Acc&, const Unit&, int, int, int, int) const {}
    __device__ __forceinline__ void after_drain(Acc& acc, const Unit& u, LAS unsigned char* lds, int wr, int wc, int fr, int fq) const {
        LAS float* Sl = (LAS float*)lds;
#pragma unroll
        for (int ai = 0; ai < 2; ++ai)
#pragma unroll
            for (int m = 0; m < 4; ++m)
#pragma unroll
                for (int n = 0; n < 2; ++n) *(LAS f32x4*)(Sl + (ai * HALF + wr * 64 + m * 16 + fr) * 128 + wc * 32 + 16 * n + 4 * fq) = acc[ai][0][m][n];
        asm volatile("s_waitcnt lgkmcnt(0)" ::: "memory"); __builtin_amdgcn_s_barrier(); asm volatile("" ::: "memory");
        if (wr * 4 + wc == 0) {
            auto AQ = (const GAS float*)(ws + OFF_TAB + TAB_AQ); const int p = fq * 16 + fr; const float ar = AQ[(u.g * 64 + p) * 2], ai_ = AQ[(u.g * 64 + p) * 2 + 1];
            float xr = 0.f, xi = 0.f; auto up = (GAS bf16_t*)(ws + OFF_U) + ((size_t)u.g * 1024 + u.pm * 256) * 640 + 512 + p;
            for (int c0 = 0; c0 < 256; c0 += 8) {
                float sr[8], si[8];
#pragma unroll
                for (int j = 0; j < 8; ++j) { sr[j] = Sl[(c0 + j) * 128 + p]; si[j] = Sl[(c0 + j) * 128 + 64 + p]; }
#pragma unroll
                for (int j = 0; j < 8; ++j) {
                    up[(size_t)(c0 + j) * 640] = (bf16_t)f2bf(xr); up[(size_t)(c0 + j) * 640 + 64] = (bf16_t)f2bf(xi);
                    const float nxr = ar * xr - ai_ * xi + sr[j], nxi = ar * xi + ai_ * xr + si[j]; xr = nxr; xi = nxi;
                }
            }
        }
    }
};
struct PY_Sched {
    int c; const unsigned char* ws;
    __device__ __forceinline__ bool unit(int i, Unit& u) const { if (i > 1 || c >= BATCH * NG) return false; u.type = 0; u.pn = 1 - i; u.g = c % NG; u.pm = c / NG; return true; }
    __device__ __forceinline__ int nseg(const Unit&) const { return 2; }
    __device__ __forceinline__ void seg(const Unit& u, int si, Seg& s) const {
        const char* Arow = (const char*)((const bf16_t*)(ws + OFF_U) + ((size_t)u.g * 1024 + u.pm * 256) * 640);
        s.a_h = 128 * 1280; s.a_k = 128; s.amode = A_STD; s.lda2 = 1280;
        if (si == 0) { s.A = Arow; s.B = (const char*)((const bf16_t*)(ws + OFF_TAB + TAB_TOEP) + (size_t)u.g * 48 * 256) + (16 * u.pn + 13) * 512; s.b_h = 8 * 512; s.b_k = -2048; s.npairs = 2 * (u.pn + 1); s.bmode = B_TOEP; s.ldb2 = 0; }
        else { s.A = Arow + 1024; s.B = (const char*)((const bf16_t*)(ws + OFF_TAB + TAB_CST) + ((size_t)u.g * 512 + u.pn * 256) * 128); s.b_h = 128 * 256; s.b_k = 128; s.npairs = 1; s.bmode = B_PERM; s.ldb2 = 256; }
    }
};
struct PY_Epi {
    GAS unsigned char* ws;
    __device__ __forceinline__ void seg_end(Acc&, const Unit&, int, int, int, int, int) const {}
    __device__ __forceinline__ void after_drain(Acc&, const Unit&, LAS unsigned char*, int, int, int, int) const {}
    __device__ __forceinline__ void finish(Acc& acc, const Unit& u, int wr, int wc, int fr, int fq) const {
        auto base = (GAS bf16_t*)(ws + OFF_U) + ((size_t)u.g * 1024 + u.pm * 256) * 640 + u.pn * 256;
        GE_FOR_PERM({ *(GAS u32x4*)(base + (size_t)row * 640 + col8) = pack8(gelu4(acc[ai][bj][m][0]), gelu4(acc[ai][bj][m][1])); })
    }
};
struct PG_Sched {
    int G, c; const unsigned char *ws, *wl;
    __device__ __forceinline__ bool unit(int i, Unit& u) const { u.type = 0; u.g = 0; return static_tile(i, G, c, T / 256, 3, u.pm, u.pn); }
    __device__ __forceinline__ int nseg(const Unit&) const { return 1; }
    __device__ __forceinline__ void seg(const Unit& u, int, Seg& s) const {
        s.A = (const char*)(ws + OFF_U) + (size_t)u.pm * 8 * 1280; s.B = (const char*)(wl + WO_GLU) + (size_t)u.pn * 256 * 1536;
        s.a_h = 4 * 1280; s.a_k = 4 * 1024 * 1280; s.amode = A_GM; s.lda2 = 0; s.b_h = 128 * 1536; s.b_k = 128; s.bmode = B_PERM; s.ldb2 = 1536; s.npairs = 6;
    }
};
struct PG_Epi {
    GAS unsigned char* ws; const GAS float* b;
    __device__ __forceinline__ void seg_end(Acc&, const Unit&, int, int, int, int, int) const {}
    __device__ __forceinline__ void after_drain(Acc&, const Unit&, LAS unsigned char*, int, int, int, int) const {}
    __device__ __forceinline__ void finish(Acc& acc, const Unit& u, int wr, int wc, int fr, int fq) const {
        auto Y = (const GAS bf16_t*)(ws + OFF_U); auto ZS = (GAS bf16_t*)(ws + OFF_ZS);
        f32x4 bb[2][2];
#pragma unroll
        for (int j = 0; j < 2; ++j) { const int c = u.pn * 256 + j * HALF + wc * 32 + 8 * fq; bb[j][0] = *(const GAS f32x4*)(b + c); bb[j][1] = *(const GAS f32x4*)(b + c + 4); }
#pragma unroll
        for (int ai = 0; ai < 2; ++ai)
#pragma unroll
            for (int bj = 0; bj < 2; ++bj) {
                u32x4 yv[4], zv[4]; const int c = u.pn * 256 + bj * HALF + wc * 32 + 8 * fq;
#pragma unroll
                for (int m = 0; m < 4; ++m) { const int tr = u.pm * 256 + ai * HALF + wr * 64 + m * 16 + fr;
                    yv[m] = *(const GAS u32x4*)(Y + ((size_t)(c >> 4) * 1024 + (tr >> 5)) * 640 + (tr & 31) * 16 + (c & 15)); zv[m] = *(const GAS u32x4*)(ZS + (size_t)tr * 768 + c); }
#pragma unroll
                for (int m = 0; m < 4; ++m) { const int tr = u.pm * 256 + ai * HALF + wr * 64 + m * 16 + fr; f32x4 y0, y1, z0, z1; unpack8(yv[m], y0, y1); unpack8(zv[m], z0, z1);
                    *(GAS u32x4*)(ZS + (size_t)tr * 768 + c) = pack8(y0 * sigm4(acc[ai][bj][m][0] + bb[bj][0]) * z0, y1 * sigm4(acc[ai][bj][m][1] + bb[bj][1]) * z1); }
            }
    }
};
struct PM_Sched {
    int G, c; const unsigned char *ws, *wl;
    __device__ __forceinline__ bool unit(int i, Unit& u) const { const int t = i / 6; u.type = i - 6 * t; u.g = 0; return static_tile(t, G, c, T / 256, 4, u.pm, u.pn); }
    __device__ __forceinline__ int nseg(const Unit&) const { return 1; }
    __device__ __forceinline__ void seg(const Unit& u, int, Seg& s) const {
        s.a_k = 128; s.b_k = 128; s.amode = A_STD; s.bmode = B_PERM;
        if ((u.type & 1) == 0) { s.A = (const char*)(ws + OFF_XB) + (size_t)u.pm * 256 * 2048; s.B = (const char*)(wl + WO_IN) + (size_t)(N_A1 + (u.type >> 1) * 1024 + u.pn * 256) * 2048; s.lda2 = 2048; s.ldb2 = 2048; s.npairs = 8; }
        else if (u.type == 1) { s.A = (const char*)(ws + OFF_ZS) + (size_t)u.pm * 256 * 1536; s.B = (const char*)(wl + WO_B1) + (size_t)u.pn * 256 * 1536; s.lda2 = 1536; s.ldb2 = 1536; s.npairs = 6; }
        else if (u.type == 3) { s.A = (const char*)(ws + OFF_Q) + (size_t)u.pm * 256 * 1536; s.B = (const char*)(wl + WO_B2) + (size_t)u.pn * 256 * 1536; s.lda2 = 1536; s.ldb2 = 1536; s.npairs = 6; }
        else { s.A = (const char*)(ws + OFF_QM) + (size_t)u.pm * 256 * 1024; s.B = (const char*)(wl + WO_B3) + (size_t)u.pn * 256 * 1024; s.lda2 = 1024; s.ldb2 = 1024; s.npairs = 4; }
        s.a_h = 128 * (int)s.lda2; s.b_h = 128 * (int)s.ldb2;
    }
};
typedef _Float16 f16x8 __attribute__((ext_vector_type(8)));
struct PM_Epi {
    GAS unsigned char* ws; const GAS float* bg; int c, l;
    __device__ __forceinline__ void seg_end(Acc&, const Unit&, int, int, int, int, int) const {}
    __device__ __forceinline__ void after_drain(Acc&, const Unit&, LAS unsigned char*, int, int, int, int) const {}
    __device__ __forceinline__ void finish(Acc& acc, const Unit& u, int wr, int wc, int fr, int fq) const {
        const int t_ = (wr * 4 + wc) * 64 + fq * 16 + fr;
        GAS unsigned char* st = (ws + OFF_V + (size_t)c * 262144);
        if ((u.type & 1) == 0) {
            auto bgs = bg + (u.type >> 1) * 1024 + u.pn * 256;
            float r8[8]; f32x4 bb[2][2];
            load_rs8(ws, u.pm * 256, wr, fr, r8);
#pragma unroll
            for (int j = 0; j < 2; ++j) { bb[j][0] = *(const GAS f32x4*)(bgs + j * HALF + wc * 32 + 8 * fq); bb[j][1] = *(const GAS f32x4*)(bgs + j * HALF + wc * 32 + 8 * fq + 4); }
            GE_FOR_PERM({ (void)row; (void)col8; const float r = r8[ai * 4 + m]; const f32x4 b0 = bb[bj][0], b1 = bb[bj][1];
                const f32x4 g0 = sigm4(acc[ai][bj][m][0] * r + b0), g1 = sigm4(acc[ai][bj][m][1] * r + b1); f16x8 h;
                h[0] = (_Float16)g0[0]; h[1] = (_Float16)g0[1]; h[2] = (_Float16)g0[2]; h[3] = (_Float16)g0[3]; h[4] = (_Float16)g1[0]; h[5] = (_Float16)g1[1]; h[6] = (_Float16)g1[2]; h[7] = (_Float16)g1[3];
                *(GAS f16x8*)(st + ((ai * 2 + bj) * 4 + m) * 8192 + t_ * 16) = h; })
        } else if (u.type == 1) branch_fin<false, false>(acc, u, st, t_, wr, wc, fr, fq);
        else if (u.type == 3) branch_fin<true, false>(acc, u, st, t_, wr, wc, fr, fq);
        else branch_fin<true, true>(acc, u, st, t_, wr, wc, fr, fq);
    }
    template <bool ADD, bool LAST>
    __device__ __forceinline__ void branch_fin(Acc& acc, const Unit& u, GAS unsigned char* st, int t_, int wr, int wc, int fr, int fq) const {
#pragma unroll
        for (int ai = 0; ai < 2; ++ai)
#pragma unroll
            for (int bj = 0; bj < 2; ++bj) {
                f16x8 h[4], pp[4];
#pragma unroll
                for (int m = 0; m < 4; ++m) { const int idx = (ai * 2 + bj) * 4 + m; h[m] = *(const GAS f16x8*)(st + idx * 8192 + t_ * 16);
                    if (ADD) pp[m] = *(const GAS f16x8*)(st + 131072 + idx * 8192 + t_ * 16); }
#pragma unroll
                for (int m = 0; m < 4; ++m) { const int idx = (ai * 2 + bj) * 4 + m; f32x4 v0 = acc[ai][bj][m][0], v1 = acc[ai][bj][m][1];
#pragma unroll
                    for (int e2 = 0; e2 < 4; ++e2) { v0[e2] *= (float)h[m][e2]; v1[e2] *= (float)h[m][4 + e2]; }
                    if (ADD) {
#pragma unroll
                        for (int e2 = 0; e2 < 4; ++e2) { v0[e2] += (float)pp[m][e2]; v1[e2] += (float)pp[m][4 + e2]; } }
                    if (!LAST) { f16x8 o; o[0] = (_Float16)v0[0]; o[1] = (_Float16)v0[1]; o[2] = (_Float16)v0[2]; o[3] = (_Float16)v0[3]; o[4] = (_Float16)v1[0]; o[5] = (_Float16)v1[1]; o[6] = (_Float16)v1[2]; o[7] = (_Float16)v1[3];
                        *(GAS f16x8*)(st + 131072 + idx * 8192 + t_ * 16) = o; }
                    else { const int row = ai * HALF + wr * 64 + m * 16 + fr, col8 = bj * HALF + wc * 32 + 8 * fq;
                        *(GAS u32x4*)((GAS bf16_t*)(ws + OFF_MERGED) + (size_t)(u.pm * 256 + row) * 1024 + u.pn * 256 + col8) = pack8(v0, v1); } }
            }
    }
};
struct PO_Sched {
    int G, c; const unsigned char *ws, *wl;
    __device__ __forceinline__ bool unit(int i, Unit& u) const { u.type = 0; u.g = 0; return static_tile(i, G, c, T / 256, 4, u.pm, u.pn); }
    __device__ __forceinline__ int nseg(const Unit&) const { return 1; }
    __device__ __forceinline__ void seg(const Unit& u, int, Seg& s) const {
        s.A = (const char*)(ws + OFF_MERGED) + (size_t)u.pm * 256 * 2048; s.B = (const char*)(wl + WO_OUT) + (size_t)u.pn * 256 * 2048;
        s.a_h = 128 * 2048; s.b_h = 128 * 2048; s.a_k = 128; s.b_k = 128; s.npairs = 8; s.amode = A_STD; s.bmode = B_STD; s.lda2 = 2048; s.ldb2 = 2048;
    }
};
struct PO_Epi {
    const GAS float* xold; GAS float* xnew; GAS unsigned char* ws; int l;
    __device__ __forceinline__ void seg_end(Acc&, const Unit&, int, int, int, int, int) const {}
    __device__ __forceinline__ void after_drain(Acc&, const Unit&, LAS unsigned char*, int, int, int, int) const {}
    template <bool NEXT>
    __device__ __forceinline__ void fin(Acc& acc, const Unit& u, int wr, int wc, int fr, int fq) const {
        LAS float* part = (LAS float*)(size_t)RING_BYTES;
        auto XBo = (GAS bf16_t*)(ws + OFF_XB);
#pragma unroll
        for (int ai = 0; ai < 2; ++ai)
#pragma unroll
            for (int mh = 0; mh < 2; ++mh) {
                f32x4 xo[2][2][2];
#pragma unroll
                for (int mm = 0; mm < 2; ++mm) { const int m = mh * 2 + mm; const size_t ro = (size_t)(u.pm * 256 + ai * HALF + wr * 64 + m * 16 + fr) * 1024 + u.pn * 256 + wc * 32 + 4 * fq;
#pragma unroll
                    for (int bj = 0; bj < 2; ++bj)
#pragma unroll
                        for (int n = 0; n < 2; ++n) xo[mm][bj][n] = *(const GAS f32x4*)(xold + ro + bj * HALF + n * 16); }
#pragma unroll
                for (int mm = 0; mm < 2; ++mm) { const int m = mh * 2 + mm, row = ai * HALF + wr * 64 + m * 16 + fr; const size_t ro = (size_t)(u.pm * 256 + row) * 1024 + u.pn * 256 + wc * 32 + 4 * fq; float sq = 0.f;
#pragma unroll
                    for (int bj = 0; bj < 2; ++bj)
#pragma unroll
                        for (int n = 0; n < 2; ++n) { const size_t o = ro + bj * HALF + n * 16; const f32x4 v = xo[mm][bj][n] + acc[ai][bj][m][n]; *(GAS f32x4*)(xnew + o) = v;
                            if (NEXT) { *(GAS u32x2*)(XBo + o) = (u32x2){cvt_pk_bf16(v[0], v[1]), cvt_pk_bf16(v[2], v[3])}; sq += (v[0] * v[0] + v[1] * v[1]) + (v[2] * v[2] + v[3] * v[3]); } }
                    if (NEXT) { sq += __shfl_xor(sq, 16); sq += __shfl_xor(sq, 32); if (fq == 0) part[row * 4 + wc] = sq; } }
            }
        if (NEXT) {
            asm volatile("s_waitcnt lgkmcnt(0)" ::: "memory"); __builtin_amdgcn_s_barrier(); asm volatile("" ::: "memory");
            const int t = (wr * 4 + wc) * 64 + fq * 16 + fr;
            if (t < 256) { const f32x4 p = *(const LAS f32x4*)(part + t * 4); ((GAS float*)(ws + OFF_ROWSQ))[(size_t)(u.pm * 256 + t) * 4 + u.pn] = (p.x + p.y) + (p.z + p.w); }
            asm volatile("s_waitcnt lgkmcnt(0)" ::: "memory"); __builtin_amdgcn_s_barrier(); asm volatile("" ::: "memory");
        }
    }
    __device__ __forceinline__ void finish(Acc& acc, const Unit& u, int wr, int wc, int fr, int fq) const { if (l == 0) fin<true>(acc, u, wr, wc, fr, fq); else fin<false>(acc, u, wr, wc, fr, fq); }
};
}

__device__ __forceinline__ void cpow(float lmag, double rev1, int k, float& re, float& im) {
    const float m = expf((float)k * lmag); double r = (double)k * rev1; r -= rint(r);
    const float a = (float)(r * 6.283185307179586476925286766559); re = m * cosf(a); im = m * sinf(a);
}
__device__ __forceinline__ void tabgen(unsigned char* tab, const float* __restrict__ lam_re, const float* __restrict__ lam_im, const float* __restrict__ log_dt, const float* __restrict__ b_re, const float* __restrict__ b_im,
                                       const float* __restrict__ c_re, const float* __restrict__ c_im, const float* __restrict__ dvec, LAS float* scr, int gw, int ngw, int lane) {
    bf16_t* TOEP = (bf16_t*)(tab + TAB_TOEP); bf16_t* CST = (bf16_t*)(tab + TAB_CST); bf16_t* WST = (bf16_t*)(tab + TAB_WST); float* AQ = (float*)(tab + TAB_AQ);
    for (int item = gw; item < NG * 32; item += ngw) {
        const int g = item >> 5, d = item & 31, p = lane;
        const float dt = expf(log_dt[g]); const float lre = lam_re[g * 64 + p], lim = lam_im[g * 64 + p];
        const float lmag = lre * dt; const double rev1 = (double)lim * (double)dt * 0.15915494309189533576888376337251;
        float fr, fi;
        {
            double r = rev1; r -= rint(r); const float bq = (float)(r * 6.283185307179586476925286766559);
            const float em1 = expm1f(lmag), sb2 = sinf(0.5f * bq); const float nr = em1 * cosf(bq) - 2.f * sb2 * sb2, ni = (em1 + 1.f) * sinf(bq);
            const float den = lre * lre + lim * lim; fr = (nr * lre + ni * lim) / den; fi = (ni * lre - nr * lim) / den;
        }
        float bbr[16], bbi[16];
#pragma unroll
        for (int h = 0; h < 16; ++h) { const float br = b_re[(g * 64 + p) * 16 + h], bi = b_im[(g * 64 + p) * 16 + h]; bbr[h] = fr * br - fi * bi; bbi[h] = fr * bi + fi * br; }
        float pr, pi;
        cpow(lmag, rev1, 31 - d, pr, pi);
        {
            unsigned wre[8], wim[8];
#pragma unroll
            for (int h = 0; h < 16; h += 2) { wre[h >> 1] = pk2(pr * bbr[h] - pi * bbi[h], pr * bbr[h + 1] - pi * bbi[h + 1]); wim[h >> 1] = pk2(pr * bbi[h] + pi * bbr[h], pr * bbi[h + 1] + pi * bbr[h + 1]); }
            u32x4* o0 = (u32x4*)(WST + ((size_t)g * 128 + p) * 512 + d * 16); u32x4* o1 = (u32x4*)(WST + ((size_t)g * 128 + 64 + p) * 512 + d * 16);
            o0[0] = (u32x4){wre[0], wre[1], wre[2], wre[3]}; o0[1] = (u32x4){wre[4], wre[5], wre[6], wre[7]};
            o1[0] = (u32x4){wim[0], wim[1], wim[2], wim[3]}; o1[1] = (u32x4){wim[4], wim[5], wim[6], wim[7]};
        }
        cpow(lmag, rev1, d + 1, pr, pi);
#pragma unroll 2
        for (int hq = 0; hq < 16; ++hq) { const float cr = c_re[(g * 16 + hq) * 64 + p], ci = c_im[(g * 16 + hq) * 64 + p];
            bf16_t* o = CST + ((size_t)g * 512 + d * 16 + hq) * 128; o[p] = (bf16_t)f2bf(cr * pr - ci * pi); o[64 + p] = (bf16_t)f2bf(-(cr * pi + ci * pr)); }
        cpow(lmag, rev1, d, pr, pi);
#pragma unroll
        for (int h = 0; h < 16; ++h) { scr[(p * 16 + h) * 2] = pr * bbr[h] - pi * bbi[h]; scr[(p * 16 + h) * 2 + 1] = pr * bbi[h] + pi * bbr[h]; }
        asm volatile("s_waitcnt lgkmcnt(0)" ::: "memory");
        {
            const int hq = lane >> 2, h0 = (lane & 3) * 4; float a0 = 0.f, a1 = 0.f, a2 = 0.f, a3 = 0.f;
            for (int q = 0; q < 64; ++q) { const float cr = c_re[(g * 16 + hq) * 64 + q], ci = c_im[(g * 16 + hq) * 64 + q]; const LAS float* s = scr + (q * 16 + h0) * 2;
                a0 += cr * s[0] - ci * s[1]; a1 += cr * s[2] - ci * s[3]; a2 += cr * s[4] - ci * s[5]; a3 += cr * s[6] - ci * s[7]; }
            if (d == 0) { const float dd = dvec[g * 16 + hq]; if (hq == h0) a0 += dd; if (hq == h0 + 1) a1 += dd; if (hq == h0 + 2) a2 += dd; if (hq == h0 + 3) a3 += dd; }
            *(u32x2*)(TOEP + ((size_t)g * 48 + 16 + d) * 256 + hq * 16 + h0) = (u32x2){pk2(a0, a1), pk2(a2, a3)};
            if (d < 16) *(u32x2*)(TOEP + ((size_t)g * 48 + d) * 256 + hq * 16 + h0) = (u32x2){0u, 0u};
        }
        asm volatile("s_waitcnt lgkmcnt(0)" ::: "memory");
        if (d == 0) { cpow(lmag, rev1, 32, pr, pi); AQ[(g * 64 + p) * 2] = pr; AQ[(g * 64 + p) * 2 + 1] = pi; }
    }
}

namespace at {
__device__ __forceinline__ int crow(int r, int hi) { return (r & 3) + 8 * (r >> 2) + 4 * hi; }
__device__ __forceinline__ unsigned cvtpk(float lo, float hi) { unsigned r; asm volatile("v_cvt_pk_bf16_f32 %0, %1, %2" : "=v"(r) : "v"(lo), "v"(hi)); return r; }
constexpr float LOG2E = 1.4426950408889634f, LN2 = 0.6931471805599453f;
constexpr size_t OFF_BIASR = 768 * 1024;
constexpr int D_VTS = 388;
constexpr int D_LK = 0, D_LVT = 49152, D_LBIAS = D_LVT + 64 * D_VTS * 2, D_LSCR = D_LBIAS + 1024, D_LEND = D_LSCR + 8 * 128;
static_assert(D_LEND <= 146432, "dilated attention LDS");
struct DilUnit { int b, head, r, s, np; };
__device__ __forceinline__ DilUnit dil_decode(int ui) { DilUnit u; const int u32i = ui & 31, bh = ui >> 5; u.head = bh % NH; u.b = bh / NH; const int grp = u.head >> 2; u.r = grp == 0 ? 1 : (grp == 1 ? 4 : 16); const int ppr = 32 / u.r; u.s = u32i / ppr; u.np = u32i % ppr; return u; }
struct DilPref { u32x4 k[6], v0[3], v1[3]; };
__device__ __forceinline__ void dil_prefetch(DilPref& p, GAS unsigned char* ws, const DilUnit& u, int tid) {
    const GAS bf16_t* Kb = (const GAS bf16_t*)(ws + OFF_K); const GAS bf16_t* V = (const GAS bf16_t*)(ws + OFF_V);
    const size_t rowbase = (size_t)u.b * SEQ; const int mk0 = u.np * 256 - 128;
#pragma unroll
    for (int i = 0; i < 6; ++i) { const int idx = tid + 512 * i, key = idx >> 3, ch = idx & 7; int mk = mk0 + key; mk = mk < 0 ? 0 : mk;
        p.k[i] = *(const GAS u32x4*)(Kb + (rowbase + (size_t)mk * u.r + u.s) * 768 + u.head * 64 + ch * 8); }
#pragma unroll
    for (int i = 0; i < 3; ++i) { const int idx = tid + 512 * i, key = (idx >> 3) * 2, ch = idx & 7; int mk = mk0 + key; mk = mk < 0 ? 0 : mk;
        const GAS bf16_t* vp = V + (rowbase + (size_t)mk * u.r + u.s) * 768 + u.head * 64 + ch * 8; p.v0[i] = *(const GAS u32x4*)vp; p.v1[i] = *(const GAS u32x4*)(vp + (size_t)u.r * 768); }
}
__device__ __forceinline__ void dil_stage(LAS unsigned char* lds, const DilPref& p, int tid) {
#pragma unroll
    for (int i = 0; i < 6; ++i) { const int idx = tid + 512 * i, key = idx >> 3, ch = idx & 7; *(LAS u32x4*)(lds + D_LK + key * 128 + ((ch ^ ((key >> 1) & 7)) << 4)) = p.k[i]; }
#pragma unroll
    for (int i = 0; i < 3; ++i) { const int idx = tid + 512 * i, key = (idx >> 3) * 2, ch = idx & 7; const u32x4 v0 = p.v0[i], v1 = p.v1[i];
        LAS unsigned* vt = (LAS unsigned*)(lds + D_LVT + ((ch * 8) * D_VTS + key) * 2);
        vt[0 * (D_VTS / 2)] = (v0.x & 0xffffu) | (v1.x << 16); vt[1 * (D_VTS / 2)] = (v0.x >> 16) | (v1.x & 0xffff0000u);
        vt[2 * (D_VTS / 2)] = (v0.y & 0xffffu) | (v1.y << 16); vt[3 * (D_VTS / 2)] = (v0.y >> 16) | (v1.y & 0xffff0000u);
        vt[4 * (D_VTS / 2)] = (v0.z & 0xffffu) | (v1.z << 16); vt[5 * (D_VTS / 2)] = (v0.z >> 16) | (v1.z & 0xffff0000u);
        vt[6 * (D_VTS / 2)] = (v0.w & 0xffffu) | (v1.w << 16); vt[7 * (D_VTS / 2)] = (v0.w >> 16) | (v1.w & 0xffff0000u); }
}
__device__ __forceinline__ void dil_unit(LAS unsigned char* lds, GAS unsigned char* ws, const DilUnit& u, DilPref& pre, bool has_next, const DilUnit& nu, int tid) {
    const int lane = tid & 63, wave = __builtin_amdgcn_readfirstlane(tid >> 6), r32 = lane & 31, hi = lane >> 5;
    GAS bf16_t* Q = (GAS bf16_t*)(ws + OFF_Q); GAS float* lse = (GAS float*)(ws + OFF_LSE);
    const size_t rowbase = (size_t)u.b * SEQ; const int M0 = u.np * 256; const int r = u.r, s = u.s, head = u.head;
    dil_stage(lds, pre, tid);
    if (tid < 196) ((LAS float*)(lds + D_LBIAS))[tid] = ((const GAS float*)(ws + OFF_BIASR))[head * 196 + tid];
    const size_t qtok = rowbase + (size_t)(M0 + 32 * wave + r32) * r + s;
    bf16x8 qf[4];
#pragma unroll
    for (int ks = 0; ks < 4; ++ks) qf[ks] = *(const GAS bf16x8*)(Q + qtok * 768 + head * 64 + 16 * ks + 8 * hi);
    asm volatile("s_waitcnt lgkmcnt(0)\n\ts_barrier" ::: "memory");
    if (has_next) dil_prefetch(pre, ws, nu, tid);
    const int tskip = u.np == 0 ? 4 - wave : 0;
    const int L0 = r32 - 4 * hi;
    const LAS float* bl = (const LAS float*)(lds + D_LBIAS) + (31 - L0);
    f32x16 S[5];
#pragma unroll
    for (int t = 0; t < 5; ++t)
#pragma unroll
        for (int q = 0; q < 16; ++q) S[t][q] = bl[32 * t + (q & 3) + 8 * (q >> 2)];
#pragma unroll
    for (int t = 0; t < 5; ++t) {
        const int key = 32 * (wave + t) + r32; const LAS unsigned char* kp = lds + D_LK + key * 128; const int sw = (key >> 1) & 7;
        bf16x8 kf[4];
#pragma unroll
        for (int ks = 0; ks < 4; ++ks) kf[ks] = *(const LAS bf16x8*)(kp + (((2 * ks + hi) ^ sw) << 4));
#pragma unroll
        for (int ks = 0; ks < 4; ++ks) S[t] = __builtin_amdgcn_mfma_f32_32x32x16_bf16(kf[ks], qf[ks], S[t], 0, 0, 0);
    }
    float mx = -1e30f;
#pragma unroll
    for (int t = 0; t < 5; ++t) {
        const bool dead = t < tskip;
#pragma unroll
        for (int q = 0; q < 16; ++q) { const int cq = (q & 3) + 8 * (q >> 2); float v = S[t][q];
            if (t == 0) v = cq >= L0 ? v : -1e30f;
            if (t == 4) v = cq <= L0 ? v : -1e30f;
            v = dead ? -1e30f : v; S[t][q] = v; mx = fmaxf(mx, v); }
    }
    mx = fmaxf(mx, __shfl_xor(mx, 32));
    float lsum = 0.f; unsigned pk[5][8];
#pragma unroll
    for (int t = 0; t < 5; ++t) {
#pragma unroll
        for (int q = 0; q < 16; ++q) { const float p = __builtin_amdgcn_exp2f(S[t][q] - mx); S[t][q] = p; lsum += p; }
#pragma unroll
        for (int q = 0; q < 8; ++q) pk[t][q] = cvtpk(S[t][2 * q], S[t][2 * q + 1]);
    }
    lsum += __shfl_xor(lsum, 32);
    f32x16 O[2];
#pragma unroll
    for (int d0 = 0; d0 < 2; ++d0)
#pragma unroll
        for (int q = 0; q < 16; ++q) O[d0][q] = 0.f;
#pragma unroll
    for (int t = 0; t < 5; ++t) {
        u32x2 vf[2][2][2];
#pragma unroll
        for (int s2 = 0; s2 < 2; ++s2)
#pragma unroll
            for (int d0 = 0; d0 < 2; ++d0) { const LAS unsigned char* vp = lds + D_LVT + ((32 * d0 + r32) * D_VTS + 32 * (wave + t) + 16 * s2 + 4 * hi) * 2; vf[s2][d0][0] = *(const LAS u32x2*)vp; vf[s2][d0][1] = *(const LAS u32x2*)(vp + 16); }
#pragma unroll
        for (int s2 = 0; s2 < 2; ++s2) {
            const bf16x8 Pf = __builtin_bit_cast(bf16x8, (u32x4){pk[t][4 * s2], pk[t][4 * s2 + 1], pk[t][4 * s2 + 2], pk[t][4 * s2 + 3]});
#pragma unroll
            for (int d0 = 0; d0 < 2; ++d0)
                O[d0] = __builtin_amdgcn_mfma_f32_32x32x16_bf16(__builtin_bit_cast(bf16x8, (u32x4){vf[s2][d0][0].x, vf[s2][d0][0].y, vf[s2][d0][1].x, vf[s2][d0][1].y}), Pf, O[d0], 0, 0, 0);
        }
    }
    const float ri = __builtin_amdgcn_rcpf(lsum);
    if (hi == 0) lse[qtok * NH + head] = (mx + __builtin_amdgcn_logf(lsum)) * LN2;
    GAS bf16_t* op = Q + qtok * 768 + head * 64 + 4 * hi;
#pragma unroll
    for (int d0 = 0; d0 < 2; ++d0)
#pragma unroll
        for (int g4 = 0; g4 < 4; ++g4)
            *(GAS u32x2*)(op + 32 * d0 + 8 * g4) = (u32x2){cvtpk(O[d0][4 * g4] * ri, O[d0][4 * g4 + 1] * ri), cvtpk(O[d0][4 * g4 + 2] * ri, O[d0][4 * g4 + 3] * ri)};
    asm volatile("s_waitcnt lgkmcnt(0)\n\ts_barrier" ::: "memory");
}
constexpr int M_VTS = 260;
constexpr int M_LK = 0, M_LVT = 65536, M_LSCR = M_LVT + 128 * M_VTS * 2, M_LEND = M_LSCR + 8 * 128;
static_assert(M_LEND <= 146432, "memory attention LDS");
__device__ __forceinline__ void mem_job(LAS unsigned char* lds, GAS unsigned char* ws, int l, int b, int head, int qb0, int nqb, int tid) {
    const int lane = tid & 63, wave = __builtin_amdgcn_readfirstlane(tid >> 6), r32 = lane & 31, hi = lane >> 5;
    GAS bf16_t* QM = (GAS bf16_t*)(ws + OFF_QM); const GAS bf16_t* ZM = (const GAS bf16_t*)(ws + OFF_ZM); const GAS bf16_t* KVM = (const GAS bf16_t*)(ws + OFF_KVM + (size_t)l * 2 * MiB) + (size_t)b * 256 * 1024 + head * 128;
    {
        u32x4 kk[8], v0[4], v1[4];
#pragma unroll
        for (int i = 0; i < 8; ++i) { const int idx = tid + 512 * i, key = idx >> 4, ch = idx & 15; kk[i] = *(const GAS u32x4*)(KVM + (size_t)key * 1024 + ch * 8); }
#pragma unroll
        for (int i = 0; i < 4; ++i) { const int idx = tid + 512 * i, key = (idx >> 4) * 2, ch = idx & 15; const GAS bf16_t* vp = KVM + (size_t)key * 1024 + 512 + ch * 8; v0[i] = *(const GAS u32x4*)vp; v1[i] = *(const GAS u32x4*)(vp + 1024); }
#pragma unroll
        for (int i = 0; i < 8; ++i) { const int idx = tid + 512 * i, key = idx >> 4, ch = idx & 15; *(LAS u32x4*)(lds + M_LK + key * 256 + ((ch ^ (key & 15)) << 4)) = kk[i]; }
#pragma unroll
        for (int i = 0; i < 4; ++i) { const int idx = tid + 512 * i, key = (idx >> 4) * 2, ch = idx & 15;
            LAS unsigned* vt = (LAS unsigned*)(lds + M_LVT + ((ch * 8) * M_VTS + key) * 2);
            vt[0 * (M_VTS / 2)] = (v0[i].x & 0xffffu) | (v1[i].x << 16); vt[1 * (M_VTS / 2)] = (v0[i].x >> 16) | (v1[i].x & 0xffff0000u);
            vt[2 * (M_VTS / 2)] = (v0[i].y & 0xffffu) | (v1[i].y << 16); vt[3 * (M_VTS / 2)] = (v0[i].y >> 16) | (v1[i].y & 0xffff0000u);
            vt[4 * (M_VTS / 2)] = (v0[i].z & 0xffffu) | (v1[i].z << 16); vt[5 * (M_VTS / 2)] = (v0[i].z >> 16) | (v1[i].z & 0xffff0000u);
            vt[6 * (M_VTS / 2)] = (v0[i].w & 0xffffu) | (v1[i].w << 16); vt[7 * (M_VTS / 2)] = (v0[i].w >> 16) | (v1[i].w & 0xffff0000u); }
    }
    __syncthreads();
    for (int j = 0; j < nqb; ++j) {
        const size_t qrow0 = (size_t)b * SEQ + (qb0 + j) * 256 + 32 * wave;
        bf16x8 qf[8];
#pragma unroll
        for (int ks = 0; ks < 8; ++ks) qf[ks] = *(const GAS bf16x8*)(QM + (qrow0 + r32) * 512 + head * 128 + 16 * ks + 8 * hi);
        f32x16 S[8];
#pragma unroll
        for (int t = 0; t < 8; ++t)
#pragma unroll
            for (int q = 0; q < 16; ++q) S[t][q] = 0.f;
#pragma unroll
        for (int ks = 0; ks < 8; ++ks) {
#pragma unroll
            for (int th = 0; th < 2; ++th) {
                bf16x8 kf[4];
#pragma unroll
                for (int t = 0; t < 4; ++t) { const int key = 32 * (4 * th + t) + r32; kf[t] = *(const LAS bf16x8*)(lds + M_LK + key * 256 + (((2 * ks + hi) ^ (key & 15)) << 4)); }
#pragma unroll
                for (int t = 0; t < 4; ++t) S[4 * th + t] = __builtin_amdgcn_mfma_f32_32x32x16_bf16(kf[t], qf[ks], S[4 * th + t], 0, 0, 0);
            }
        }
        float mx = -1e30f;
#pragma unroll
        for (int t = 0; t < 8; ++t)
#pragma unroll
            for (int q = 0; q < 16; ++q) mx = fmaxf(mx, S[t][q]);
        mx = fmaxf(mx, __shfl_xor(mx, 32));
        float lsum = 0.f; unsigned pk[8][8];
#pragma unroll
        for (int t = 0; t < 8; ++t) {
#pragma unroll
            for (int q = 0; q < 16; ++q) { const float p = __builtin_amdgcn_exp2f(S[t][q] - mx); S[t][q] = p; lsum += p; }
#pragma unroll
            for (int q = 0; q < 8; ++q) pk[t][q] = cvtpk(S[t][2 * q], S[t][2 * q + 1]);
        }
        lsum += __shfl_xor(lsum, 32);
        f32x16 O[4];
#pragma unroll
        for (int d0 = 0; d0 < 4; ++d0)
#pragma unroll
            for (int q = 0; q < 16; ++q) O[d0][q] = 0.f;
#pragma unroll
        for (int t = 0; t < 8; ++t)
#pragma unroll
            for (int s2 = 0; s2 < 2; ++s2) {
                const bf16x8 Pf = __builtin_bit_cast(bf16x8, (u32x4){pk[t][4 * s2], pk[t][4 * s2 + 1], pk[t][4 * s2 + 2], pk[t][4 * s2 + 3]});
                u32x2 vf[4][2];
#pragma unroll
                for (int d0 = 0; d0 < 4; ++d0) { const LAS unsigned char* vp = lds + M_LVT + ((32 * d0 + r32) * M_VTS + 32 * t + 16 * s2 + 4 * hi) * 2; vf[d0][0] = *(const LAS u32x2*)vp; vf[d0][1] = *(const LAS u32x2*)(vp + 16); }
#pragma unroll
                for (int d0 = 0; d0 < 4; ++d0) O[d0] = __builtin_amdgcn_mfma_f32_32x32x16_bf16(__builtin_bit_cast(bf16x8, (u32x4){vf[d0][0].x, vf[d0][0].y, vf[d0][1].x, vf[d0][1].y}), Pf, O[d0], 0, 0, 0);
            }
        const float ri = __builtin_amdgcn_rcpf(lsum); const size_t go = (qrow0 + r32) * 512 + head * 128 + 4 * hi;
        u32x2 zz[4][4];
#pragma unroll
        for (int d0 = 0; d0 < 4; ++d0)
#pragma unroll
            for (int g4 = 0; g4 < 4; ++g4) zz[d0][g4] = *(const GAS u32x2*)(ZM + go + 32 * d0 + 8 * g4);
#pragma unroll
        for (int d0 = 0; d0 < 4; ++d0)
#pragma unroll
            for (int g4 = 0; g4 < 4; ++g4) { const u32x2 z = zz[d0][g4];
                *(GAS u32x2*)(QM + go + 32 * d0 + 8 * g4) = (u32x2){cvtpk(O[d0][4 * g4] * ri * bflo(z.x), O[d0][4 * g4 + 1] * ri * bfhi(z.x)), cvtpk(O[d0][4 * g4 + 2] * ri * bflo(z.y), O[d0][4 * g4 + 3] * ri * bfhi(z.y))}; }
    }
    __syncthreads();
}
}

constexpr int PTR_OFF = MISC_OFF + 256;
__device__ __forceinline__ const float* ld_inptr(LAS unsigned char* lds, int k) {
    const unsigned long long v = ((volatile LAS unsigned long long*)(lds + PTR_OFF))[k];
    const unsigned lo = __builtin_amdgcn_readfirstlane((unsigned)v), hi = __builtin_amdgcn_readfirstlane((unsigned)(v >> 32));
    return (const float*)(GAS const float*)(((unsigned long long)hi << 32) | lo);
}
struct Args { const float* in[23]; float* out; unsigned char* ws; int ph_lo, ph_hi; };
__global__ void __launch_bounds__(NTHREADS, 2) mega_fwd(Args args) {
    extern __shared__ __attribute__((aligned(16))) unsigned char lds_raw[];
    LAS unsigned char* lds = (LAS unsigned char*)lds_raw;
    const int G_ = gridDim.x, ngw = G_ * NWAVES;
#define PHASE_IDS() const int tid = fresh_tid(), lane = tid & 63, wave = __builtin_amdgcn_readfirstlane(tid >> 6), cb = fresh_bid(), gw = cb * NWAVES + wave; (void)lane; (void)gw; (void)tid; \
        GAS unsigned char* ws = (GAS unsigned char*)fresh_ptr(args.ws); GAS unsigned char* out_p = (GAS unsigned char*)fresh_ptr((unsigned char*)args.out); (void)ws; (void)out_p
    for (int u = threadIdx.x; u < (LDS_BYTES - LDSCTL_OFF) / 4; u += NTHREADS) ((LAS unsigned*)(lds + LDSCTL_OFF))[u] = 0u;
    __syncthreads();
    if (threadIdx.x == 0) {
#pragma unroll
        for (int k = 0; k < 23; ++k) ((volatile LAS unsigned long long*)(lds + PTR_OFF))[k] = (unsigned long long)args.in[k];
    }
    __syncthreads();
#define INP(k) ld_inptr(lds, k)
    XcdBarrier bar = xcd_barrier_post((unsigned*)args.ws + CW_BAR, (volatile LAS unsigned*)(lds + MISC_OFF) + 8);
#define xout ((float*)(unsigned char*)out_p)
#define rs ((float*)(unsigned char*)(ws + OFF_RS))
#define rs_mem ((float*)(unsigned char*)(ws + OFF_RSMEM))
#define lse ((float*)(unsigned char*)(ws + OFF_LSE))
#define XB ((bf16_t*)(unsigned char*)(ws + OFF_XB))
#define U ((bf16_t*)(unsigned char*)(ws + OFF_U))
#define ZM ((bf16_t*)(unsigned char*)(ws + OFF_ZM))
#define ZS ((bf16_t*)(unsigned char*)(ws + OFF_ZS))
#define Q ((bf16_t*)(unsigned char*)(ws + OFF_Q))
#define Kb ((bf16_t*)(unsigned char*)(ws + OFF_K))
#define V ((bf16_t*)(unsigned char*)(ws + OFF_V))
#define ZA ((bf16_t*)(unsigned char*)(ws + OFF_ZA))
#define QM ((bf16_t*)(unsigned char*)(ws + OFF_QM))
#define Y ((bf16_t*)(unsigned char*)(ws + OFF_Y))
#define MG ((bf16_t*)(unsigned char*)(ws + OFF_MERGED))
#define MEMB ((bf16_t*)(unsigned char*)(ws + OFF_MEMB))
#define tab ((unsigned char*)(ws + OFF_TAB))
#define x_in INP(0)
#define mem INP(1)
#define norm_g INP(2)
#define mem_norm_g INP(3)
#define w_in INP(4)
#define b_gate INP(5)
#define lam_re INP(6)
#define lam_im INP(7)
#define log_dt INP(8)
#define b_re INP(9)
#define b_im INP(10)
#define c_re INP(11)
#define c_im INP(12)
#define ssm_d INP(13)
#define w_glu INP(14)
#define b_glu INP(15)
#define w_mem_kv INP(16)
#define w_br_ssm INP(17)
#define w_br_attn INP(18)
#define w_br_mem INP(19)
#define w_out INP(20)
#define rel_bias INP(21)
#define final_g INP(22)
#define WL(l, o) ((bf16_t*)(unsigned char*)(ws + OFF_W + (size_t)(l) * W_STRIDE + (o)))
#define GRID_BAR() xcd_barrier(bar)
#define TABGEN(l) tabgen(tab, lam_re + (l) * NG * NP, lam_im + (l) * NG * NP, log_dt + (l) * NG, b_re + (size_t)(l) * NG * NP * HG, b_im + (size_t)(l) * NG * NP * HG, \
                         c_re + (size_t)(l) * NG * HG * NP, c_im + (size_t)(l) * NG * HG * NP, ssm_d + (l) * D_SSM, (LAS float*)(lds + wave * 16384), gw, ngw, lane)
    {
        PHASE_IDS();
        LAS float* scr = (LAS float*)(lds + wave * 16384);
        for (int l = 0; l < DEPTH; ++l) {
            constexpr int I_IN = (1024 / 64) * (D_IN / 32), I_GLU = (768 / 64) * (768 / 32), I_B12 = (768 / 64) * (1024 / 32), I_B3 = (512 / 64) * (1024 / 32), I_SQ = (1024 / 64) * (1024 / 32);
            constexpr int NIT = I_IN + I_GLU + 2 * I_B12 + I_B3 + 2 * I_SQ;
            for (int it = gw; it < NIT; it += ngw) {
                int r = it;
                if (r < I_IN) { transpose_item(w_in + (size_t)l * 1024 * D_IN, 1024, D_IN, WL(l, WO_IN), 1024, norm_g + l * 1024, scr, r, lane); continue; } r -= I_IN;
                if (r < I_GLU) { transpose_item(w_glu + (size_t)l * 768 * 768, 768, 768, WL(l, WO_GLU), 768, nullptr, scr, r, lane); continue; } r -= I_GLU;
                if (r < I_B12) { transpose_item(w_br_ssm + (size_t)l * 768 * 1024, 768, 1024, WL(l, WO_B1), 768, nullptr, scr, r, lane); continue; } r -= I_B12;
                if (r < I_B12) { transpose_item(w_br_attn + (size_t)l * 768 * 1024, 768, 1024, WL(l, WO_B2), 768, nullptr, scr, r, lane); continue; } r -= I_B12;
                if (r < I_B3) { transpose_item(w_br_mem + (size_t)l * 512 * 1024, 512, 1024, WL(l, WO_B3), 512, nullptr, scr, r, lane); continue; } r -= I_B3;
                if (r < I_SQ) { transpose_item(w_out + (size_t)l * 1024 * 1024, 1024, 1024, WL(l, WO_OUT), 1024, nullptr, scr, r, lane); continue; } r -= I_SQ;
                transpose_item(w_mem_kv + (size_t)l * 1024 * 1024, 1024, 1024, WL(l, WO_MKV), 1024, mem_norm_g + l * 1024, scr, r, lane);
            }
        }
        for (int m = 2 * gw; m < T; m += 2 * ngw) rownorm_row2(x_in, XB, rs, m, lane, (float*)(unsigned char*)(ws + OFF_ROWSQ));
        for (int m = gw; m < BATCH * MEM_LEN; m += ngw) rownorm_row(mem, MEMB, rs_mem, m, lane);
    }
    { PHASE_IDS(); TABGEN(0); }
    {
        PHASE_IDS();
        for (int i = gw * 64 + lane; i < NH * 196; i += ngw * 64) {
            const int head = i / 196, d = 159 - (i - head * 196), grp = head >> 2, r = grp == 0 ? 1 : (grp == 1 ? 4 : 16);
            ((float*)(unsigned char*)(ws + at::OFF_BIASR))[i] = (d >= 0 && d <= 128) ? rel_bias[rel_bucket(d * r) * NH + head] * at::LOG2E : 0.f;
        }
    }
    GRID_BAR();
#pragma unroll 1
    for (int l = 0; l < DEPTH; ++l) {
#define KVM ((bf16_t*)(unsigned char*)(ws + OFF_KVM + (size_t)l * 2 * MiB))
        {
            PHASE_IDS();
            if (l > 0) { TABGEN(l); __syncthreads(); }
            ge::PA_Sched S{G_, cb, (unsigned char*)ws, (unsigned char*)ws + OFF_W + (size_t)l * W_STRIDE};
            ge::PA_Epi E{ws, l};
            ge::gemm_run(lds, S, E);
        }
        GRID_BAR();
        {
            PHASE_IDS();
            { ge::PS_Sched S{cb, (unsigned char*)ws}; ge::PS_Epi E{ws}; ge::gemm_run(lds, S, E); }
            asm volatile("s_waitcnt vmcnt(0)" ::: "memory"); __syncthreads();
            { ge::PY_Sched S{cb, (unsigned char*)ws}; ge::PY_Epi E{ws}; ge::gemm_run(lds, S, E); }
            __syncthreads();
        }
        {
            PHASE_IDS();
            const int nss = BATCH * NG, n_lo = 5, n_hi = (BATCH * NH * 32 - nss * n_lo + (G_ - nss) - 1) / (G_ - nss);
            const int u_beg = cb < nss ? cb * n_lo : nss * n_lo + (cb - nss) * n_hi, u_cnt = cb < nss ? n_lo : n_hi;
            const int u_end = (u_beg + u_cnt) < BATCH * NH * 32 ? (u_beg + u_cnt) : BATCH * NH * 32;
            if (u_beg < u_end) {
                at::DilPref pre; at::DilUnit cu = at::dil_decode(u_beg); at::dil_prefetch(pre, ws, cu, tid);
                for (int ui = u_beg; ui < u_end; ++ui) { const bool hn = ui + 1 < u_end; const at::DilUnit nu = at::dil_decode(hn ? ui + 1 : ui); at::dil_unit(lds, ws, cu, pre, hn, nu, tid); cu = nu; }
            }
        }
        {
            PHASE_IDS();
            for (int ji = cb; ji < BATCH * MH * 16; ji += G_) at::mem_job(lds, ws, l, ji >> 6, (ji >> 4) & 3, (ji & 15) * 2, 2, tid);
        }
        GRID_BAR();
        {
            PHASE_IDS();
            ge::PG_Sched S{G_, cb, (unsigned char*)ws, (unsigned char*)ws + OFF_W + (size_t)l * W_STRIDE};
            ge::PG_Epi E{ws, (const GAS float*)(b_glu + l * 768)};
            ge::gemm_run(lds, S, E);
        }
        {
            PHASE_IDS();
            const int nfree = G_ - 128;
            if (nfree > 0) { if (cb >= 128) for (int tp = (cb - 128) * NWAVES + wave; tp < T / 2; tp += nfree * NWAVES) attn_final_pair(Q, lse, ZA, 2 * tp, lane); }
            else for (int tp = gw; tp < T / 2; tp += ngw) attn_final_pair(Q, lse, ZA, 2 * tp, lane);
        }
        GRID_BAR();
        {
            PHASE_IDS();
            ge::PM_Sched S{G_, cb, (unsigned char*)ws, (unsigned char*)ws + OFF_W + (size_t)l * W_STRIDE};
            ge::PM_Epi E{ws, (const GAS float*)(b_gate + l * 3072), cb, l};
            ge::gemm_run(lds, S, E);
        }
        GRID_BAR();
        {
            PHASE_IDS();
            ge::PO_Sched S{G_, cb, (unsigned char*)ws, (unsigned char*)ws + OFF_W + (size_t)l * W_STRIDE};
            ge::PO_Epi E{(const GAS float*)(l == 0 ? x_in : xout), (GAS float*)xout, ws, l};
            ge::gemm_run(lds, S, E);
        }
        GRID_BAR();
        if (l + 1 == DEPTH) { PHASE_IDS(); for (int m = gw; m < T; m += ngw) final_norm_row(xout, final_g, m, lane); }
    }
}

extern "C" void kernel_launch(void* const* d_in, const int* in_sizes, int n_in, void* d_out, int out_size, void* d_ws, size_t ws_size, hipStream_t stream) {
    static int grid = 0;
    if (grid == 0) {
        if (n_in != 23 || ws_size < WS_NEED || out_size != T * D_MODEL) { fprintf(stderr, "kernel_launch: unexpected shapes (n_in %d, ws %zu, out %d)\n", n_in, ws_size, out_size); grid = -1; return; }
        int dev = 0, cus = 0, per_cu = 0;
        if (hipGetDevice(&dev) != hipSuccess || hipDeviceGetAttribute(&cus, hipDeviceAttributeMultiprocessorCount, dev) != hipSuccess) { grid = -1; return; }
        if (hipFuncSetAttribute((const void*)mega_fwd, hipFuncAttributeMaxDynamicSharedMemorySize, LDS_BYTES) != hipSuccess) { fprintf(stderr, "kernel_launch: hipFuncSetAttribute failed\n"); grid = -1; return; }
        if (hipOccupancyMaxActiveBlocksPerMultiprocessor(&per_cu, (const void*)mega_fwd, NTHREADS, LDS_BYTES) != hipSuccess || per_cu < 1) { fprintf(stderr, "kernel_launch: occupancy query says %d blocks/CU\n", per_cu); per_cu = 1; }
        (void)hipGetLastError();
        grid = cus * 1;
    }
    if (grid < 0) return;
    (void)hipMemsetAsync(d_ws, 0, CTL_ZERO_BYTES, stream);
    Args a{};
    for (int i = 0; i < 23; ++i) a.in[i] = (const float*)d_in[i];
    a.out = (float*)d_out; a.ws = (unsigned char*)d_ws; a.ph_lo = 0; a.ph_hi = 0;
    hipLaunchKernelGGL(mega_fwd, dim3(grid), dim3(NTHREADS), LDS_BYTES, stream, a);
}
```

```cpp
#include <hip/hip_runtime.h>
#include <cstdint>
#include <cstdio>

typedef unsigned short bf16_t;
typedef short bf16x8 __attribute__((ext_vector_type(8)));
typedef float f32x4 __attribute__((ext_vector_type(4)));
typedef float f32x16 __attribute__((ext_vector_type(16)));
typedef unsigned u32x4 __attribute__((ext_vector_type(4)));
typedef unsigned u32x2 __attribute__((ext_vector_type(2)));

constexpr int D_MODEL = 1024, BATCH = 4, SEQ = 8192, DEPTH = 2, T = BATCH * SEQ;
constexpr int D_SSM = 768, NG = 48, HG = 16, NP = 64;
constexpr int NH = 12, HD = 64, D_ATTN = 768;
constexpr int MEM_LEN = 256, MH = 4, MHD = 128, D_MEM = 512;
constexpr int D_IN = 8704, N_A1 = 5632;
constexpr float EPS = 1e-6f;

constexpr size_t MiB = 1u << 20;
constexpr size_t OFF_RS = 1 * MiB, OFF_RSMEM = 1 * MiB + 256 * 1024, OFF_LSE = 2 * MiB;
constexpr size_t OFF_W = 4 * MiB, W_STRIDE = 27 * MiB;
constexpr size_t WO_IN = 0, WO_GLU = 17 * MiB, WO_B1 = WO_GLU + 1179648, WO_B2 = WO_B1 + 1572864, WO_B3 = WO_B2 + 1572864, WO_OUT = WO_B3 + 1048576, WO_MKV = WO_OUT + 2 * MiB;
static_assert(WO_MKV + 2 * MiB <= W_STRIDE, "weights");
constexpr size_t OFF_KVM = 58 * MiB, OFF_MEMB = 62 * MiB, OFF_XB = 64 * MiB, OFF_U = 128 * MiB, OFF_ZM = 188 * MiB, OFF_ZS = 220 * MiB, OFF_Q = 268 * MiB,
                 OFF_K = 316 * MiB, OFF_V = 364 * MiB, OFF_ZA = 412 * MiB, OFF_QM = 460 * MiB, OFF_TAB = 492 * MiB, WS_NEED = 512 * MiB;
constexpr size_t OFF_Y = OFF_K, OFF_MERGED = OFF_U;

__device__ __forceinline__ unsigned f2bf(float f) { unsigned u = __builtin_bit_cast(unsigned, f); return (u + 0x7fffu + ((u >> 16) & 1u)) >> 16; }
__device__ __forceinline__ unsigned pk2(float lo, float hi) { return f2bf(lo) | (f2bf(hi) << 16); }
__device__ __forceinline__ float bflo(unsigned u) { return __builtin_bit_cast(float, u << 16); }
__device__ __forceinline__ float bfhi(unsigned u) { return __builtin_bit_cast(float, u & 0xffff0000u); }
__device__ __forceinline__ float bf2f(bf16_t h) { return __builtin_bit_cast(float, (unsigned)h << 16); }
__device__ __forceinline__ float sigmoidf_(float x) { return 1.f / (1.f + __expf(-x)); }
__device__ __forceinline__ float siluf_(float x) { return x * sigmoidf_(x); }
__device__ __forceinline__ float gelu_tanh(float y) { return 0.5f * y * (1.f + tanhf(0.7978845608028654f * (y + 0.044715f * y * y * y))); }
__device__ __forceinline__ float wave_sum(float v) {
#pragma unroll
    for (int o = 1; o < 64; o <<= 1) v += __shfl_xor(v, o);
    return v;
}
__device__ __forceinline__ float wave_max(float v) {
#pragma unroll
    for (int o = 1; o < 64; o <<= 1) v = fmaxf(v, __shfl_xor(v, o));
    return v;
}

#define GAS __attribute__((address_space(1)))
#define LAS __attribute__((address_space(3)))
constexpr int NWAVES = 8, NTHREADS = 512;
constexpr int RING_BYTES = 131072, LDS_BYTES = 147456, LDSCTL_OFF = LDS_BYTES - 1024, MISC_OFF = LDSCTL_OFF + 320;
constexpr size_t CTL_ZERO_BYTES = 1 * MiB; constexpr int CW_BAR = 4096;

#define XB_TMO      128
#define XB_XCNT(j)  (256  + 64 * (j))
#define XB_XSUB(j)  (1280 + 64 * (j))
#define XB_XGEN(j)  (2304 + 64 * (j))
#define XB_TOP      3328
#define XB_TOPGEN   3392
#define XCD_BAR_WORDS 3456
#define XB_SPIN_CAP (1u << 18)
__device__ __forceinline__ unsigned xb_ld(unsigned* p)              { return __hip_atomic_load(p, __ATOMIC_RELAXED, __HIP_MEMORY_SCOPE_AGENT); }
__device__ __forceinline__ unsigned xb_add(unsigned* p, unsigned v) { return __hip_atomic_fetch_add(p, v, __ATOMIC_RELAXED, __HIP_MEMORY_SCOPE_AGENT); }
__device__ __forceinline__ unsigned xb_xcc_id() { return (unsigned)__builtin_amdgcn_s_getreg((3 << 11) | 20) & 0xFu; }
#define XB_SPIN(cond, bar) do { unsigned _sp = 0; while (cond) { __builtin_amdgcn_s_sleep(1); \
    if ((++_sp & 255u) == 0u) { if (xb_ld(&(bar)[XB_TMO])) break; if (_sp > XB_SPIN_CAP) { atomicAdd(&(bar)[XB_TMO], 1u); break; } } } } while (0)
struct XcdBarrier { unsigned* bar; unsigned x; volatile LAS unsigned* st; };
__device__ __forceinline__ XcdBarrier xcd_barrier_post(unsigned* bar, volatile LAS unsigned* st) {
    XcdBarrier b; b.bar = bar; b.x = (unsigned)__builtin_amdgcn_readfirstlane((int)xb_xcc_id()); b.st = st;
    if (threadIdx.x == 0) (void)xb_add(&bar[XB_XCNT(b.x)], 1u);
    return b;
}
__device__ __forceinline__ void xcd_barrier_complete(unsigned* bar, unsigned x, unsigned& nloc, unsigned& nx) {
    const unsigned G = gridDim.x * gridDim.y * gridDim.z;
    unsigned sum, cnt, mine, sp = 0u;
    for (;;) {
        sum = 0u; cnt = 0u; mine = 0u;
#pragma unroll
        for (unsigned j = 0; j < 16; ++j) { const unsigned c = xb_ld(&bar[XB_XCNT(j)]); sum += c; cnt += (c > 0u) ? 1u : 0u; mine = (j == x) ? c : mine; }
        if (sum == G) break;
        __builtin_amdgcn_s_sleep(1);
        if ((++sp & 255u) == 0u) { if (xb_ld(&bar[XB_TMO])) break; if (sp > XB_SPIN_CAP) { atomicAdd(&bar[XB_TMO], 1u); break; } }
    }
    nloc = mine > 0u ? mine : 1u; nx = cnt > 0u ? cnt : 1u;
}
__device__ __forceinline__ void xcd_barrier(const XcdBarrier& b) {
    asm volatile("s_waitcnt vmcnt(0)" ::: "memory");
    __syncthreads();
    if (threadIdx.x == 0) {
        unsigned* bar = b.bar; unsigned bx = b.x; asm volatile("" : "+s"(bar), "+s"(bx));
        __builtin_amdgcn_s_waitcnt(0);
        unsigned nloc = b.st[0], nx = b.st[1];
        if (nloc == 0u) { xcd_barrier_complete(bar, bx, nloc, nx); b.st[0] = nloc; b.st[1] = nx; }
        const unsigned old = xb_add(&bar[XB_XSUB(bx)], 1u);
        const unsigned gen = old / nloc;
        if (old + 1u == (gen + 1u) * nloc) {
            __builtin_amdgcn_fence(__ATOMIC_RELEASE, "agent");
            asm volatile("s_waitcnt vmcnt(0)" ::: "memory");
            const unsigned og = xb_add(&bar[XB_TOP], 1u);
            const unsigned tg = og / nx;
            if (og + 1u == (tg + 1u) * nx) xb_add(&bar[XB_TOPGEN], 1u);
            else XB_SPIN(xb_ld(&bar[XB_TOPGEN]) == tg, bar);
            __builtin_amdgcn_fence(__ATOMIC_ACQUIRE, "agent");
            xb_add(&bar[XB_XGEN(bx)], 1u);
            asm volatile("s_waitcnt vmcnt(0)" ::: "memory");
        } else {
            XB_SPIN(xb_ld(&bar[XB_XGEN(bx)]) == gen, bar);
            __builtin_amdgcn_fence(__ATOMIC_ACQUIRE, "agent");
            asm volatile("s_waitcnt vmcnt(0)" ::: "memory");
        }
    }
    __syncthreads();
}

struct TItem { const float* W; bf16_t* WT; const float* ks; int N, ldt, k0, n0; };
__device__ __forceinline__ void titem_load(const TItem& t, float (&v)[32], int lane) {
#pragma unroll
    for (int i = 0; i < 32; ++i) { const int kk = 2 * i + (lane >> 5); v[i] = t.W[(size_t)(t.k0 + kk) * t.N + t.n0 + (lane & 31)]; }
}
__device__ __forceinline__ void titem_finish(const TItem& t, const float (&v)[32], LAS float* scr, int lane) {
#pragma unroll
    for (int i = 0; i < 32; ++i) { const int kk = 2 * i + (lane >> 5); const float s = t.ks ? t.ks[t.k0 + kk] : 1.f; scr[kk * 33 + (lane & 31)] = v[i] * s; }
    asm volatile("s_waitcnt lgkmcnt(0)" ::: "memory");
    const int c = lane & 7;
#pragma unroll
    for (int j = 0; j < 4; ++j) { const int n = (lane >> 3) + 8 * j; const LAS float* s = scr + (8 * c) * 33 + n;
        u32x4 o; o.x = pk2(s[0 * 33], s[1 * 33]); o.y = pk2(s[2 * 33], s[3 * 33]); o.z = pk2(s[4 * 33], s[5 * 33]); o.w = pk2(s[6 * 33], s[7 * 33]);
        *(u32x4*)(t.WT + (size_t)(t.n0 + n) * t.ldt + t.k0 + 8 * c) = o; }
    asm volatile("s_waitcnt lgkmcnt(0)" ::: "memory");
}
__device__ __forceinline__ void rownorm_row(const float* __restrict__ x, bf16_t* __restrict__ xb, float* __restrict__ rs, int row, int lane, float* __restrict__ sq4 = nullptr) {
    const f32x4* xr = (const f32x4*)(x + (size_t)row * 1024) + lane;
    f32x4 v[4]; float s = 0.f;
#pragma unroll
    for (int j = 0; j < 4; ++j) { v[j] = xr[64 * j]; s += (v[j].x * v[j].x + v[j].y * v[j].y) + (v[j].z * v[j].z + v[j].w * v[j].w); }
    s = wave_sum(s);
    u32x2* o = (u32x2*)(xb + (size_t)row * 1024) + lane;
#pragma unroll
    for (int j = 0; j < 4; ++j) o[64 * j] = (u32x2){pk2(v[j].x, v[j].y), pk2(v[j].z, v[j].w)};
    if (lane == 0) { rs[row] = 1.0f / sqrtf(s * (1.f / 1024.f) + EPS); if (sq4) *(f32x4*)(sq4 + (size_t)row * 4) = (f32x4){s, 0.f, 0.f, 0.f}; }
}
__device__ __forceinline__ void rownorm_row2(const float* __restrict__ x, bf16_t* __restrict__ xb, float* __restrict__ rs, int row, int lane, float* __restrict__ sq4) {
    const f32x4* xr = (const f32x4*)(x + (size_t)row * 1024) + lane;
    f32x4 v[8]; float s0 = 0.f, s1 = 0.f;
#pragma unroll
    for (int j = 0; j < 8; ++j) v[j] = xr[64 * j];
#pragma unroll
    for (int j = 0; j < 4; ++j) { s0 += (v[j].x * v[j].x + v[j].y * v[j].y) + (v[j].z * v[j].z + v[j].w * v[j].w); s1 += (v[4 + j].x * v[4 + j].x + v[4 + j].y * v[4 + j].y) + (v[4 + j].z * v[4 + j].z + v[4 + j].w * v[4 + j].w); }
#pragma unroll
    for (int o = 1; o < 64; o <<= 1) { s0 += __shfl_xor(s0, o); s1 += __shfl_xor(s1, o); }
    u32x2* ob = (u32x2*)(xb + (size_t)row * 1024) + lane;
#pragma unroll
    for (int j = 0; j < 8; ++j) ob[64 * j] = (u32x2){pk2(v[j].x, v[j].y), pk2(v[j].z, v[j].w)};
    if (lane == 0) { rs[row] = 1.0f / sqrtf(s0 * (1.f / 1024.f) + EPS); rs[row + 1] = 1.0f / sqrtf(s1 * (1.f / 1024.f) + EPS);
        *(f32x4*)(sq4 + (size_t)row * 4) = (f32x4){s0, 0.f, 0.f, 0.f}; *(f32x4*)(sq4 + (size_t)row * 4 + 4) = (f32x4){s1, 0.f, 0.f, 0.f}; }
}
__device__ __forceinline__ void final_norm_row(float* __restrict__ x, const float* __restrict__ g, int row, int lane) {
    f32x4* xr = (f32x4*)(x + (size_t)row * 1024) + lane; const f32x4* gr = (const f32x4*)g + lane;
    f32x4 v[4]; float s = 0.f;
#pragma unroll
    for (int j = 0; j < 4; ++j) { v[j] = xr[64 * j]; s += (v[j].x * v[j].x + v[j].y * v[j].y) + (v[j].z * v[j].z + v[j].w * v[j].w); }
    s = wave_sum(s); const float r = 1.0f / sqrtf(s * (1.f / 1024.f) + EPS);
#pragma unroll
    for (int j = 0; j < 4; ++j) xr[64 * j] = v[j] * r * gr[64 * j];
}

struct EpiA1 {
    const float* rs; bf16_t *U, *ZS, *Q, *Kb, *V, *ZA, *QM, *ZM;
    __device__ __forceinline__ void operator()(int m, int n, f32x4 v) const {
        v = v * rs[m]; bf16_t* dst; bool silu = false; float sc = 1.f;
        if (n < 768) dst = U + (size_t)m * 768 + n;
        else if (n < 1536) { dst = ZS + (size_t)m * 768 + (n - 768); silu = true; }
        else if (n < 2304) { dst = Q + (size_t)m * 768 + (n - 1536); sc = 0.125f; }
        else if (n < 3072) dst = Kb + (size_t)m * 768 + (n - 2304);
        else if (n < 3840) dst = V + (size_t)m * 768 + (n - 3072);
        else if (n < 4608) { dst = ZA + (size_t)m * 768 + (n - 3840); silu = true; }
        else if (n < 5120) { dst = QM + (size_t)m * 512 + (n - 4608); sc = 0.08838834764831845f; }
        else { dst = ZM + (size_t)m * 512 + (n - 5120); silu = true; }
        if (silu) { v.x = siluf_(v.x); v.y = siluf_(v.y); v.z = siluf_(v.z); v.w = siluf_(v.w); }
        v = v * sc;
        *(u32x2*)dst = (u32x2){pk2(v.x, v.y), pk2(v.z, v.w)};
    }
};
struct EpiKvm {
    const float* rs; bf16_t* O;
    __device__ __forceinline__ void operator()(int m, int n, f32x4 v) const { v = v * rs[m]; *(u32x2*)(O + (size_t)m * 1024 + n) = (u32x2){pk2(v.x, v.y), pk2(v.z, v.w)}; }
};
struct EpiGlu {
    const bf16_t* Y; bf16_t* ZS; const float* b;
    __device__ __forceinline__ void operator()(int m, int n, f32x4 v) const {
        const u32x2 y = *(const u32x2*)(Y + (size_t)m * 768 + n); u32x2* zp = (u32x2*)(ZS + (size_t)m * 768 + n); const u32x2 z = *zp; const f32x4 bb = *(const f32x4*)(b + n);
        const float o0 = bflo(y.x) * sigmoidf_(v.x + bb.x) * bflo(z.x), o1 = bfhi(y.x) * sigmoidf_(v.y + bb.y) * bfhi(z.x);
        const float o2 = bflo(y.y) * sigmoidf_(v.z + bb.z) * bflo(z.y), o3 = bfhi(y.y) * sigmoidf_(v.w + bb.w) * bfhi(z.y);
        *zp = (u32x2){pk2(o0, o1), pk2(o2, o3)};
    }
};
struct EpiOut {
    const float* xold; float* xnew;
    __device__ __forceinline__ void operator()(int m, int n, f32x4 v) const { const size_t o = (size_t)m * 1024 + n; *(f32x4*)(xnew + o) = *(const f32x4*)(xold + o) + v; }
};
template <class Epi>
__device__ __forceinline__ void wgemm(const bf16_t* __restrict__ A, int lda, const bf16_t* __restrict__ Bt, int ldb, int M, int N, int K, const Epi& epi, int gw, int ngw, int lane) {
    const int r = lane & 31, hi = lane >> 5; const int ntn = N / 64, ntiles = (M / 64) * ntn;
    for (int tile = gw; tile < ntiles; tile += ngw) {
        const int m0 = (tile / ntn) * 64, n0 = (tile % ntn) * 64;
        f32x16 acc[2][2];
#pragma unroll
        for (int i = 0; i < 2; ++i)
#pragma unroll
            for (int j = 0; j < 2; ++j)
#pragma unroll
                for (int q = 0; q < 16; ++q) acc[i][j][q] = 0.f;
        const bf16_t* ap = A + (size_t)(m0 + r) * lda + 8 * hi;
        const bf16_t* bp = Bt + (size_t)(n0 + r) * ldb + 8 * hi;
        for (int k = 0; k < K; k += 16) {
            const bf16x8 a0 = *(const bf16x8*)(ap + k), a1 = *(const bf16x8*)(ap + (size_t)32 * lda + k);
            const bf16x8 b0 = *(const bf16x8*)(bp + k), b1 = *(const bf16x8*)(bp + (size_t)32 * ldb + k);
            acc[0][0] = __builtin_amdgcn_mfma_f32_32x32x16_bf16(b0, a0, acc[0][0], 0, 0, 0);
            acc[0][1] = __builtin_amdgcn_mfma_f32_32x32x16_bf16(b1, a0, acc[0][1], 0, 0, 0);
            acc[1][0] = __builtin_amdgcn_mfma_f32_32x32x16_bf16(b0, a1, acc[1][0], 0, 0, 0);
            acc[1][1] = __builtin_amdgcn_mfma_f32_32x32x16_bf16(b1, a1, acc[1][1], 0, 0, 0);
        }
#pragma unroll
        for (int mi = 0; mi < 2; ++mi)
#pragma unroll
            for (int ni = 0; ni < 2; ++ni)
#pragma unroll
                for (int q = 0; q < 4; ++q)
                    epi(m0 + 32 * mi + r, n0 + 32 * ni + 8 * q + 4 * hi, (f32x4){acc[mi][ni][4 * q], acc[mi][ni][4 * q + 1], acc[mi][ni][4 * q + 2], acc[mi][ni][4 * q + 3]});
    }
}
__device__ __forceinline__ void merge_ref(const bf16_t* __restrict__ XB, const float* __restrict__ rs, const bf16_t* __restrict__ WinT, const float* __restrict__ bg,
                                          const bf16_t* __restrict__ OS, const bf16_t* __restrict__ OA, const bf16_t* __restrict__ OM,
                                          const bf16_t* __restrict__ W1, const bf16_t* __restrict__ W2, const bf16_t* __restrict__ W3, bf16_t* __restrict__ MG, int gw, int ngw, int lane) {
    const int r = lane & 31, hi = lane >> 5;
    for (int tile = gw; tile < (T / 32) * 32; tile += ngw) {
        const int m0 = (tile >> 5) * 32, n0 = (tile & 31) * 32;
        f32x16 L0, L1, L2, P0, P1, P2;
#pragma unroll
        for (int q = 0; q < 16; ++q) { L0[q] = 0.f; L1[q] = 0.f; L2[q] = 0.f; P0[q] = 0.f; P1[q] = 0.f; P2[q] = 0.f; }
        {
            const bf16_t* ap = XB + (size_t)(m0 + r) * 1024 + 8 * hi; const bf16_t* bp = WinT + (size_t)(N_A1 + n0 + r) * 1024 + 8 * hi;
            for (int k = 0; k < 1024; k += 16) {
                const bf16x8 a = *(const bf16x8*)(ap + k);
                L0 = __builtin_amdgcn_mfma_f32_32x32x16_bf16(*(const bf16x8*)(bp + k), a, L0, 0, 0, 0);
                L1 = __builtin_amdgcn_mfma_f32_32x32x16_bf16(*(const bf16x8*)(bp + (size_t)1024 * 1024 + k), a, L1, 0, 0, 0);
                L2 = __builtin_amdgcn_mfma_f32_32x32x16_bf16(*(const bf16x8*)(bp + (size_t)2048 * 1024 + k), a, L2, 0, 0, 0);
            }
        }
        {
            const bf16_t* ap = OS + (size_t)(m0 + r) * 768 + 8 * hi; const bf16_t* bp = W1 + (size_t)(n0 + r) * 768 + 8 * hi;
            for (int k = 0; k < 768; k += 16) P0 = __builtin_amdgcn_mfma_f32_32x32x16_bf16(*(const bf16x8*)(bp + k), *(const bf16x8*)(ap + k), P0, 0, 0, 0);
        }
        {
            const bf16_t* ap = OA + (size_t)(m0 + r) * 768 + 8 * hi; const bf16_t* bp = W2 + (size_t)(n0 + r) * 768 + 8 * hi;
            for (int k = 0; k < 768; k += 16) P1 = __builtin_amdgcn_mfma_f32_32x32x16_bf16(*(const bf16x8*)(bp + k), *(const bf16x8*)(ap + k), P1, 0, 0, 0);
        }
        {
            const bf16_t* ap = OM + (size_t)(m0 + r) * 512 + 8 * hi; const bf16_t* bp = W3 + (size_t)(n0 + r) * 512 + 8 * hi;
            for (int k = 0; k < 512; k += 16) P2 = __builtin_amdgcn_mfma_f32_32x32x16_bf16(*(const bf16x8*)(bp + k), *(const bf16x8*)(ap + k), P2, 0, 0, 0);
        }
        const int m = m0 + r; const float rsm = rs[m];
#pragma unroll
        for (int q = 0; q < 4; ++q) {
            const int n = n0 + 8 * q + 4 * hi; float o[4];
#pragma unroll
            for (int e = 0; e < 4; ++e) {
                const int rg = 4 * q + e;
                const float g0 = sigmoidf_(rsm * L0[rg] + bg[n + e]), g1 = sigmoidf_(rsm * L1[rg] + bg[1024 + n + e]), g2 = sigmoidf_(rsm * L2[rg] + bg[2048 + n + e]);
                o[e] = g0 * P0[rg] + g1 * P1[rg] + g2 * P2[rg];
            }
            *(u32x2*)(MG + (size_t)m * 1024 + n) = (u32x2){pk2(o[0], o[1]), pk2(o[2], o[3])};
        }
    }
}

__device__ __forceinline__ void ssm_ref(int b, int g, int lane, LAS float* xs, const bf16_t* __restrict__ U, bf16_t* __restrict__ Y, const float* __restrict__ lam_re, const float* __restrict__ lam_im,
                                        const float* __restrict__ log_dt, const float* __restrict__ b_re, const float* __restrict__ b_im,
                                        const float* __restrict__ c_re, const float* __restrict__ c_im, const float* __restrict__ dvec) {
    const float dt = expf(log_dt[g]); const float lre = lam_re[g * 64 + lane], lim = lam_im[g * 64 + lane];
    const float mag = expf(lre * dt); const float ar = mag * cosf(lim * dt), ai = mag * sinf(lim * dt);
    const float den = lre * lre + lim * lim, nr = ar - 1.0f, ni = ai;
    const float fr = (nr * lre + ni * lim) / den, fi = (ni * lre - nr * lim) / den;
    float bbr[16], bbi[16];
#pragma unroll
    for (int h = 0; h < 16; ++h) { const float br = b_re[(g * 64 + lane) * 16 + h], bi = b_im[(g * 64 + lane) * 16 + h]; bbr[h] = fr * br - fi * bi; bbi[h] = fr * bi + fi * br; }
    const int hq = lane & 15, part = lane >> 4;
    float cr[16], ci[16];
#pragma unroll
    for (int i = 0; i < 16; ++i) { cr[i] = c_re[(g * 16 + hq) * 64 + part * 16 + i]; ci[i] = c_im[(g * 16 + hq) * 64 + part * 16 + i]; }
    const float dd = dvec[g * 16 + hq];
    float xr = 0.f, xi = 0.f;
    const bf16_t* up = U + (size_t)b * SEQ * 768 + g * 16; bf16_t* yp = Y + (size_t)b * SEQ * 768 + g * 16;
    for (int t = 0; t < SEQ; ++t) {
        const u32x4 ua = *(const u32x4*)(up + (size_t)t * 768), ub = *(const u32x4*)(up + (size_t)t * 768 + 8);
        const float uh = bf2f(up[(size_t)t * 768 + hq]);
        float u[16];
        u[0] = bflo(ua.x); u[1] = bfhi(ua.x); u[2] = bflo(ua.y); u[3] = bfhi(ua.y); u[4] = bflo(ua.z); u[5] = bfhi(ua.z); u[6] = bflo(ua.w); u[7] = bfhi(ua.w);
        u[8] = bflo(ub.x); u[9] = bfhi(ub.x); u[10] = bflo(ub.y); u[11] = bfhi(ub.y); u[12] = bflo(ub.z); u[13] = bfhi(ub.z); u[14] = bflo(ub.w); u[15] = bfhi(ub.w);
        float bur = 0.f, bui = 0.f;
#pragma unroll
        for (int h = 0; h < 16; ++h) { bur += bbr[h] * u[h]; bui += bbi[h] * u[h]; }
        const float nxr = ar * xr - ai * xi + bur, nxi = ar * xi + ai * xr + bui; xr = nxr; xi = nxi;
        xs[lane] = xr; xs[64 + lane] = xi;
        asm volatile("s_waitcnt lgkmcnt(0)" ::: "memory");
        float acc = 0.f;
#pragma unroll
        for (int i = 0; i < 16; ++i) acc += cr[i] * xs[part * 16 + i] - ci[i] * xs[64 + part * 16 + i];
        acc += __shfl_xor(acc, 16); acc += __shfl_xor(acc, 32);
        asm volatile("s_waitcnt lgkmcnt(0)" ::: "memory");
        if (lane < 16) yp[(size_t)t * 768 + lane] = (bf16_t)f2bf(gelu_tanh(acc + dd * uh));
    }
}

__device__ __forceinline__ int rel_bucket(int n) {
    if (n < 16) return n;
    const float v = logf((float)n / 16.0f) / 4.852030263919617f * 16.0f;
    const int lg = 16 + (int)v; return lg < 31 ? lg : 31;
}
__device__ __forceinline__ float dot8(const u32x4 a, const u32x4 b) {
    return bflo(a.x) * bflo(b.x) + bfhi(a.x) * bfhi(b.x) + bflo(a.y) * bflo(b.y) + bfhi(a.y) * bfhi(b.y) + bflo(a.z) * bflo(b.z) + bfhi(a.z) * bfhi(b.z) + bflo(a.w) * bflo(b.w) + bfhi(a.w) * bfhi(b.w);
}
__device__ __forceinline__ void attn_ref(bf16_t* Q, const bf16_t* __restrict__ Kb, const bf16_t* __restrict__ V, const float* __restrict__ rel_bias, float* __restrict__ lse, int gw, int ngw, int lane) {
    for (int item = gw; item < T * NH; item += ngw) {
        const int head = item % NH, tok = item / NH, t = tok % SEQ, row0 = tok - t;
        const int grp = head >> 2, r = grp == 0 ? 1 : (grp == 1 ? 4 : 16);
        bf16_t* qp = Q + (size_t)tok * 768 + head * 64;
        u32x4 qv[8];
#pragma unroll
        for (int i = 0; i < 8; ++i) qv[i] = ((const u32x4*)qp)[i];
        float s[3]; bool ok[3];
#pragma unroll
        for (int sl = 0; sl < 3; ++sl) {
            const int j = sl * 64 + lane, p = t - j * r; ok[sl] = (j <= 128) && (p >= 0); s[sl] = -1e30f;
            if (ok[sl]) {
                const u32x4* kp = (const u32x4*)(Kb + (size_t)(row0 + p) * 768 + head * 64); float d = 0.f;
#pragma unroll
                for (int i = 0; i < 8; ++i) d += dot8(qv[i], kp[i]);
                s[sl] = d + rel_bias[rel_bucket(j * r) * NH + head];
            }
        }
        const float m = wave_max(fmaxf(fmaxf(s[0], s[1]), s[2]));
        float e[3];
#pragma unroll
        for (int sl = 0; sl < 3; ++sl) e[sl] = ok[sl] ? __expf(s[sl] - m) : 0.f;
        const float l = wave_sum(e[0] + e[1] + e[2]);
        float o = 0.f;
#pragma unroll
        for (int sl = 0; sl < 3; ++sl) {
            for (int jj = 0; jj < 64; ++jj) {
                const int j = sl * 64 + jj, p = t - j * r; if (j > 128 || p < 0) break;
                const float pj = __shfl(e[sl], jj);
                o += pj * bf2f(V[(size_t)(row0 + p) * 768 + head * 64 + lane]);
            }
        }
        qp[lane] = (bf16_t)f2bf(o / l);
        if (lane == 0) lse[(size_t)tok * NH + head] = m + logf(l);
    }
}
__device__ __forceinline__ void attn_final_pair(bf16_t* __restrict__ Q, const float* __restrict__ lse, const bf16_t* __restrict__ ZA, int tok0, int lane) {
    u32x4 o[3], z[3]; float l0[3], l1[3], l2[3]; int off[3], hd[3];
#pragma unroll
    for (int j = 0; j < 3; ++j) { const int ci = lane + 64 * j, tl = ci >= 96 ? 1 : 0, c8 = (ci - 96 * tl) * 8; hd[j] = c8 >> 6; off[j] = (tok0 + tl) * 768 + c8;
        o[j] = *(const u32x4*)(Q + off[j]); z[j] = *(const u32x4*)(ZA + off[j]); const float* lp = lse + (size_t)(tok0 + tl) * NH + (hd[j] & 3); l0[j] = lp[0]; l1[j] = lp[4]; l2[j] = lp[8]; }
#pragma unroll
    for (int j = 0; j < 3; ++j) {
        const float mx = fmaxf(fmaxf(l0[j], l1[j]), l2[j]); const float e0 = __expf(l0[j] - mx), e1 = __expf(l1[j] - mx), e2 = __expf(l2[j] - mx);
        const float mine = hd[j] < 4 ? e0 : (hd[j] < 8 ? e1 : e2); const float al = mine / (e0 + e1 + e2);
        *(u32x4*)(Q + off[j]) = (u32x4){pk2(bflo(o[j].x) * al * bflo(z[j].x), bfhi(o[j].x) * al * bfhi(z[j].x)), pk2(bflo(o[j].y) * al * bflo(z[j].y), bfhi(o[j].y) * al * bfhi(z[j].y)),
                                        pk2(bflo(o[j].z) * al * bflo(z[j].z), bfhi(o[j].z) * al * bfhi(z[j].z)), pk2(bflo(o[j].w) * al * bflo(z[j].w), bfhi(o[j].w) * al * bfhi(z[j].w))};
    }
}
__device__ __forceinline__ void memattn_ref(bf16_t* QM, const bf16_t* __restrict__ KVM, const bf16_t* __restrict__ ZM, int gw, int ngw, int lane) {
    for (int item = gw; item < T * MH; item += ngw) {
        const int head = item & 3, tok = item >> 2, b = tok / SEQ;
        bf16_t* qp = QM + (size_t)tok * 512 + head * 128;
        u32x4 qv[16];
#pragma unroll
        for (int i = 0; i < 16; ++i) qv[i] = ((const u32x4*)qp)[i];
        float s[4];
#pragma unroll
        for (int sl = 0; sl < 4; ++sl) {
            const int j = sl * 64 + lane; const u32x4* kp = (const u32x4*)(KVM + (size_t)(b * 256 + j) * 1024 + head * 128); float d = 0.f;
#pragma unroll
            for (int i = 0; i < 16; ++i) d += dot8(qv[i], kp[i]);
            s[sl] = d;
        }
        const float m = wave_max(fmaxf(fmaxf(s[0], s[1]), fmaxf(s[2], s[3])));
        float e[4];
#pragma unroll
        for (int sl = 0; sl < 4; ++sl) e[sl] = __expf(s[sl] - m);
        const float l = wave_sum((e[0] + e[1]) + (e[2] + e[3]));
        float o0 = 0.f, o1 = 0.f;
#pragma unroll
        for (int sl = 0; sl < 4; ++sl)
            for (int jj = 0; jj < 64; ++jj) {
                const int j = sl * 64 + jj; const float pj = __shfl(e[sl], jj);
                const bf16_t* vp = KVM + (size_t)(b * 256 + j) * 1024 + 512 + head * 128;
                o0 += pj * bf2f(vp[lane]); o1 += pj * bf2f(vp[64 + lane]);
            }
        const bf16_t* zp = ZM + (size_t)tok * 512 + head * 128;
        qp[lane] = (bf16_t)f2bf(o0 / l * bf2f(zp[lane])); qp[64 + lane] = (bf16_t)f2bf(o1 / l * bf2f(zp[64 + lane]));
    }
}

constexpr size_t OFF_ROWSQ = 3 * MiB + 512 * 1024;
constexpr size_t TAB_TOEP = 0, TAB_CST = 2 * MiB, TAB_WST = 8 * MiB, TAB_AQ = 15 * MiB;
__device__ __forceinline__ int fresh_tid() { int t = threadIdx.x; asm volatile("" : "+v"(t)); return t; }
__device__ __forceinline__ unsigned char* fresh_ptr(unsigned char* p) { asm volatile("" : "+s"(p)); return (unsigned char*)(GAS unsigned char*)p; }
__device__ __forceinline__ int fresh_bid() { int b = blockIdx.x; asm volatile("" : "+s"(b)); return b; }
__device__ __forceinline__ float load_rs(GAS unsigned char* ws, int, int tr) {
    const f32x4 p = ((const GAS f32x4*)(ws + OFF_ROWSQ))[tr]; return __builtin_amdgcn_rsqf(((p.x + p.y) + (p.z + p.w)) * (1.f / 1024.f) + EPS);
}
__device__ __forceinline__ void load_rs8(GAS unsigned char* ws, int row0, int wr, int fr, float (&r8)[8]) {
    f32x4 p[8];
#pragma unroll
    for (int i = 0; i < 8; ++i) p[i] = ((const GAS f32x4*)(ws + OFF_ROWSQ))[row0 + (i >> 2) * 128 + wr * 64 + (i & 3) * 16 + fr];
#pragma unroll
    for (int i = 0; i < 8; ++i) r8[i] = __builtin_amdgcn_rsqf(((p[i].x + p[i].y) + (p[i].z + p[i].w)) * (1.f / 1024.f) + EPS);
}
namespace ge {
constexpr int BM = 256, BK = 64, HALF = 128, HTB = HALF * BK * 2, STAGE_BYTES = 8 * HTB;
__device__ __forceinline__ int lds_byte(int r, int c) { const int st = (r >> 4) * 2 + (c >> 5), rr = r & 15, cc = c & 31, ob = rr * 64 + cc * 2; return st * 1024 + (ob ^ (((ob >> 9) & 1) << 5)); }
__device__ __forceinline__ void stage_rc(int b, int& R, int& C) { const int st = b / 1024, sb = b % 1024, swz = sb ^ (((sb >> 9) & 1) << 5); R = (st >> 1) * 16 + swz / 64; C = (st & 1) * 32 + (swz % 64) / 2; }
__device__ __forceinline__ int perm32(int rho) { const int n = rho >> 4, i = rho & 15; return 8 * (i >> 2) + 4 * n + (i & 3); }
enum { A_STD = 0, A_GM = 1 };
enum { B_STD = 0, B_PERM = 1, B_TOEP = 2 };
struct Seg { const char* A; const char* B; int a_h, b_h, a_k, b_k, npairs, amode, bmode; unsigned lda2, ldb2; };
struct Unit { int type, pm, pn, g; };
typedef f32x4 Acc[2][2][4][2];

template <class Sched, class Epi>
__device__ __forceinline__ void gemm_run(LAS unsigned char* lds, const Sched& S, const Epi& E) {
    const int tid = fresh_tid(), wid = __builtin_amdgcn_readfirstlane(tid >> 6), lane = tid & 63, wr = wid >> 2, wc = wid & 3, fr = lane & 15, fq = lane >> 4;
    const unsigned ldsw = (unsigned)wid * 1024u;
    const int aoff = lds_byte(wr * 64 + fr, fq * 8), boff = lds_byte(wc * 32 + fr, fq * 8);
#define GE_SA(b, h) (((b) * 2 + (h)) * HTB)
#define GE_SB(b, h) ((4 + (b) * 2 + (h)) * HTB)
#define GE_STAGE(bufoff, gbase, voff) do { _Pragma("unroll") for (int _i = 0; _i < 2; ++_i) \
        __builtin_amdgcn_global_load_lds((const unsigned*)((const char*)(gbase) + (voff)[_i]), (LAS unsigned*)(lds + (bufoff) + ldsw + _i * 8192), 16, 0, 0); } while (0)
#define GE_LDA(dst, b, h) do { _Pragma("unroll") for (int m = 0; m < 4; ++m) _Pragma("unroll") for (int k = 0; k < 2; ++k) dst[m][k] = *(const LAS bf16x8*)(lds + GE_SA(b, h) + aoff + m * 2048 + k * 1024); } while (0)
#define GE_LDB(dst, b, h) do { _Pragma("unroll") for (int n = 0; n < 2; ++n) _Pragma("unroll") for (int k = 0; k < 2; ++k) dst[n][k] = *(const LAS bf16x8*)(lds + GE_SB(b, h) + boff + n * 2048 + k * 1024); } while (0)
#define GE_MMA(ai, bj, At, Bt) do { __builtin_amdgcn_s_setprio(1); _Pragma("unroll") for (int m = 0; m < 4; ++m) _Pragma("unroll") for (int n = 0; n < 2; ++n) _Pragma("unroll") for (int k = 0; k < 2; ++k) \
        acc[ai][bj][m][n] = __builtin_amdgcn_mfma_f32_16x16x32_bf16(Bt[n][k], At[m][k], acc[ai][bj][m][n], 0, 0, 0); __builtin_amdgcn_s_setprio(0); } while (0)
#define GE_WAIT_V(n) asm volatile("s_waitcnt vmcnt(" #n ")" ::: "memory")
#define GE_WAIT_L(n) asm volatile("s_waitcnt lgkmcnt(" #n ")" ::: "memory")
#define GE_BAR __builtin_amdgcn_s_barrier()
#define GE_SCHED __builtin_amdgcn_sched_barrier(0)
#define GE_VOFFS(sg, va, vb) do { _Pragma("unroll") for (int _i = 0; _i < 2; ++_i) { int R_, C_; stage_rc(tid * 16 + _i * 8192, R_, C_); const int Rp_ = (R_ & ~31) + perm32(R_ & 31); \
        va[_i] = (sg).amode == A_GM ? (unsigned)((R_ >> 5) * 1280 + (R_ & 31) * 32 + (C_ >> 4) * (1024 * 1280) + (C_ & 15) * 2) : (unsigned)R_ * (sg).lda2 + (unsigned)(C_ * 2); \
        vb[_i] = (sg).bmode == B_TOEP ? (unsigned)((((Rp_ >> 4) - (C_ >> 4) + 3) * 256 + (Rp_ & 15) * 16 + (C_ & 15)) * 2) : (unsigned)((sg).bmode == B_PERM ? Rp_ : R_) * (sg).ldb2 + (unsigned)(C_ * 2); } } while (0)
    Unit nu; int nui = 0;
    if (!S.unit(0, nu)) return;
    Seg ns; int nsi = 0, npi = 0; S.seg(nu, 0, ns);
    const char* npa = ns.A; const char* npb = ns.B; unsigned nva[2], nvb[2]; GE_VOFFS(ns, nva, nvb);
    bool nreal = true;
    Unit cu; int csi; bool c_lastseg, c_lastunit; const char* c_a1h; unsigned cva[2];
#define GE_ADVANCE() do { ++npi; if (npi < ns.npairs) { npa += 2 * ns.a_k; npb += 2 * ns.b_k; } else { npi = 0; ++nsi; \
        if (nsi >= S.nseg(nu)) { nsi = 0; Unit tu; if (S.unit(nui + 1, tu)) { ++nui; nu = tu; } else nreal = false; } \
        S.seg(nu, nsi, ns); npa = ns.A; npb = ns.B; GE_VOFFS(ns, nva, nvb); } } while (0)
#define GE_SHIFT() do { cu = nu; csi = nsi; c_lastseg = (npi == ns.npairs - 1); c_lastunit = c_lastseg && (nsi == S.nseg(nu) - 1); \
        c_a1h = npa + ns.a_k + ns.a_h; cva[0] = nva[0]; cva[1] = nva[1]; GE_ADVANCE(); } while (0)
    Acc acc;
#pragma unroll
    for (int a = 0; a < 2; ++a)
#pragma unroll
        for (int b = 0; b < 2; ++b)
#pragma unroll
            for (int m = 0; m < 4; ++m)
#pragma unroll
                for (int n = 0; n < 2; ++n) acc[a][b][m][n] = (f32x4){0.f, 0.f, 0.f, 0.f};
    bf16x8 At[4][2], B0[2][2], B1[2][2];
    GE_STAGE(GE_SB(0, 0), npb, nvb); GE_STAGE(GE_SB(0, 1), npb + ns.b_h, nvb); GE_STAGE(GE_SA(0, 0), npa, nva); GE_STAGE(GE_SA(0, 1), npa + ns.a_h, nva);
    if (wr == 1) GE_BAR;
    GE_WAIT_V(2); GE_BAR;
    GE_STAGE(GE_SB(1, 0), npb + ns.b_k, nvb); GE_STAGE(GE_SA(1, 0), npa + ns.a_k, nva); GE_STAGE(GE_SB(1, 1), npb + ns.b_k + ns.b_h, nvb);
    GE_WAIT_V(6); GE_BAR;
    GE_SHIFT();
    for (;;) {
        GE_LDB(B0, 0, 0); GE_LDB(B1, 0, 1); GE_SCHED; GE_LDA(At, 0, 0); GE_STAGE(GE_SA(1, 1), c_a1h, cva);
        GE_WAIT_V(8); GE_WAIT_L(0); GE_BAR; GE_MMA(0, 0, At, B0); GE_MMA(0, 1, At, B1); GE_BAR; GE_SCHED;
        GE_LDA(At, 0, 1); GE_STAGE(GE_SB(0, 0), npb, nvb); GE_STAGE(GE_SB(0, 1), npb + ns.b_h, nvb); GE_STAGE(GE_SA(0, 0), npa, nva);
        GE_WAIT_V(8); GE_WAIT_L(0); GE_BAR; GE_MMA(1, 0, At, B0); GE_MMA(1, 1, At, B1); GE_BAR; GE_SCHED;
        GE_LDB(B0, 1, 0); GE_LDB(B1, 1, 1); GE_SCHED; GE_LDA(At, 1, 0); GE_STAGE(GE_SA(0, 1), npa + ns.a_h, nva);
        GE_WAIT_V(8); GE_WAIT_L(0); GE_BAR; GE_MMA(0, 0, At, B0); GE_MMA(0, 1, At, B1); GE_BAR; GE_SCHED;
        GE_LDA(At, 1, 1); GE_STAGE(GE_SB(1, 0), npb + ns.b_k, nvb); GE_STAGE(GE_SB(1, 1), npb + ns.b_k + ns.b_h, nvb); GE_STAGE(GE_SA(1, 0), npa + ns.a_k, nva);
        GE_WAIT_V(8); GE_WAIT_L(0); GE_BAR; GE_MMA(1, 0, At, B0); GE_MMA(1, 1, At, B1); GE_BAR; GE_SCHED;
        if (c_lastunit) {
            if (wr == 0) GE_BAR;
            { int fr_ = fr, fq_ = fq; asm volatile("" : "+v"(fr_), "+v"(fq_)); E.finish(acc, cu, wr, wc, fr_, fq_); }
            if (!nreal) break;
#pragma unroll
            for (int a = 0; a < 2; ++a)
#pragma unroll
                for (int b = 0; b < 2; ++b)
#pragma unroll
                    for (int m = 0; m < 4; ++m)
#pragma unroll
                        for (int n = 0; n < 2; ++n) acc[a][b][m][n] = (f32x4){0.f, 0.f, 0.f, 0.f};
            if (wr == 1) GE_BAR;
        } else if (c_lastseg) {
            { int fr_ = fr, fq_ = fq; asm volatile("" : "+v"(fr_), "+v"(fq_)); E.seg_end(acc, cu, csi, wr, wc, fr_, fq_); }
        }
        GE_SHIFT();
    }
    GE_WAIT_V(0);
    GE_BAR;
    { int fr_ = fr, fq_ = fq; asm volatile("" : "+v"(fr_), "+v"(fq_)); E.after_drain(acc, cu, lds, wr, wc, fr_, fq_); }
#undef GE_SA
#undef GE_SB
#undef GE_STAGE
#undef GE_LDA
#undef GE_LDB
#undef GE_MMA
#undef GE_WAIT_V
#undef GE_WAIT_L
#undef GE_BAR
#undef GE_SCHED
#undef GE_VOFFS
#undef GE_ADVANCE
#undef GE_SHIFT
}
__device__ __forceinline__ bool static_tile(int i, int G, int c, int nM, int nN, int& pm, int& pn) {
    const int nwg = nM * nN; const long L = (long)i * G + c; if (L >= nwg) return false;
    int wgid = (int)L; { const int q = nwg / 8, r = nwg % 8, xcd = wgid % 8, off = wgid / 8; wgid = (xcd < r ? xcd * (q + 1) : r * (q + 1) + (xcd - r) * q) + off; }
    const int nig = 8 * nN, gid = wgid / nig, fm = gid * 8, gsz = (nM - fm) < 8 ? (nM - fm) : 8;
    pm = fm + ((wgid % nig) % gsz); pn = (wgid % nig) / gsz; return true;
}
__device__ __forceinline__ unsigned cvt_pk_bf16(float lo, float hi) { unsigned r; asm volatile("v_cvt_pk_bf16_f32 %0, %1, %2" : "=v"(r) : "v"(lo), "v"(hi)); return r; }
__device__ __forceinline__ u32x4 pack8(const f32x4 a, const f32x4 b) { u32x4 w; w.x = cvt_pk_bf16(a[0], a[1]); w.y = cvt_pk_bf16(a[2], a[3]); w.z = cvt_pk_bf16(b[0], b[1]); w.w = cvt_pk_bf16(b[2], b[3]); return w; }
__device__ __forceinline__ void unpack8(const u32x4 w, f32x4& a, f32x4& b) { a = (f32x4){bflo(w.x), bfhi(w.x), bflo(w.y), bfhi(w.y)}; b = (f32x4){bflo(w.z), bfhi(w.z), bflo(w.w), bfhi(w.w)}; }
__device__ __forceinline__ float fsigm(float x) { return __builtin_amdgcn_rcpf(1.f + __builtin_amdgcn_exp2f(-1.4426950408889634f * x)); }
__device__ __forceinline__ float fgelu(float y) { return y * fsigm(1.5957691216057308f * (y + 0.044715f * y * y * y)); }
__device__ __forceinline__ f32x4 silu4(f32x4 v) { return (f32x4){v[0] * fsigm(v[0]), v[1] * fsigm(v[1]), v[2] * fsigm(v[2]), v[3] * fsigm(v[3])}; }
__device__ __forceinline__ f32x4 sigm4(f32x4 v) { return (f32x4){fsigm(v[0]), fsigm(v[1]), fsigm(v[2]), fsigm(v[3])}; }
__device__ __forceinline__ f32x4 gelu4(f32x4 v) { return (f32x4){fgelu(v[0]), fgelu(v[1]), fgelu(v[2]), fgelu(v[3])}; }
#define GE_FOR_PERM(...) _Pragma("unroll") for (int ai = 0; ai < 2; ++ai) _Pragma("unroll") for (int m = 0; m < 4; ++m) _Pragma("unroll") for (int bj = 0; bj < 2; ++bj) { \
        const int row = ai * HALF + wr * 64 + m * 16 + fr, col8 = bj * HALF + wc * 32 + 8 * fq; __VA_ARGS__ }

struct PA_Sched {
    int G, c; const unsigned char *ws, *wl;
    __device__ __forceinline__ bool unit(int i, Unit& u) const {
        constexpr int nwg = (T / 256) * (N_A1 / 256); const int nA = c < nwg ? (nwg - c + G - 1) / G : 0;
        if (i < nA) { u.type = 0; u.g = 0; return static_tile(i, G, c, T / 256, N_A1 / 256, u.pm, u.pn); }
        if (i == nA && c < 16) { u.type = 1; u.pm = c >> 2; u.pn = c & 3; u.g = 0; return true; }
        return false;
    }
    __device__ __forceinline__ int nseg(const Unit&) const { return 1; }
    __device__ __forceinline__ void seg(const Unit& u, int, Seg& s) const {
        s.A = (const char*)(ws + (u.type == 0 ? OFF_XB : OFF_MEMB)) + (size_t)u.pm * 256 * 2048; s.B = (const char*)(wl + (u.type == 0 ? WO_IN : WO_MKV)) + (size_t)u.pn * 256 * 2048;
        s.a_h = 128 * 2048; s.b_h = 128 * 2048; s.a_k = 128; s.b_k = 128; s.npairs = 8; s.amode = A_STD; s.bmode = B_PERM; s.lda2 = 2048; s.ldb2 = 2048;
    }
};
struct PA_Epi {
    GAS unsigned char* ws; int l;
    __device__ __forceinline__ void seg_end(Acc&, const Unit&, int, int, int, int, int) const {}
    __device__ __forceinline__ void after_drain(Acc&, const Unit&, LAS unsigned char*, int, int, int, int) const {}
    __device__ __forceinline__ void finish(Acc& acc, const Unit& u, int wr, int wc, int fr, int fq) const {
        const int pn = u.pn;
        float r8[8];
        if (u.type == 1) {
#pragma unroll
            for (int i = 0; i < 8; ++i) r8[i] = ((const GAS float*)(ws + OFF_RSMEM))[u.pm * 256 + (i >> 2) * HALF + wr * 64 + (i & 3) * 16 + fr];
        } else {
            load_rs8(ws, u.pm * 256, wr, fr, r8);
        }
        if (u.type == 1) {
            auto KVM = (GAS bf16_t*)(ws + OFF_KVM + (size_t)l * 2 * MiB);
            GE_FOR_PERM({ const int tr = u.pm * 256 + row; const float r = r8[ai * 4 + m]; *(GAS u32x4*)(KVM + (size_t)tr * 1024 + pn * 256 + col8) = pack8(acc[ai][bj][m][0] * r, acc[ai][bj][m][1] * r); })
            return;
        }
        if (pn < 3) {
            auto U = (GAS bf16_t*)(ws + OFF_U);
            GE_FOR_PERM({ const int tr = u.pm * 256 + row; const float r = r8[ai * 4 + m]; const int c = pn * 256 + col8;
                *(GAS u32x4*)(U + ((size_t)(c >> 4) * 1024 + (tr >> 5)) * 640 + (tr & 31) * 16 + (c & 15)) = pack8(acc[ai][bj][m][0] * r, acc[ai][bj][m][1] * r); })
        } else if (pn < 18) {
            const int k = (pn - 3) / 3; const size_t off = k == 0 ? OFF_ZS : (k == 1 ? OFF_Q : (k == 2 ? OFF_K : (k == 3 ? OFF_V : OFF_ZA)));
            auto D = (GAS bf16_t*)(ws + off); const bool silu = (k == 0 || k == 4); const float sc = k == 1 ? 0.125f * 1.4426950408889634f : 1.0f;
            const int cb = (pn - 3 - 3 * k) * 256;
            if (silu) { GE_FOR_PERM({ const int tr = u.pm * 256 + row; const float r = r8[ai * 4 + m]; *(GAS u32x4*)(D + (size_t)tr * 768 + cb + col8) = pack8(silu4(acc[ai][bj][m][0] * r), silu4(acc[ai][bj][m][1] * r)); }) }
            else { GE_FOR_PERM({ const int tr = u.pm * 256 + row; const float r = r8[ai * 4 + m] * sc; *(GAS u32x4*)(D + (size_t)tr * 768 + cb + col8) = pack8(acc[ai][bj][m][0] * r, acc[ai][bj][m][1] * r); }) }
        } else {
            const bool isz = pn >= 20; auto D = (GAS bf16_t*)(ws + (isz ? OFF_ZM : OFF_QM)); const int cb = (pn - (isz ? 20 : 18)) * 256; const float sc = isz ? 1.0f : 0.08838834764831845f * 1.4426950408889634f;
            if (isz) { GE_FOR_PERM({ const int tr = u.pm * 256 + row; const float r = r8[ai * 4 + m]; *(GAS u32x4*)(D + (size_t)tr * 512 + cb + col8) = pack8(silu4(acc[ai][bj][m][0] * r), silu4(acc[ai][bj][m][1] * r)); }) }
            else { GE_FOR_PERM({ const int tr = u.pm * 256 + row; const float r = r8[ai * 4 + m] * sc; *(GAS u32x4*)(D + (size_t)tr * 512 + cb + col8) = pack8(acc[ai][bj][m][0] * r, acc[ai][bj][m][1] * r); }) }
        }
    }
};
struct PS_Sched {
    int c; const unsigned char* ws;
    __device__ __forceinline__ bool unit(int i, Unit& u) const { if (i != 0 || c >= BATCH * NG) return false; u.type = 0; u.g = c % NG; u.pm = c / NG; u.pn = 0; return true; }
    __device__ __forceinline__ int nseg(const Unit&) const { return 1; }
    __device__ __forceinline__ void seg(const Unit& u, int, Seg& s) const {
        s.A = (const char*)((const bf16_t*)(ws + OFF_U) + ((size_t)u.g * 1024 + u.pm * 256) * 640); s.B = (const char*)((const bf16_t*)(ws + OFF_TAB + TAB_WST) + (size_t)u.g * 128 * 512);
        s.a_h = 128 * 1280; s.b_h = 128 * 1024; s.a_k = 128; s.b_k = 128; s.npairs = 4; s.amode = A_STD; s.bmode = B_STD; s.lda2 = 1280; s.ldb2 = 1024;
    }
};
struct PS_Epi {
    GAS unsigned char* ws;
    __device__ __forceinline__ void seg_end(Acc&, const Unit&, int, int, int, int, int) const {}
    __device__ __forceinline__ void finish(Acc&, const Unit&, int, int, int, int) const {}
    __device__ __forceinline__ void after_drain(Acc& acc, const Unit& u, LAS unsigned char* lds, int wr, int wc, int fr, int fq) const {
        LAS float* Sl = (LAS float*)lds;
#pragma unroll
        for (int ai = 0; ai < 2; ++ai)
#pragma unroll
            for (int m = 0; m < 4; ++m)
#pragma unroll
                for (int n = 0; n < 2; ++n) *(LAS f32x4*)(Sl + (ai * HALF + wr * 64 + m * 16 + fr) * 128 + wc * 32 + 16 * n + 4 * fq) = acc[ai][0][m][n];
        asm volatile("s_waitcnt lgkmcnt(0)" ::: "memory"); __builtin_amdgcn_s_barrier(); asm volatile("" ::: "memory");
        if (wr * 4 + wc == 0) {
            auto AQ = (const GAS float*)(ws + OFF_TAB + TAB_AQ); const int p = fq * 16 + fr; const float ar = AQ[(u.g * 64 + p) * 2], ai_ = AQ[(u.g * 64 + p) * 2 + 1];
            float xr = 0.f, xi = 0.f; auto up = (GAS bf16_t*)(ws + OFF_U) + ((size_t)u.g * 1024 + u.pm * 256) * 640 + 512 + p;
            for (int c0 = 0; c0 < 256; c0 += 8) {
                float sr[8], si[8];
#pragma unroll
                for (int j = 0; j < 8; ++j) { sr[j] = Sl[(c0 + j) * 128 + p]; si[j] = Sl[(c0 + j) * 128 + 64 + p]; }
#pragma unroll
                for (int j = 0; j < 8; ++j) {
                    up[(size_t)(c0 + j) * 640] = (bf16_t)f2bf(xr); up[(size_t)(c0 + j) * 640 + 64] = (bf16_t)f2bf(xi);
                    const float nxr = ar * xr - ai_ * xi + sr[j], nxi = ar * xi + ai_ * xr + si[j]; xr = nxr; xi = nxi;
                }
            }
        }
    }
};
struct PY_Sched {
    int c; const unsigned char* ws;
    __device__ __forceinline__ bool unit(int i, Unit& u) const { if (i > 1 || c >= BATCH * NG) return false; u.type = 0; u.pn = 1 - i; u.g = c % NG; u.pm = c / NG; return true; }
    __device__ __forceinline__ int nseg(const Unit&) const { return 2; }
    __device__ __forceinline__ void seg(const Unit& u, int si, Seg& s) const {
        const char* Arow = (const char*)((const bf16_t*)(ws + OFF_U) + ((size_t)u.g * 1024 + u.pm * 256) * 640);
        s.a_h = 128 * 1280; s.a_k = 128; s.amode = A_STD; s.lda2 = 1280;
        if (si == 0) { s.A = Arow; s.B = (const char*)((const bf16_t*)(ws + OFF_TAB + TAB_TOEP) + (size_t)u.g * 48 * 256) + (16 * u.pn + 13) * 512; s.b_h = 8 * 512; s.b_k = -2048; s.npairs = 2 * (u.pn + 1); s.bmode = B_TOEP; s.ldb2 = 0; }
        else { s.A = Arow + 1024; s.B = (const char*)((const bf16_t*)(ws + OFF_TAB + TAB_CST) + ((size_t)u.g * 512 + u.pn * 256) * 128); s.b_h = 128 * 256; s.b_k = 128; s.npairs = 1; s.bmode = B_PERM; s.ldb2 = 256; }
    }
};
struct PY_Epi {
    GAS unsigned char* ws;
    __device__ __forceinline__ void seg_end(Acc&, const Unit&, int, int, int, int, int) const {}
    __device__ __forceinline__ void after_drain(Acc&, const Unit&, LAS unsigned char*, int, int, int, int) const {}
    __device__ __forceinline__ void finish(Acc& acc, const Unit& u, int wr, int wc, int fr, int fq) const {
        auto base = (GAS bf16_t*)(ws + OFF_U) + ((size_t)u.g * 1024 + u.pm * 256) * 640 + u.pn * 256;
        GE_FOR_PERM({ *(GAS u32x4*)(base + (size_t)row * 640 + col8) = pack8(gelu4(acc[ai][bj][m][0]), gelu4(acc[ai][bj][m][1])); })
    }
};
struct PG_Sched {
    int G, c; const unsigned char *ws, *wl;
    __device__ __forceinline__ bool unit(int i, Unit& u) const { u.type = 0; u.g = 0; return static_tile(i, G, c, T / 256, 3, u.pm, u.pn); }
    __device__ __forceinline__ int nseg(const Unit&) const { return 1; }
    __device__ __forceinline__ void seg(const Unit& u, int, Seg& s) const {
        s.A = (const char*)(ws + OFF_U) + (size_t)u.pm * 8 * 1280; s.B = (const char*)(wl + WO_GLU) + (size_t)u.pn * 256 * 1536;
        s.a_h = 4 * 1280; s.a_k = 4 * 1024 * 1280; s.amode = A_GM; s.lda2 = 0; s.b_h = 128 * 1536; s.b_k = 128; s.bmode = B_PERM; s.ldb2 = 1536; s.npairs = 6;
    }
};
struct PG_Epi {
    GAS unsigned char* ws; const GAS float* b;
    __device__ __forceinline__ void seg_end(Acc&, const Unit&, int, int, int, int, int) const {}
    __device__ __forceinline__ void after_drain(Acc&, const Unit&, LAS unsigned char*, int, int, int, int) const {}
    __device__ __forceinline__ void finish(Acc& acc, const Unit& u, int wr, int wc, int fr, int fq) const {
        auto Y = (const GAS bf16_t*)(ws + OFF_U); auto ZS = (GAS bf16_t*)(ws + OFF_ZS);
        f32x4 bb[2][2];
#pragma unroll
        for (int j = 0; j < 2; ++j) { const int c = u.pn * 256 + j * HALF + wc * 32 + 8 * fq; bb[j][0] = *(const GAS f32x4*)(b + c); bb[j][1] = *(const GAS f32x4*)(b + c + 4); }
#pragma unroll
        for (int ai = 0; ai < 2; ++ai)
#pragma unroll
            for (int bj = 0; bj < 2; ++bj) {
                u32x4 yv[4], zv[4]; const int c = u.pn * 256 + bj * HALF + wc * 32 + 8 * fq;
#pragma unroll
                for (int m = 0; m < 4; ++m) { const int tr = u.pm * 256 + ai * HALF + wr * 64 + m * 16 + fr;
                    yv[m] = *(const GAS u32x4*)(Y + ((size_t)(c >> 4) * 1024 + (tr >> 5)) * 640 + (tr & 31) * 16 + (c & 15)); zv[m] = *(const GAS u32x4*)(ZS + (size_t)tr * 768 + c); }
#pragma unroll
                for (int m = 0; m < 4; ++m) { const int tr = u.pm * 256 + ai * HALF + wr * 64 + m * 16 + fr; f32x4 y0, y1, z0, z1; unpack8(yv[m], y0, y1); unpack8(zv[m], z0, z1);
                    *(GAS u32x4*)(ZS + (size_t)tr * 768 + c) = pack8(y0 * sigm4(acc[ai][bj][m][0] + bb[bj][0]) * z0, y1 * sigm4(acc[ai][bj][m][1] + bb[bj][1]) * z1); }
            }
    }
};
struct PM_Sched {
    int G, c; const unsigned char *ws, *wl;
    __device__ __forceinline__ bool unit(int i, Unit& u) const { const int t = i / 6; u.type = i - 6 * t; u.g = 0; return static_tile(t, G, c, T / 256, 4, u.pm, u.pn); }
    __device__ __forceinline__ int nseg(const Unit&) const { return 1; }
    __device__ __forceinline__ void seg(const Unit& u, int, Seg& s) const {
        s.a_k = 128; s.b_k = 128; s.amode = A_STD; s.bmode = B_PERM;
        if ((u.type & 1) == 0) { s.A = (const char*)(ws + OFF_XB) + (size_t)u.pm * 256 * 2048; s.B = (const char*)(wl + WO_IN) + (size_t)(N_A1 + (u.type >> 1) * 1024 + u.pn * 256) * 2048; s.lda2 = 2048; s.ldb2 = 2048; s.npairs = 8; }
        else if (u.type == 1) { s.A = (const char*)(ws + OFF_ZS) + (size_t)u.pm * 256 * 1536; s.B = (const char*)(wl + WO_B1) + (size_t)u.pn * 256 * 1536; s.lda2 = 1536; s.ldb2 = 1536; s.npairs = 6; }
        else if (u.type == 3) { s.A = (const char*)(ws + OFF_Q) + (size_t)u.pm * 256 * 1536; s.B = (const char*)(wl + WO_B2) + (size_t)u.pn * 256 * 1536; s.lda2 = 1536; s.ldb2 = 1536; s.npairs = 6; }
        else { s.A = (const char*)(ws + OFF_QM) + (size_t)u.pm * 256 * 1024; s.B = (const char*)(wl + WO_B3) + (size_t)u.pn * 256 * 1024; s.lda2 = 1024; s.ldb2 = 1024; s.npairs = 4; }
        s.a_h = 128 * (int)s.lda2; s.b_h = 128 * (int)s.ldb2;
    }
};
typedef _Float16 f16x8 __attribute__((ext_vector_type(8)));
struct PM_Epi {
    GAS unsigned char* ws; const GAS float* bg; int c, l;
    __device__ __forceinline__ void seg_end(Acc&, const Unit&, int, int, int, int, int) const {}
    __device__ __forceinline__ void after_drain(Acc&, const Unit&, LAS unsigned char*, int, int, int, int) const {}
    __device__ __forceinline__ void finish(Acc& acc, const Unit& u, int wr, int wc, int fr, int fq) const {
        const int t_ = (wr * 4 + wc) * 64 + fq * 16 + fr;
        GAS unsigned char* st = (ws + OFF_V + (size_t)c * 262144);
        if ((u.type & 1) == 0) {
            auto bgs = bg + (u.type >> 1) * 1024 + u.pn * 256;
            float r8[8]; f32x4 bb[2][2];
            load_rs8(ws, u.pm * 256, wr, fr, r8);
#pragma unroll
            for (int j = 0; j < 2; ++j) { bb[j][0] = *(const GAS f32x4*)(bgs + j * HALF + wc * 32 + 8 * fq); bb[j][1] = *(const GAS f32x4*)(bgs + j * HALF + wc * 32 + 8 * fq + 4); }
            GE_FOR_PERM({ (void)row; (void)col8; const float r = r8[ai * 4 + m]; const f32x4 b0 = bb[bj][0], b1 = bb[bj][1];
                const f32x4 g0 = sigm4(acc[ai][bj][m][0] * r + b0), g1 = sigm4(acc[ai][bj][m][1] * r + b1); f16x8 h;
                h[0] = (_Float16)g0[0]; h[1] = (_Float16)g0[1]; h[2] = (_Float16)g0[2]; h[3] = (_Float16)g0[3]; h[4] = (_Float16)g1[0]; h[5] = (_Float16)g1[1]; h[6] = (_Float16)g1[2]; h[7] = (_Float16)g1[3];
                *(GAS f16x8*)(st + ((ai * 2 + bj) * 4 + m) * 8192 + t_ * 16) = h; })
        } else if (u.type == 1) branch_fin<false, false>(acc, u, st, t_, wr, wc, fr, fq);
        else if (u.type == 3) branch_fin<true, false>(acc, u, st, t_, wr, wc, fr, fq);
        else branch_fin<true, true>(acc, u, st, t_, wr, wc, fr, fq);
    }
    template <bool ADD, bool LAST>
    __device__ __forceinline__ void branch_fin(Acc& acc, const Unit& u, GAS unsigned char* st, int t_, int wr, int wc, int fr, int fq) const {
#pragma unroll
        for (int ai = 0; ai < 2; ++ai)
#pragma unroll
            for (int bj = 0; bj < 2; ++bj) {
                f16x8 h[4], pp[4];
#pragma unroll
                for (int m = 0; m < 4; ++m) { const int idx = (ai * 2 + bj) * 4 + m; h[m] = *(const GAS f16x8*)(st + idx * 8192 + t_ * 16);
                    if (ADD) pp[m] = *(const GAS f16x8*)(st + 131072 + idx * 8192 + t_ * 16); }
#pragma unroll
                for (int m = 0; m < 4; ++m) { const int idx = (ai * 2 + bj) * 4 + m; f32x4 v0 = acc[ai][bj][m][0], v1 = acc[ai][bj][m][1];
#pragma unroll
                    for (int e2 = 0; e2 < 4; ++e2) { v0[e2] *= (float)h[m][e2]; v1[e2] *= (float)h[m][4 + e2]; }
                    if (ADD) {
#pragma unroll
                        for (int e2 = 0; e2 < 4; ++e2) { v0[e2] += (float)pp[m][e2]; v1[e2] += (float)pp[m][4 + e2]; } }
                    if (!LAST) { f16x8 o; o[0] = (_Float16)v0[0]; o[1] = (_Float16)v0[1]; o[2] = (_Float16)v0[2]; o[3] = (_Float16)v0[3]; o[4] = (_Float16)v1[0]; o[5] = (_Float16)v1[1]; o[6] = (_Float16)v1[2]; o[7] = (_Float16)v1[3];
                        *(GAS f16x8*)(st + 131072 + idx * 8192 + t_ * 16) = o; }
                    else { const int row = ai * HALF + wr * 64 + m * 16 + fr, col8 = bj * HALF + wc * 32 + 8 * fq;
                        *(GAS u32x4*)((GAS bf16_t*)(ws + OFF_MERGED) + (size_t)(u.pm * 256 + row) * 1024 + u.pn * 256 + col8) = pack8(v0, v1); } }
            }
    }
};
struct PO_Sched {
    int G, c; const unsigned char *ws, *wl;
    __device__ __forceinline__ bool unit(int i, Unit& u) const { u.type = 0; u.g = 0; return static_tile(i, G, c, T / 256, 4, u.pm, u.pn); }
    __device__ __forceinline__ int nseg(const Unit&) const { return 1; }
    __device__ __forceinline__ void seg(const Unit& u, int, Seg& s) const {
        s.A = (const char*)(ws + OFF_MERGED) + (size_t)u.pm * 256 * 2048; s.B = (const char*)(wl + WO_OUT) + (size_t)u.pn * 256 * 2048;
        s.a_h = 128 * 2048; s.b_h = 128 * 2048; s.a_k = 128; s.b_k = 128; s.npairs = 8; s.amode = A_STD; s.bmode = B_STD; s.lda2 = 2048; s.ldb2 = 2048;
    }
};
struct PO_Epi {
    const GAS float* xold; GAS float* xnew; GAS unsigned char* ws; int l;
    __device__ __forceinline__ void seg_end(Acc&, const Unit&, int, int, int, int, int) const {}
    __device__ __forceinline__ void after_drain(Acc&, const Unit&, LAS unsigned char*, int, int, int, int) const {}
    template <bool NEXT>
    __device__ __forceinline__ void fin(Acc& acc, const Unit& u, int wr, int wc, int fr, int fq) const {
        LAS float* part = (LAS float*)(size_t)RING_BYTES;
        auto XBo = (GAS bf16_t*)(ws + OFF_XB);
#pragma unroll
        for (int ai = 0; ai < 2; ++ai)
#pragma unroll
            for (int mh = 0; mh < 2; ++mh) {
                f32x4 xo[2][2][2];
#pragma unroll
                for (int mm = 0; mm < 2; ++mm) { const int m = mh * 2 + mm; const size_t ro = (size_t)(u.pm * 256 + ai * HALF + wr * 64 + m * 16 + fr) * 1024 + u.pn * 256 + wc * 32 + 4 * fq;
#pragma unroll
                    for (int bj = 0; bj < 2; ++bj)
#pragma unroll
                        for (int n = 0; n < 2; ++n) xo[mm][bj][n] = *(const GAS f32x4*)(xold + ro + bj * HALF + n * 16); }
#pragma unroll
                for (int mm = 0; mm < 2; ++mm) { const int m = mh * 2 + mm, row = ai * HALF + wr * 64 + m * 16 + fr; const size_t ro = (size_t)(u.pm * 256 + row) * 1024 + u.pn * 256 + wc * 32 + 4 * fq; float sq = 0.f;
#pragma unroll
                    for (int bj = 0; bj < 2; ++bj)
#pragma unroll
                        for (int n = 0; n < 2; ++n) { const size_t o = ro + bj * HALF + n * 16; const f32x4 v = xo[mm][bj][n] + acc[ai][bj][m][n]; *(GAS f32x4*)(xnew + o) = v;
                            if (NEXT) { *(GAS u32x2*)(XBo + o) = (u32x2){cvt_pk_bf16(v[0], v[1]), cvt_pk_bf16(v[2], v[3])}; sq += (v[0] * v[0] + v[1] * v[1]) + (v[2] * v[2] + v[3] * v[3]); } }
                    if (NEXT) { sq += __shfl_xor(sq, 16); sq += __shfl_xor(sq, 32); if (fq == 0) part[row * 4 + wc] = sq; } }
            }
        if (NEXT) {
            asm volatile("s_waitcnt lgkmcnt(0)" ::: "memory"); __builtin_amdgcn_s_barrier(); asm volatile("" ::: "memory");
            const int t = (wr * 4 + wc) * 64 + fq * 16 + fr;
            if (t < 256) { const f32x4 p = *(const LAS f32x4*)(part + t * 4); ((GAS float*)(ws + OFF_ROWSQ))[(size_t)(u.pm * 256 + t) * 4 + u.pn] = (p.x + p.y) + (p.z + p.w); }
            asm volatile("s_waitcnt lgkmcnt(0)" ::: "memory"); __builtin_amdgcn_s_barrier(); asm volatile("" ::: "memory");
        }
    }
    __device__ __forceinline__ void finish(Acc& acc, const Unit& u, int wr, int wc, int fr, int fq) const { if (l == 0) fin<true>(acc, u, wr, wc, fr, fq); else fin<false>(acc, u, wr, wc, fr, fq); }
};
}

__device__ __forceinline__ void cpow(float lmag, double rev1, int k, float& re, float& im) {
    const float m = expf((float)k * lmag); double r = (double)k * rev1; r -= rint(r);
    const float a = (float)(r * 6.283185307179586476925286766559); re = m * cosf(a); im = m * sinf(a);
}
__device__ __forceinline__ void tabgen(unsigned char* tab, const float* __restrict__ lam_re, const float* __restrict__ lam_im, const float* __restrict__ log_dt, const float* __restrict__ b_re, const float* __restrict__ b_im,
                                       const float* __restrict__ c_re, const float* __restrict__ c_im, const float* __restrict__ dvec, LAS float* scr, int gw, int ngw, int lane) {
    bf16_t* TOEP = (bf16_t*)(tab + TAB_TOEP); bf16_t* CST = (bf16_t*)(tab + TAB_CST); bf16_t* WST = (bf16_t*)(tab + TAB_WST); float* AQ = (float*)(tab + TAB_AQ);
    for (int item = gw; item < NG * 32; item += ngw) {
        const int g = item >> 5, d = item & 31, p = lane;
        const float dt = expf(log_dt[g]); const float lre = lam_re[g * 64 + p], lim = lam_im[g * 64 + p];
        const float lmag = lre * dt; const double rev1 = (double)lim * (double)dt * 0.15915494309189533576888376337251;
        float fr, fi;
        {
            double r = rev1; r -= rint(r); const float bq = (float)(r * 6.283185307179586476925286766559);
            const float em1 = expm1f(lmag), sb2 = sinf(0.5f * bq); const float nr = em1 * cosf(bq) - 2.f * sb2 * sb2, ni = (em1 + 1.f) * sinf(bq);
            const float den = lre * lre + lim * lim; fr = (nr * lre + ni * lim) / den; fi = (ni * lre - nr * lim) / den;
        }
        float bbr[16], bbi[16];
#pragma unroll
        for (int h = 0; h < 16; ++h) { const float br = b_re[(g * 64 + p) * 16 + h], bi = b_im[(g * 64 + p) * 16 + h]; bbr[h] = fr * br - fi * bi; bbi[h] = fr * bi + fi * br; }
        float pr, pi;
        cpow(lmag, rev1, 31 - d, pr, pi);
        {
            unsigned wre[8], wim[8];
#pragma unroll
            for (int h = 0; h < 16; h += 2) { wre[h >> 1] = pk2(pr * bbr[h] - pi * bbi[h], pr * bbr[h + 1] - pi * bbi[h + 1]); wim[h >> 1] = pk2(pr * bbi[h] + pi * bbr[h], pr * bbi[h + 1] + pi * bbr[h + 1]); }
            u32x4* o0 = (u32x4*)(WST + ((size_t)g * 128 + p) * 512 + d * 16); u32x4* o1 = (u32x4*)(WST + ((size_t)g * 128 + 64 + p) * 512 + d * 16);
            o0[0] = (u32x4){wre[0], wre[1], wre[2], wre[3]}; o0[1] = (u32x4){wre[4], wre[5], wre[6], wre[7]};
            o1[0] = (u32x4){wim[0], wim[1], wim[2], wim[3]}; o1[1] = (u32x4){wim[4], wim[5], wim[6], wim[7]};
        }
        cpow(lmag, rev1, d + 1, pr, pi);
#pragma unroll 2
        for (int hq = 0; hq < 16; ++hq) { const float cr = c_re[(g * 16 + hq) * 64 + p], ci = c_im[(g * 16 + hq) * 64 + p];
            bf16_t* o = CST + ((size_t)g * 512 + d * 16 + hq) * 128; o[p] = (bf16_t)f2bf(cr * pr - ci * pi); o[64 + p] = (bf16_t)f2bf(-(cr * pi + ci * pr)); }
        cpow(lmag, rev1, d, pr, pi);
#pragma unroll
        for (int h = 0; h < 16; ++h) { scr[(p * 16 + h) * 2] = pr * bbr[h] - pi * bbi[h]; scr[(p * 16 + h) * 2 + 1] = pr * bbi[h] + pi * bbr[h]; }
        asm volatile("s_waitcnt lgkmcnt(0)" ::: "memory");
        {
            const int hq = lane >> 2, h0 = (lane & 3) * 4; float a0 = 0.f, a1 = 0.f, a2 = 0.f, a3 = 0.f;
            for (int q = 0; q < 64; ++q) { const float cr = c_re[(g * 16 + hq) * 64 + q], ci = c_im[(g * 16 + hq) * 64 + q]; const LAS float* s = scr + (q * 16 + h0) * 2;
                a0 += cr * s[0] - ci * s[1]; a1 += cr * s[2] - ci * s[3]; a2 += cr * s[4] - ci * s[5]; a3 += cr * s[6] - ci * s[7]; }
            if (d == 0) { const float dd = dvec[g * 16 + hq]; if (hq == h0) a0 += dd; if (hq == h0 + 1) a1 += dd; if (hq == h0 + 2) a2 += dd; if (hq == h0 + 3) a3 += dd; }
            *(u32x2*)(TOEP + ((size_t)g * 48 + 16 + d) * 256 + hq * 16 + h0) = (u32x2){pk2(a0, a1), pk2(a2, a3)};
            if (d < 16) *(u32x2*)(TOEP + ((size_t)g * 48 + d) * 256 + hq * 16 + h0) = (u32x2){0u, 0u};
        }
        asm volatile("s_waitcnt lgkmcnt(0)" ::: "memory");
        if (d == 0) { cpow(lmag, rev1, 32, pr, pi); AQ[(g * 64 + p) * 2] = pr; AQ[(g * 64 + p) * 2 + 1] = pi; }
    }
}

namespace at {
__device__ __forceinline__ int crow(int r, int hi) { return (r & 3) + 8 * (r >> 2) + 4 * hi; }
__device__ __forceinline__ unsigned cvtpk(float lo, float hi) { unsigned r; asm volatile("v_cvt_pk_bf16_f32 %0, %1, %2" : "=v"(r) : "v"(lo), "v"(hi)); return r; }
constexpr float LOG2E = 1.4426950408889634f, LN2 = 0.6931471805599453f;
constexpr size_t OFF_BIASR = 768 * 1024;
constexpr int D_VTS = 388;
constexpr int D_LK = 0, D_LVT = 49152, D_LBIAS = D_LVT + 64 * D_VTS * 2, D_LSCR = D_LBIAS + 1024, D_LEND = D_LSCR + 8 * 128;
static_assert(D_LEND <= 146432, "dilated attention LDS");
struct DilUnit { int b, head, r, s, np; };
__device__ __forceinline__ DilUnit dil_decode(int ui) { DilUnit u; const int u32i = ui & 31, bh = ui >> 5; u.head = bh % NH; u.b = bh / NH; const int grp = u.head >> 2; u.r = grp == 0 ? 1 : (grp == 1 ? 4 : 16); const int ppr = 32 / u.r; u.s = u32i / ppr; u.np = u32i % ppr; return u; }
struct DilPref { u32x4 k[6], v0[3], v1[3]; };
__device__ __forceinline__ void dil_prefetch(DilPref& p, GAS unsigned char* ws, const DilUnit& u, int tid) {
    const GAS bf16_t* Kb = (const GAS bf16_t*)(ws + OFF_K); const GAS bf16_t* V = (const GAS bf16_t*)(ws + OFF_V);
    const size_t rowbase = (size_t)u.b * SEQ; const int mk0 = u.np * 256 - 128;
#pragma unroll
    for (int i = 0; i < 6; ++i) { const int idx = tid + 512 * i, key = idx >> 3, ch = idx & 7; int mk = mk0 + key; mk = mk < 0 ? 0 : mk;
        p.k[i] = *(const GAS u32x4*)(Kb + (rowbase + (size_t)mk * u.r + u.s) * 768 + u.head * 64 + ch * 8); }
#pragma unroll
    for (int i = 0; i < 3; ++i) { const int idx = tid + 512 * i, key = (idx >> 3) * 2, ch = idx & 7; int mk = mk0 + key; mk = mk < 0 ? 0 : mk;
        const GAS bf16_t* vp = V + (rowbase + (size_t)mk * u.r + u.s) * 768 + u.head * 64 + ch * 8; p.v0[i] = *(const GAS u32x4*)vp; p.v1[i] = *(const GAS u32x4*)(vp + (size_t)u.r * 768); }
}
__device__ __forceinline__ void dil_stage(LAS unsigned char* lds, const DilPref& p, int tid) {
#pragma unroll
    for (int i = 0; i < 6; ++i) { const int idx = tid + 512 * i, key = idx >> 3, ch = idx & 7; *(LAS u32x4*)(lds + D_LK + key * 128 + ((ch ^ ((key >> 1) & 7)) << 4)) = p.k[i]; }
#pragma unroll
    for (int i = 0; i < 3; ++i) { const int idx = tid + 512 * i, key = (idx >> 3) * 2, ch = idx & 7; const u32x4 v0 = p.v0[i], v1 = p.v1[i];
        LAS unsigned* vt = (LAS unsigned*)(lds + D_LVT + ((ch * 8) * D_VTS + key) * 2);
        vt[0 * (D_VTS / 2)] = (v0.x & 0xffffu) | (v1.x << 16); vt[1 * (D_VTS / 2)] = (v0.x >> 16) | (v1.x & 0xffff0000u);
        vt[2 * (D_VTS / 2)] = (v0.y & 0xffffu) | (v1.y << 16); vt[3 * (D_VTS / 2)] = (v0.y >> 16) | (v1.y & 0xffff0000u);
        vt[4 * (D_VTS / 2)] = (v0.z & 0xffffu) | (v1.z << 16); vt[5 * (D_VTS / 2)] = (v0.z >> 16) | (v1.z & 0xffff0000u);
        vt[6 * (D_VTS / 2)] = (v0.w & 0xffffu) | (v1.w << 16); vt[7 * (D_VTS / 2)] = (v0.w >> 16) | (v1.w & 0xffff0000u); }
}
__device__ __forceinline__ void dil_unit(LAS unsigned char* lds, GAS unsigned char* ws, const DilUnit& u, DilPref& pre, bool has_next, const DilUnit& nu, int tid) {
    const int lane = tid & 63, wave = __builtin_amdgcn_readfirstlane(tid >> 6), r32 = lane & 31, hi = lane >> 5;
    GAS bf16_t* Q = (GAS bf16_t*)(ws + OFF_Q); GAS float* lse = (GAS float*)(ws + OFF_LSE);
    const size_t rowbase = (size_t)u.b * SEQ; const int M0 = u.np * 256; const int r = u.r, s = u.s, head = u.head;
    dil_stage(lds, pre, tid);
    if (tid < 196) ((LAS float*)(lds + D_LBIAS))[tid] = ((const GAS float*)(ws + OFF_BIASR))[head * 196 + tid];
    const size_t qtok = rowbase + (size_t)(M0 + 32 * wave + r32) * r + s;
    bf16x8 qf[4];
#pragma unroll
    for (int ks = 0; ks < 4; ++ks) qf[ks] = *(const GAS bf16x8*)(Q + qtok * 768 + head * 64 + 16 * ks + 8 * hi);
    asm volatile("s_waitcnt lgkmcnt(0)\n\ts_barrier" ::: "memory");
    if (has_next) dil_prefetch(pre, ws, nu, tid);
    const int tskip = u.np == 0 ? 4 - wave : 0;
    const int L0 = r32 - 4 * hi;
    const LAS float* bl = (const LAS float*)(lds + D_LBIAS) + (31 - L0);
    f32x16 S[5];
#pragma unroll
    for (int t = 0; t < 5; ++t)
#pragma unroll
        for (int q = 0; q < 16; ++q) S[t][q] = bl[32 * t + (q & 3) + 8 * (q >> 2)];
#pragma unroll
    for (int t = 0; t < 5; ++t) {
        const int key = 32 * (wave + t) + r32; const LAS unsigned char* kp = lds + D_LK + key * 128; const int sw = (key >> 1) & 7;
        bf16x8 kf[4];
#pragma unroll
        for (int ks = 0; ks < 4; ++ks) kf[ks] = *(const LAS bf16x8*)(kp + (((2 * ks + hi) ^ sw) << 4));
#pragma unroll
        for (int ks = 0; ks < 4; ++ks) S[t] = __builtin_amdgcn_mfma_f32_32x32x16_bf16(kf[ks], qf[ks], S[t], 0, 0, 0);
    }
    float mx = -1e30f;
#pragma unroll
    for (int t = 0; t < 5; ++t) {
        const bool dead = t < tskip;
#pragma unroll
        for (int q = 0; q < 16; ++q) { const int cq = (q & 3) + 8 * (q >> 2); float v = S[t][q];
            if (t == 0) v = cq >= L0 ? v : -1e30f;
            if (t == 4) v = cq <= L0 ? v : -1e30f;
            v = dead ? -1e30f : v; S[t][q] = v; mx = fmaxf(mx, v); }
    }
    mx = fmaxf(mx, __shfl_xor(mx, 32));
    float lsum = 0.f; unsigned pk[5][8];
#pragma unroll
    for (int t = 0; t < 5; ++t) {
#pragma unroll
        for (int q = 0; q < 16; ++q) { const float p = __builtin_amdgcn_exp2f(S[t][q] - mx); S[t][q] = p; lsum += p; }
#pragma unroll
        for (int q = 0; q < 8; ++q) pk[t][q] = cvtpk(S[t][2 * q], S[t][2 * q + 1]);
    }
    lsum += __shfl_xor(lsum, 32);
    f32x16 O[2];
#pragma unroll
    for (int d0 = 0; d0 < 2; ++d0)
#pragma unroll
        for (int q = 0; q < 16; ++q) O[d0][q] = 0.f;
#pragma unroll
    for (int t = 0; t < 5; ++t) {
        u32x2 vf[2][2][2];
#pragma unroll
        for (int s2 = 0; s2 < 2; ++s2)
#pragma unroll
            for (int d0 = 0; d0 < 2; ++d0) { const LAS unsigned char* vp = lds + D_LVT + ((32 * d0 + r32) * D_VTS + 32 * (wave + t) + 16 * s2 + 4 * hi) * 2; vf[s2][d0][0] = *(const LAS u32x2*)vp; vf[s2][d0][1] = *(const LAS u32x2*)(vp + 16); }
#pragma unroll
        for (int s2 = 0; s2 < 2; ++s2) {
            const bf16x8 Pf = __builtin_bit_cast(bf16x8, (u32x4){pk[t][4 * s2], pk[t][4 * s2 + 1], pk[t][4 * s2 + 2], pk[t][4 * s2 + 3]});
#pragma unroll
            for (int d0 = 0; d0 < 2; ++d0)
                O[d0] = __builtin_amdgcn_mfma_f32_32x32x16_bf16(__builtin_bit_cast(bf16x8, (u32x4){vf[s2][d0][0].x, vf[s2][d0][0].y, vf[s2][d0][1].x, vf[s2][d0][1].y}), Pf, O[d0], 0, 0, 0);
        }
    }
    const float ri = __builtin_amdgcn_rcpf(lsum);
    if (hi == 0) lse[qtok * NH + head] = (mx + __builtin_amdgcn_logf(lsum)) * LN2;
    GAS bf16_t* op = Q + qtok * 768 + head * 64 + 4 * hi;
#pragma unroll
    for (int d0 = 0; d0 < 2; ++d0)
#pragma unroll
        for (int g4 = 0; g4 < 4; ++g4)
            *(GAS u32x2*)(op + 32 * d0 + 8 * g4) = (u32x2){cvtpk(O[d0][4 * g4] * ri, O[d0][4 * g4 + 1] * ri), cvtpk(O[d0][4 * g4 + 2] * ri, O[d0][4 * g4 + 3] * ri)};
    asm volatile("s_waitcnt lgkmcnt(0)\n\ts_barrier" ::: "memory");
}
constexpr int M_VTS = 260;
constexpr int M_LK = 0, M_LVT = 65536, M_LSCR = M_LVT + 128 * M_VTS * 2, M_LEND = M_LSCR + 8 * 128;
static_assert(M_LEND <= 146432, "memory attention LDS");
__device__ __forceinline__ void mem_job(LAS unsigned char* lds, GAS unsigned char* ws, int l, int b, int head, int qb0, int nqb, int tid) {
    const int lane = tid & 63, wave = __builtin_amdgcn_readfirstlane(tid >> 6), r32 = lane & 31, hi = lane >> 5;
    GAS bf16_t* QM = (GAS bf16_t*)(ws + OFF_QM); const GAS bf16_t* ZM = (const GAS bf16_t*)(ws + OFF_ZM); const GAS bf16_t* KVM = (const GAS bf16_t*)(ws + OFF_KVM + (size_t)l * 2 * MiB) + (size_t)b * 256 * 1024 + head * 128;
    {
        u32x4 kk[8], v0[4], v1[4];
#pragma unroll
        for (int i = 0; i < 8; ++i) { const int idx = tid + 512 * i, key = idx >> 4, ch = idx & 15; kk[i] = *(const GAS u32x4*)(KVM + (size_t)key * 1024 + ch * 8); }
#pragma unroll
        for (int i = 0; i < 4; ++i) { const int idx = tid + 512 * i, key = (idx >> 4) * 2, ch = idx & 15; const GAS bf16_t* vp = KVM + (size_t)key * 1024 + 512 + ch * 8; v0[i] = *(const GAS u32x4*)vp; v1[i] = *(const GAS u32x4*)(vp + 1024); }
#pragma unroll
        for (int i = 0; i < 8; ++i) { const int idx = tid + 512 * i, key = idx >> 4, ch = idx & 15; *(LAS u32x4*)(lds + M_LK + key * 256 + ((ch ^ (key & 15)) << 4)) = kk[i]; }
#pragma unroll
        for (int i = 0; i < 4; ++i) { const int idx = tid + 512 * i, key = (idx >> 4) * 2, ch = idx & 15;
            LAS unsigned* vt = (LAS unsigned*)(lds + M_LVT + ((ch * 8) * M_VTS + key) * 2);
            vt[0 * (M_VTS / 2)] = (v0[i].x & 0xffffu) | (v1[i].x << 16); vt[1 * (M_VTS / 2)] = (v0[i].x >> 16) | (v1[i].x & 0xffff0000u);
            vt[2 * (M_VTS / 2)] = (v0[i].y & 0xffffu) | (v1[i].y << 16); vt[3 * (M_VTS / 2)] = (v0[i].y >> 16) | (v1[i].y & 0xffff0000u);
            vt[4 * (M_VTS / 2)] = (v0[i].z & 0xffffu) | (v1[i].z << 16); vt[5 * (M_VTS / 2)] = (v0[i].z >> 16) | (v1[i].z & 0xffff0000u);
            vt[6 * (M_VTS / 2)] = (v0[i].w & 0xffffu) | (v1[i].w << 16); vt[7 * (M_VTS / 2)] = (v0[i].w >> 16) | (v1[i].w & 0xffff0000u); }
    }
    __syncthreads();
    for (int j = 0; j < nqb; ++j) {
        const size_t qrow0 = (size_t)b * SEQ + (qb0 + j) * 256 + 32 * wave;
        bf16x8 qf[8];
#pragma unroll
        for (int ks = 0; ks < 8; ++ks) qf[ks] = *(const GAS bf16x8*)(QM + (qrow0 + r32) * 512 + head * 128 + 16 * ks + 8 * hi);
        f32x16 S[8];
#pragma unroll
        for (int t = 0; t < 8; ++t)
#pragma unroll
            for (int q = 0; q < 16; ++q) S[t][q] = 0.f;
#pragma unroll
        for (int ks = 0; ks < 8; ++ks) {
#pragma unroll
            for (int th = 0; th < 2; ++th) {
                bf16x8 kf[4];
#pragma unroll
                for (int t = 0; t < 4; ++t) { const int key = 32 * (4 * th + t) + r32; kf[t] = *(const LAS bf16x8*)(lds + M_LK + key * 256 + (((2 * ks + hi) ^ (key & 15)) << 4)); }
#pragma unroll
                for (int t = 0; t < 4; ++t) S[4 * th + t] = __builtin_amdgcn_mfma_f32_32x32x16_bf16(kf[t], qf[ks], S[4 * th + t], 0, 0, 0);
            }
        }
        float mx = -1e30f;
#pragma unroll
        for (int t = 0; t < 8; ++t)
#pragma unroll
            for (int q = 0; q < 16; ++q) mx = fmaxf(mx, S[t][q]);
        mx = fmaxf(mx, __shfl_xor(mx, 32));
        float lsum = 0.f; unsigned pk[8][8];
#pragma unroll
        for (int t = 0; t < 8; ++t) {
#pragma unroll
            for (int q = 0; q < 16; ++q) { const float p = __builtin_amdgcn_exp2f(S[t][q] - mx); S[t][q] = p; lsum += p; }
#pragma unroll
            for (int q = 0; q < 8; ++q) pk[t][q] = cvtpk(S[t][2 * q], S[t][2 * q + 1]);
        }
        lsum += __shfl_xor(lsum, 32);
        f32x16 O[4];
#pragma unroll
        for (int d0 = 0; d0 < 4; ++d0)
#pragma unroll
            for (int q = 0; q < 16; ++q) O[d0][q] = 0.f;
#pragma unroll
        for (int t = 0; t < 8; ++t)
#pragma unroll
            for (int s2 = 0; s2 < 2; ++s2) {
                const bf16x8 Pf = __builtin_bit_cast(bf16x8, (u32x4){pk[t][4 * s2], pk[t][4 * s2 + 1], pk[t][4 * s2 + 2], pk[t][4 * s2 + 3]});
                u32x2 vf[4][2];
#pragma unroll
                for (int d0 = 0; d0 < 4; ++d0) { const LAS unsigned char* vp = lds + M_LVT + ((32 * d0 + r32) * M_VTS + 32 * t + 16 * s2 + 4 * hi) * 2; vf[d0][0] = *(const LAS u32x2*)vp; vf[d0][1] = *(const LAS u32x2*)(vp + 16); }
#pragma unroll
                for (int d0 = 0; d0 < 4; ++d0) O[d0] = __builtin_amdgcn_mfma_f32_32x32x16_bf16(__builtin_bit_cast(bf16x8, (u32x4){vf[d0][0].x, vf[d0][0].y, vf[d0][1].x, vf[d0][1].y}), Pf, O[d0], 0, 0, 0);
            }
        const float ri = __builtin_amdgcn_rcpf(lsum); const size_t go = (qrow0 + r32) * 512 + head * 128 + 4 * hi;
        u32x2 zz[4][4];
#pragma unroll
        for (int d0 = 0; d0 < 4; ++d0)
#pragma unroll
            for (int g4 = 0; g4 < 4; ++g4) zz[d0][g4] = *(const GAS u32x2*)(ZM + go + 32 * d0 + 8 * g4);
#pragma unroll
        for (int d0 = 0; d0 < 4; ++d0)
#pragma unroll
            for (int g4 = 0; g4 < 4; ++g4) { const u32x2 z = zz[d0][g4];
                *(GAS u32x2*)(QM + go + 32 * d0 + 8 * g4) = (u32x2){cvtpk(O[d0][4 * g4] * ri * bflo(z.x), O[d0][4 * g4 + 1] * ri * bfhi(z.x)), cvtpk(O[d0][4 * g4 + 2] * ri * bflo(z.y), O[d0][4 * g4 + 3] * ri * bfhi(z.y))}; }
    }
    __syncthreads();
}
}

constexpr int PTR_OFF = MISC_OFF + 256;
__device__ __forceinline__ const float* ld_inptr(LAS unsigned char* lds, int k) {
    const unsigned long long v = ((volatile LAS unsigned long long*)(lds + PTR_OFF))[k];
    const unsigned lo = __builtin_amdgcn_readfirstlane((unsigned)v), hi = __builtin_amdgcn_readfirstlane((unsigned)(v >> 32));
    return (const float*)(GAS const float*)(((unsigned long long)hi << 32) | lo);
}
struct Args { const float* in[23]; float* out; unsigned char* ws; int ph_lo, ph_hi; };
__global__ void __launch_bounds__(NTHREADS, 2) mega_fwd(Args args) {
    extern __shared__ __attribute__((aligned(16))) unsigned char lds_raw[];
    LAS unsigned char* lds = (LAS unsigned char*)lds_raw;
    const int G_ = gridDim.x, ngw = G_ * NWAVES;
#define PHASE_IDS() const int tid = fresh_tid(), lane = tid & 63, wave = __builtin_amdgcn_readfirstlane(tid >> 6), cb = fresh_bid(), gw = cb * NWAVES + wave; (void)lane; (void)gw; (void)tid; \
        GAS unsigned char* ws = (GAS unsigned char*)fresh_ptr(args.ws); GAS unsigned char* out_p = (GAS unsigned char*)fresh_ptr((unsigned char*)args.out); (void)ws; (void)out_p
    for (int u = threadIdx.x; u < (LDS_BYTES - LDSCTL_OFF) / 4; u += NTHREADS) ((LAS unsigned*)(lds + LDSCTL_OFF))[u] = 0u;
    __syncthreads();
    if (threadIdx.x == 0) {
#pragma unroll
        for (int k = 0; k < 23; ++k) ((volatile LAS unsigned long long*)(lds + PTR_OFF))[k] = (unsigned long long)args.in[k];
    }
    __syncthreads();
#define INP(k) ld_inptr(lds, k)
    XcdBarrier bar = xcd_barrier_post((unsigned*)args.ws + CW_BAR, (volatile LAS unsigned*)(lds + MISC_OFF) + 8);
#define xout ((float*)(unsigned char*)out_p)
#define rs ((float*)(unsigned char*)(ws + OFF_RS))
#define rs_mem ((float*)(unsigned char*)(ws + OFF_RSMEM))
#define lse ((float*)(unsigned char*)(ws + OFF_LSE))
#define XB ((bf16_t*)(unsigned char*)(ws + OFF_XB))
#define U ((bf16_t*)(unsigned char*)(ws + OFF_U))
#define ZM ((bf16_t*)(unsigned char*)(ws + OFF_ZM))
#define ZS ((bf16_t*)(unsigned char*)(ws + OFF_ZS))
#define Q ((bf16_t*)(unsigned char*)(ws + OFF_Q))
#define Kb ((bf16_t*)(unsigned char*)(ws + OFF_K))
#define V ((bf16_t*)(unsigned char*)(ws + OFF_V))
#define ZA ((bf16_t*)(unsigned char*)(ws + OFF_ZA))
#define QM ((bf16_t*)(unsigned char*)(ws + OFF_QM))
#define Y ((bf16_t*)(unsigned char*)(ws + OFF_Y))
#define MG ((bf16_t*)(unsigned char*)(ws + OFF_MERGED))
#define MEMB ((bf16_t*)(unsigned char*)(ws + OFF_MEMB))
#define tab ((unsigned char*)(ws + OFF_TAB))
#define x_in INP(0)
#define mem INP(1)
#define norm_g INP(2)
#define mem_norm_g INP(3)
#define w_in INP(4)
#define b_gate INP(5)
#define lam_re INP(6)
#define lam_im INP(7)
#define log_dt INP(8)
#define b_re INP(9)
#define b_im INP(10)
#define c_re INP(11)
#define c_im INP(12)
#define ssm_d INP(13)
#define w_glu INP(14)
#define b_glu INP(15)
#define w_mem_kv INP(16)
#define w_br_ssm INP(17)
#define w_br_attn INP(18)
#define w_br_mem INP(19)
#define w_out INP(20)
#define rel_bias INP(21)
#define final_g INP(22)
#define WL(l, o) ((bf16_t*)(unsigned char*)(ws + OFF_W + (size_t)(l) * W_STRIDE + (o)))
#define GRID_BAR() xcd_barrier(bar)
#define TABGEN(l) tabgen(tab, lam_re + (l) * NG * NP, lam_im + (l) * NG * NP, log_dt + (l) * NG, b_re + (size_t)(l) * NG * NP * HG, b_im + (size_t)(l) * NG * NP * HG, \
                         c_re + (size_t)(l) * NG * HG * NP, c_im + (size_t)(l) * NG * HG * NP, ssm_d + (l) * D_SSM, (LAS float*)(lds + wave * 16384), gw, ngw, lane)
    {
        PHASE_IDS();
        LAS float* scr = (LAS float*)(lds + wave * 18304);
        constexpr int I_IN = (1024 / 64) * (D_IN / 32), I_GLU = (768 / 64) * (768 / 32), I_B12 = (768 / 64) * (1024 / 32), I_B3 = (512 / 64) * (1024 / 32), I_SQ = (1024 / 64) * (1024 / 32);
        constexpr int NIT = I_IN + I_GLU + 2 * I_B12 + I_B3 + 2 * I_SQ;
        auto decode = [&](int it, TItem& t) {
            const int l = it >= NIT ? 1 : 0; int r = it - l * NIT; const float* W; int K_, N_; size_t wo; const float* ks = nullptr;
            if (r < I_IN) { W = w_in + (size_t)l * 1024 * D_IN; K_ = 1024; N_ = D_IN; wo = WO_IN; ks = norm_g + l * 1024; }
            else if ((r -= I_IN) < I_GLU) { W = w_glu + (size_t)l * 768 * 768; K_ = 768; N_ = 768; wo = WO_GLU; }
            else if ((r -= I_GLU) < I_B12) { W = w_br_ssm + (size_t)l * 768 * 1024; K_ = 768; N_ = 1024; wo = WO_B1; }
            else if ((r -= I_B12) < I_B12) { W = w_br_attn + (size_t)l * 768 * 1024; K_ = 768; N_ = 1024; wo = WO_B2; }
            else if ((r -= I_B12) < I_B3) { W = w_br_mem + (size_t)l * 512 * 1024; K_ = 512; N_ = 1024; wo = WO_B3; }
            else if ((r -= I_B3) < I_SQ) { W = w_out + (size_t)l * 1024 * 1024; K_ = 1024; N_ = 1024; wo = WO_OUT; }
            else { r -= I_SQ; W = w_mem_kv + (size_t)l * 1024 * 1024; K_ = 1024; N_ = 1024; wo = WO_MKV; ks = mem_norm_g + l * 1024; }
            const int nblk = N_ / 32; t.W = W; t.WT = WL(l, wo); t.ks = ks; t.N = N_; t.ldt = K_; t.k0 = 64 * (r / nblk); t.n0 = 32 * (r % nblk);
        };
        for (int it = gw; it < 2 * NIT; it += 2 * ngw) {
            TItem ta, tb; float va[32], vb[32]; const bool two = it + ngw < 2 * NIT;
            decode(it, ta); titem_load(ta, va, lane);
            if (two) { decode(it + ngw, tb); titem_load(tb, vb, lane); }
            titem_finish(ta, va, scr, lane);
            if (two) titem_finish(tb, vb, scr + 64 * 33, lane);
        }
        for (int m = 2 * gw; m < T; m += 2 * ngw) rownorm_row2(x_in, XB, rs, m, lane, (float*)(unsigned char*)(ws + OFF_ROWSQ));
        for (int m = gw; m < BATCH * MEM_LEN; m += ngw) rownorm_row(mem, MEMB, rs_mem, m, lane);
    }
    { PHASE_IDS(); TABGEN(0); }
    {
        PHASE_IDS();
        for (int i = gw * 64 + lane; i < NH * 196; i += ngw * 64) {
            const int head = i / 196, d = 159 - (i - head * 196), grp = head >> 2, r = grp == 0 ? 1 : (grp == 1 ? 4 : 16);
            ((float*)(unsigned char*)(ws + at::OFF_BIASR))[i] = (d >= 0 && d <= 128) ? rel_bias[rel_bucket(d * r) * NH + head] * at::LOG2E : 0.f;
        }
    }
    GRID_BAR();
#pragma unroll 1
    for (int l = 0; l < DEPTH; ++l) {
#define KVM ((bf16_t*)(unsigned char*)(ws + OFF_KVM + (size_t)l * 2 * MiB))
        {
            PHASE_IDS();
            if (l > 0) { TABGEN(l); __syncthreads(); }
            ge::PA_Sched S{G_, cb, (unsigned char*)ws, (unsigned char*)ws + OFF_W + (size_t)l * W_STRIDE};
            ge::PA_Epi E{ws, l};
            ge::gemm_run(lds, S, E);
        }
        GRID_BAR();
        {
            PHASE_IDS();
            { ge::PS_Sched S{cb, (unsigned char*)ws}; ge::PS_Epi E{ws}; ge::gemm_run(lds, S, E); }
            asm volatile("s_waitcnt vmcnt(0)" ::: "memory"); __syncthreads();
            { ge::PY_Sched S{cb, (unsigned char*)ws}; ge::PY_Epi E{ws}; ge::gemm_run(lds, S, E); }
            __syncthreads();
        }
        {
            PHASE_IDS();
            const int nss = BATCH * NG, n_lo = 5, n_hi = (BATCH * NH * 32 - nss * n_lo + (G_ - nss) - 1) / (G_ - nss);
            const int u_beg = cb < nss ? cb * n_lo : nss * n_lo + (cb - nss) * n_hi, u_cnt = cb < nss ? n_lo : n_hi;
            const int u_end = (u_beg + u_cnt) < BATCH * NH * 32 ? (u_beg + u_cnt) : BATCH * NH * 32;
            if (u_beg < u_end) {
                at::DilPref pre; at::DilUnit cu = at::dil_decode(u_beg); at::dil_prefetch(pre, ws, cu, tid);
                for (int ui = u_beg; ui < u_end; ++ui) { const bool hn = ui + 1 < u_end; const at::DilUnit nu = at::dil_decode(hn ? ui + 1 : ui); at::dil_unit(lds, ws, cu, pre, hn, nu, tid); cu = nu; }
            }
        }
        {
            PHASE_IDS();
            for (int ji = cb; ji < BATCH * MH * 16; ji += G_) at::mem_job(lds, ws, l, ji >> 6, (ji >> 4) & 3, (ji & 15) * 2, 2, tid);
        }
        GRID_BAR();
        {
            PHASE_IDS();
            ge::PG_Sched S{G_, cb, (unsigned char*)ws, (unsigned char*)ws + OFF_W + (size_t)l * W_STRIDE};
            ge::PG_Epi E{ws, (const GAS float*)(b_glu + l * 768)};
            ge::gemm_run(lds, S, E);
        }
        {
            PHASE_IDS();
            const int nfree = G_ - 128;
            if (nfree > 0) { if (cb >= 128) for (int tp = (cb - 128) * NWAVES + wave; tp < T / 2; tp += nfree * NWAVES) attn_final_pair(Q, lse, ZA, 2 * tp, lane); }
            else for (int tp = gw; tp < T / 2; tp += ngw) attn_final_pair(Q, lse, ZA, 2 * tp, lane);
        }
        GRID_BAR();
        {
            PHASE_IDS();
            ge::PM_Sched S{G_, cb, (unsigned char*)ws, (unsigned char*)ws + OFF_W + (size_t)l * W_STRIDE};
            ge::PM_Epi E{ws, (const GAS float*)(b_gate + l * 3072), cb, l};
            ge::gemm_run(lds, S, E);
        }
        GRID_BAR();
        {
            PHASE_IDS();
            ge::PO_Sched S{G_, cb, (unsigned char*)ws, (unsigned char*)ws + OFF_W + (size_t)l * W_STRIDE};
            ge::PO_Epi E{(const GAS float*)(l == 0 ? x_in : xout), (GAS float*)xout, ws, l};
            ge::gemm_run(lds, S, E);
        }
        GRID_BAR();
        if (l + 1 == DEPTH) { PHASE_IDS(); for (int m = gw; m < T; m += ngw) final_norm_row(xout, final_g, m, lane); }
    }
}

extern "C" void kernel_launch(void* const* d_in, const int* in_sizes, int n_in, void* d_out, int out_size, void* d_ws, size_t ws_size, hipStream_t stream) {
    static int grid = 0;
    if (grid == 0) {
        if (n_in != 23 || ws_size < WS_NEED || out_size != T * D_MODEL) { fprintf(stderr, "kernel_launch: unexpected shapes (n_in %d, ws %zu, out %d)\n", n_in, ws_size, out_size); grid = -1; return; }
        int dev = 0, cus = 0, per_cu = 0;
        if (hipGetDevice(&dev) != hipSuccess || hipDeviceGetAttribute(&cus, hipDeviceAttributeMultiprocessorCount, dev) != hipSuccess) { grid = -1; return; }
        if (hipFuncSetAttribute((const void*)mega_fwd, hipFuncAttributeMaxDynamicSharedMemorySize, LDS_BYTES) != hipSuccess) { fprintf(stderr, "kernel_launch: hipFuncSetAttribute failed\n"); grid = -1; return; }
        if (hipOccupancyMaxActiveBlocksPerMultiprocessor(&per_cu, (const void*)mega_fwd, NTHREADS, LDS_BYTES) != hipSuccess || per_cu < 1) { fprintf(stderr, "kernel_launch: occupancy query says %d blocks/CU\n", per_cu); per_cu = 1; }
        (void)hipGetLastError();
        grid = cus * 1;
    }
    if (grid < 0) return;
    (void)hipMemsetAsync(d_ws, 0, CTL_ZERO_BYTES, stream);
    Args a{};
    for (int i = 0; i < 23; ++i) a.in[i] = (const float*)d_in[i];
    a.out = (float*)d_out; a.ws = (unsigned char*)d_ws; a.ph_lo = 0; a.ph_hi = 0;
    hipLaunchKernelGGL(mega_fwd, dim3(grid), dim3(NTHREADS), LDS_BYTES, stream, a);
}
```
